# Optimizing an MI355X kernel written in HIP

```python
import jax, jax.numpy as jnp
from jax import lax
import numpy as np

D_MODEL = 1024
BATCH = 4
SEQ = 4096
DEPTH = 1

D_MIX = D_MODEL
D_ATTN = D_MIX // 2
D_REC = D_MIX - D_ATTN
HEAD_DIM = 64
N_HEADS = D_ATTN // HEAD_DIM
DILATED_PATTERNS = ((128, 1), (512, 4), (2048, 16))
REC_BLOCKS = 8
REC_BLOCK_W = D_REC // REC_BLOCKS
CONV_WIDTH = 4
RG_C = 8.0
N_EXPERTS = 32
TOP_K = 4
D_EXPERT = D_MODEL
SWIGLU_LIMIT = 7.0
SWIGLU_ALPHA = 1.702
EXPERT_BLOCK = 128
NORM_EPS = 1e-6
NEG_INF = -1e30
IN_COLS = 3 * D_ATTN + 2 * D_REC

kernel_name = "hymba_rglru_dilated_attn_moe_block"


def _rmsnorm(x, g):
    xf = x.astype(jnp.float32)
    y = xf * lax.rsqrt(jnp.mean(xf * xf, axis=-1, keepdims=True) + NORM_EPS)
    return (y * g.astype(jnp.float32)).astype(x.dtype)


def _modulate(h, shift, scale):
    return h * (1.0 + scale[:, None, :]) + shift[:, None, :]


def _dilated_branch(q, k, v, window, dilation):
    bsz, s, nh, e = q.shape
    span = window // dilation
    sub_len = s // dilation
    nb = -(-sub_len // span)
    lp = nb * span

    def to_sub(t):
        t = t.reshape(bsz, sub_len, dilation, nh, e).transpose(0, 2, 3, 1, 4)
        t = jnp.pad(t, ((0, 0), (0, 0), (0, 0), (0, lp - sub_len), (0, 0)))
        return t.reshape(bsz, dilation, nh, nb, span, e)

    def with_prev(t):
        prev = jnp.pad(t[:, :, :, :-1], ((0, 0), (0, 0), (0, 0), (1, 0), (0, 0), (0, 0)))
        return jnp.concatenate([prev, t], axis=4)

    qb = to_sub(q)
    kc = with_prev(to_sub(k))
    vc = with_prev(to_sub(v))
    scores = jnp.einsum('bdhnqe,bdhnke->bdhnqk', qb, kc) * (e ** -0.5)
    blk = jnp.arange(nb)[:, None, None] * span
    qpos = blk + jnp.arange(span)[None, :, None]
    kpos = blk - span + jnp.arange(2 * span)[None, None, :]
    rel = qpos - kpos
    mask = (rel >= 0) & (rel <= span) & (kpos >= 0)
    scores = jnp.where(mask, scores, NEG_INF)
    lse = jax.nn.logsumexp(scores, axis=-1)
    p = jnp.exp(scores - lse[..., None])
    o = jnp.einsum('bdhnqk,bdhnke->bdhnqe', p, vc)
    o = o.reshape(bsz, dilation, nh, lp, e)[:, :, :, :sub_len]
    o = o.transpose(0, 3, 1, 2, 4).reshape(bsz, s, nh, e)
    lse = lse.reshape(bsz, dilation, nh, lp)[:, :, :, :sub_len]
    lse = lse.transpose(0, 3, 1, 2).reshape(bsz, s, nh)
    return o, lse


def _dilated_attention(q, k, v):
    dt = q.dtype
    qf, kf, vf = q.astype(jnp.float32), k.astype(jnp.float32), v.astype(jnp.float32)
    outs, lses = [], []
    for window, dilation in DILATED_PATTERNS:
        o, lse = _dilated_branch(qf, kf, vf, window, dilation)
        outs.append(o)
        lses.append(lse)
    w = jax.nn.softmax(jnp.stack(lses, axis=0), axis=0)
    o = jnp.sum(w[..., None] * jnp.stack(outs, axis=0), axis=0)
    return o.astype(dt)


def _rglru_branch(xr, gr, conv_w, conv_b, w_a, b_a, w_x, b_x, lam):
    bsz, s, ch = xr.shape
    xc = lax.conv_general_dilated(
        xr, conv_w[:, None, :].astype(xr.dtype), window_strides=(1,),
        padding=[(CONV_WIDTH - 1, 0)], dimension_numbers=('NWC', 'WIO', 'NWC'),
        feature_group_count=ch) + conv_b
    xf = xc.astype(jnp.float32)
    xh = xf.reshape(bsz, s, REC_BLOCKS, REC_BLOCK_W)
    r = jax.nn.sigmoid(jnp.einsum('bsnh,nhk->bsnk', xh, w_a.astype(jnp.float32)).reshape(bsz, s, ch) + b_a)
    i = jax.nn.sigmoid(jnp.einsum('bsnh,nhk->bsnk', xh, w_x.astype(jnp.float32)).reshape(bsz, s, ch) + b_x)
    log_a = -RG_C * r * jax.nn.softplus(-lam.astype(jnp.float32))
    a = jnp.exp(log_a)
    mult = jnp.sqrt(-jnp.expm1(2.0 * log_a))
    u = mult * (i * xf)

    def combine(left, right):
        a1, b1 = left
        a2, b2 = right
        return a1 * a2, a2 * b1 + b2

    _, h = lax.associative_scan(combine, (a, u), axis=1)
    out = h * jax.nn.gelu(gr.astype(jnp.float32), approximate=True)
    return out.astype(xr.dtype)


def _moe(h, w_router, b_router, w_gate_up, b_gate_up, w_down, b_down):
    bsz, s, d = h.shape
    t = bsz * s
    ht = h.reshape(t, d)
    logits = (ht @ w_router + b_router).astype(jnp.float32)
    top_val, top_idx = lax.top_k(logits, TOP_K)
    gates = jax.nn.softmax(top_val, axis=-1)
    n_assign = t * TOP_K
    e_flat = top_idx.reshape(n_assign)
    tok_flat = jnp.arange(n_assign, dtype=jnp.int32) // TOP_K
    g_flat = gates.reshape(n_assign)
    order = jnp.argsort(e_flat)
    e_sorted = e_flat[order]
    tok_sorted = tok_flat[order]
    g_sorted = g_flat[order]
    counts = jnp.bincount(e_flat, length=N_EXPERTS)
    padded = ((counts + EXPERT_BLOCK - 1) // EXPERT_BLOCK) * EXPERT_BLOCK
    start = jnp.cumsum(counts) - counts
    pend = jnp.cumsum(padded)
    pstart = pend - padded
    rank = jnp.arange(n_assign, dtype=jnp.int32) - start[e_sorted]
    dest = pstart[e_sorted] + rank
    buf_len = (-(-n_assign // EXPERT_BLOCK) + N_EXPERTS) * EXPERT_BLOCK
    n_blocks = buf_len // EXPERT_BLOCK
    buf_tok = jnp.full((buf_len,), t, dtype=jnp.int32).at[dest].set(tok_sorted)
    ht_pad = jnp.concatenate([ht, jnp.zeros((1, d), ht.dtype)], axis=0)
    x_buf = ht_pad[buf_tok].reshape(n_blocks, EXPERT_BLOCK, d)
    blk_start = jnp.arange(n_blocks, dtype=pend.dtype) * EXPERT_BLOCK
    blk_exp = jnp.minimum(jnp.searchsorted(pend, blk_start, side='right'), N_EXPERTS - 1)

    def expert_block(args):
        xb, e = args
        gu = xb @ w_gate_up[e] + b_gate_up[e]
        gate, up = gu[:, :D_EXPERT], gu[:, D_EXPERT:]
        gate = jnp.minimum(gate, SWIGLU_LIMIT)
        up = jnp.clip(up, -SWIGLU_LIMIT, SWIGLU_LIMIT)
        glu = gate * jax.nn.sigmoid(gate * SWIGLU_ALPHA)
        return ((up + 1.0) * glu) @ w_down[e] + b_down[e]

    y_buf = lax.map(expert_block, (x_buf, blk_exp)).reshape(buf_len, d)
    y = jnp.zeros((t, d), jnp.float32).at[tok_sorted].add(
        y_buf[dest].astype(jnp.float32) * g_sorted[:, None])
    return y.reshape(bsz, s, d).astype(h.dtype)


def setup_inputs(seed: int = 0) -> dict:
    key = jax.random.key(seed)
    ks = jax.random.split(key, 24)
    nrm = jax.random.normal
    D = D_MODEL
    a0 = jax.random.uniform(ks[12], (DEPTH, D_REC), minval=0.9, maxval=0.999)
    sig = a0 ** (1.0 / RG_C)
    lam = jnp.log(sig) - jnp.log1p(-sig)
    return {
        'x': nrm(ks[0], (BATCH, SEQ, D), jnp.float32),
        'c': nrm(ks[1], (BATCH, D), jnp.float32),
        'w_ada': nrm(ks[2], (DEPTH, D, 6 * D)) * (0.5 * D ** -0.5),
        'b_ada': 0.01 * nrm(ks[3], (DEPTH, 6 * D)),
        'g_mix': 1.0 + 0.05 * nrm(ks[4], (DEPTH, D)),
        'w_in': nrm(ks[5], (DEPTH, D, IN_COLS)) * D ** -0.5,
        'conv_w': nrm(ks[6], (DEPTH, CONV_WIDTH, D_REC)) * CONV_WIDTH ** -0.5,
        'conv_b': 0.01 * nrm(ks[7], (DEPTH, D_REC)),
        'w_rg_a': nrm(ks[8], (DEPTH, REC_BLOCKS, REC_BLOCK_W, REC_BLOCK_W)) * REC_BLOCK_W ** -0.5,
        'b_rg_a': 0.01 * nrm(ks[9], (DEPTH, D_REC)),
        'w_rg_x': nrm(ks[10], (DEPTH, REC_BLOCKS, REC_BLOCK_W, REC_BLOCK_W)) * REC_BLOCK_W ** -0.5,
        'b_rg_x': 0.01 * nrm(ks[11], (DEPTH, D_REC)),
        'lam': lam,
        'w_out': nrm(ks[13], (DEPTH, D_MIX, D)) * D_MIX ** -0.5,
        'g_ffn': 1.0 + 0.05 * nrm(ks[14], (DEPTH, D)),
        'w_router': nrm(ks[15], (DEPTH, D, N_EXPERTS)) * D ** -0.5,
        'b_router': 0.01 * nrm(ks[16], (DEPTH, N_EXPERTS)),
        'w_gate_up': nrm(ks[17], (DEPTH, N_EXPERTS, D, 2 * D_EXPERT)) * D ** -0.5,
        'b_gate_up': 0.01 * nrm(ks[18], (DEPTH, N_EXPERTS, 2 * D_EXPERT)),
        'w_down': nrm(ks[19], (DEPTH, N_EXPERTS, D_EXPERT, D)) * D_EXPERT ** -0.5,
        'b_down': 0.01 * nrm(ks[20], (DEPTH, N_EXPERTS, D)),
        'g_final': 1.0 + 0.05 * nrm(ks[21], (D,)),
    }


def reference(x, c, w_ada, b_ada, g_mix, w_in, conv_w, conv_b, w_rg_a, b_rg_a, w_rg_x, b_rg_x,
              lam, w_out, g_ffn, w_router, b_router, w_gate_up, b_gate_up, w_down, b_down, g_final):
    bsz, s, _ = x.shape
    for l in range(DEPTH):
        mod = c @ w_ada[l] + b_ada[l]
        shift_m, scale_m, gate_m, shift_f, scale_f, gate_f = jnp.split(mod, 6, axis=-1)
        h = _modulate(_rmsnorm(x, g_mix[l]), shift_m, scale_m)
        z = h @ w_in[l]
        q, k, v, xr, gr = jnp.split(
            z, [D_ATTN, 2 * D_ATTN, 3 * D_ATTN, 3 * D_ATTN + D_REC], axis=-1)
        hd = (bsz, s, N_HEADS, HEAD_DIM)
        attn = _dilated_attention(q.reshape(hd), k.reshape(hd), v.reshape(hd)).reshape(bsz, s, D_ATTN)
        rec = _rglru_branch(xr, gr, conv_w[l], conv_b[l], w_rg_a[l], b_rg_a[l],
                            w_rg_x[l], b_rg_x[l], lam[l])
        y = jnp.concatenate([attn, rec], axis=-1) @ w_out[l]
        x = x + gate_m[:, None, :] * y
        h = _modulate(_rmsnorm(x, g_ffn[l]), shift_f, scale_f)
        x = x + gate_f[:, None, :] * _moe(h, w_router[l], b_router[l], w_gate_up[l],
                                          b_gate_up[l], w_down[l], b_down[l])
    return _rmsnorm(x, g_final)
```

```cpp
#include <hip/hip_runtime.h>
#include <cstdio>
#include <cstdint>
#define MK_N_LAUNCHES 1
namespace pg8 {
#define PG8_LAS __attribute__((address_space(3)))
typedef unsigned short bf16_t;
typedef short bf16x8 __attribute__((ext_vector_type(8)));
typedef float f32x4 __attribute__((ext_vector_type(4)));
typedef unsigned u32x4 __attribute__((ext_vector_type(4)));
constexpr int BM = 256, BK = 64, HALF = 128, HTB = HALF * BK * 2  , STAGE_BYTES = 8 * HTB, NXCD = 8, WGM = 8;

__host__ __device__ __forceinline__ int lds_byte(int r, int c) { const int st = (r >> 4) * 2 + (c >> 5), rr = r & 15, cc = c & 31, ob = rr * 64 + cc * 2; return st * 1024 + (ob ^ (((ob >> 9) & 1) << 5)); }
__host__ __device__ __forceinline__ void stage_rc(int b, int& R, int& C) { const int st = b / 1024, sb = b % 1024, swz = sb ^ (((sb >> 9) & 1) << 5); R = (st >> 1) * 16 + swz / 64; C = (st & 1) * 32 + (swz % 64) / 2; }
__host__ __device__ __forceinline__ int perm32(int rho) { const int n = rho >> 4, i = rho & 15; return 8 * (i >> 2) + 4 * n + (i & 3); }

struct Unit { int pm, pn; };
struct Gemm { const bf16_t* A; const bf16_t* Bt; int M, N, K; };

struct StaticOrder {
    int nM, nN, nwg, G, c;
    __host__ __device__ void init(int M, int N, int G_, int c_) { nM = M / BM; nN = N / BM; nwg = nM * nN; G = G_; c = c_; }
    __host__ __device__ bool next(int i, Unit& u) const {
        const long L = (long)i * G + c; if (L >= nwg) return false;
        int wgid = (int)L; { const int q = nwg / NXCD, r = nwg % NXCD, xcd = wgid % NXCD, off = wgid / NXCD; wgid = (xcd < r ? xcd * (q + 1) : r * (q + 1) + (xcd - r) * q) + off; }
        const int nig = WGM * nN, gid = wgid / nig, fm = gid * WGM, gsz = (nM - fm) < WGM ? (nM - fm) : WGM;
        u.pm = fm + ((wgid % nig) % gsz); u.pn = (wgid % nig) / gsz; return true;
    }
    __device__ __forceinline__ void a_ready(const Unit&) const {}
    __device__ __forceinline__ void done(const Unit&) const {}
};

__device__ __forceinline__ unsigned cvt_pk_bf16(float lo, float hi) { unsigned r; asm volatile("v_cvt_pk_bf16_f32 %0, %1, %2" : "=v"(r) : "v"(lo), "v"(hi)); return r; }
typedef float f32x2 __attribute__((ext_vector_type(2)));
__device__ __forceinline__ f32x2 gelu_pk(f32x2 v) {
    const f32x2 av = __builtin_elementwise_abs(v), d = av * 0.2316418882f + 1.0f;
    f32x2 t; t.x = __builtin_amdgcn_rcpf(d.x); t.y = __builtin_amdgcn_rcpf(d.y);
    f32x2 q = t * 0.5307027145f + (-0.7265760135f); q = q * t + 0.7107068705f; q = q * t + (-0.142248368f); q = q * t + 0.127414796f; q = q * t;
    const f32x2 s = (v * v) * (-0.72134752044f);
    f32x2 e; e.x = __builtin_amdgcn_exp2f(s.x); e.y = __builtin_amdgcn_exp2f(s.y);
    const f32x2 m = v * (q * e), r = v - m;
    f32x2 o; o.x = v.x < 0.f ? m.x : r.x; o.y = v.y < 0.f ? m.y : r.y; return o;
}

template <int ACT  > struct EpiBf16 {
    static constexpr bool PERM = true, AFTER_DRAIN = false; static_assert(ACT == 0 || ACT == 1, "EpiBf16: ACT is 0 (none) or 1 (gelu_pk)");
    bf16_t* O; int ldc; const float* bias; int split_cols; size_t split_stride; float scale0;
    __device__ __forceinline__ void operator()(const f32x4 (&acc)[2][2][4][2], const Unit& u, int wr, int wc, int fr, int fq) const {
        const int row0 = u.pm * BM + wr * 64 + fr; int colt = u.pn * BM; bf16_t* base = O;
        float sc = 1.f; if (split_cols) { const int t = colt / split_cols; base += (size_t)t * split_stride; colt -= t * split_cols; if (t == 0) sc = scale0; }
        const int col0 = colt + wc * 32 + 8 * fq, bcol0 = u.pn * BM + wc * 32 + 8 * fq;
        f32x4 bv[2][2];
#pragma unroll
        for (int bj = 0; bj < 2; ++bj)
#pragma unroll
            for (int n = 0; n < 2; ++n) bv[bj][n] = bias ? *(const f32x4*)(bias + bcol0 + bj * HALF + 4 * n) : (f32x4){0.f, 0.f, 0.f, 0.f};
#pragma unroll
        for (int ai = 0; ai < 2; ++ai)
#pragma unroll
            for (int m = 0; m < 4; ++m) { bf16_t* rowp = base + (size_t)(row0 + ai * HALF + m * 16) * ldc + col0;
#pragma unroll
                for (int bj = 0; bj < 2; ++bj) { f32x4 v0 = acc[ai][bj][m][0] + bv[bj][0], v1 = acc[ai][bj][m][1] + bv[bj][1];
                    if (ACT == 1) { f32x2 a = gelu_pk((f32x2){v0[0], v0[1]}), b = gelu_pk((f32x2){v0[2], v0[3]}), c = gelu_pk((f32x2){v1[0], v1[1]}), d = gelu_pk((f32x2){v1[2], v1[3]});
                        v0 = (f32x4){a.x, a.y, b.x, b.y}; v1 = (f32x4){c.x, c.y, d.x, d.y}; }
                    v0 = v0 * sc; v1 = v1 * sc; u32x4 w; w.x = cvt_pk_bf16(v0[0], v0[1]); w.y = cvt_pk_bf16(v0[2], v0[3]); w.z = cvt_pk_bf16(v1[0], v1[1]); w.w = cvt_pk_bf16(v1[2], v1[3]);
                    *(u32x4*)(rowp + bj * HALF) = w; } }
    }
};
template <class Epi, class Sched, bool ALIGN_EPI = false, bool SP2 = false>
__device__ __forceinline__ void gemm_phase(PG8_LAS unsigned char* lds, const Gemm g, const Sched& S, const Epi& E) {
    const int tid = threadIdx.x, wid = __builtin_amdgcn_readfirstlane(tid >> 6), lane = tid & 63, wr = wid >> 2, wc = wid & 3, fr = lane & 15, fq = lane >> 4;
    const int K = g.K, nt = K / BK;
    unsigned voffA[2], voffB[2];
#pragma unroll
    for (int i = 0; i < 2; ++i) { int R, C; stage_rc(tid * 16 + i * 8192, R, C); const int Rb = Epi::PERM ? ((R & ~31) + perm32(R & 31)) : R;
        voffA[i] = (unsigned)(R * K + C) * 2u; voffB[i] = (unsigned)(Rb * K + C) * 2u; }
    const size_t kstep = (size_t)(BK * 2);
    const size_t hstep = (size_t)HALF * K * 2;
    const size_t tstep = 2 * hstep;
    const unsigned ldsw = (unsigned)wid * 1024u;
    const int aoff = lds_byte(wr * 64 + fr, fq * 8), boff = lds_byte(wc * 32 + fr, fq * 8);
#define PG8_SA(b, h) (((b) * 2 + (h)) * HTB)
#define PG8_SB(b, h) ((4 + (b) * 2 + (h)) * HTB)
#define PG8_STAGE(bufoff, gbase, voff) do { _Pragma("unroll") for (int _i = 0; _i < 2; ++_i) \
        __builtin_amdgcn_global_load_lds((const unsigned*)((const char*)(gbase) + (voff)[_i]), (PG8_LAS unsigned*)(lds + (bufoff) + ldsw + _i * 8192), 16, 0, 0); } while (0)
#define PG8_LDA(dst, b, h) do { _Pragma("unroll") for (int m = 0; m < 4; ++m) _Pragma("unroll") for (int k = 0; k < 2; ++k) dst[m][k] = *(const PG8_LAS bf16x8*)(lds + PG8_SA(b, h) + aoff + m * 2048 + k * 1024); } while (0)
#define PG8_LDB(dst, b, h) do { _Pragma("unroll") for (int n = 0; n < 2; ++n) _Pragma("unroll") for (int k = 0; k < 2; ++k) dst[n][k] = *(const PG8_LAS bf16x8*)(lds + PG8_SB(b, h) + boff + n * 2048 + k * 1024); } while (0)
#define PG8_MMA(ai, bj, At, Bt) do { __builtin_amdgcn_s_setprio(1); _Pragma("unroll") for (int m = 0; m < 4; ++m) _Pragma("unroll") for (int n = 0; n < 2; ++n) _Pragma("unroll") for (int k = 0; k < 2; ++k) \
        acc[ai][bj][m][n] = __builtin_amdgcn_mfma_f32_16x16x32_bf16(Bt[n][k], At[m][k], acc[ai][bj][m][n], 0, 0, 0); __builtin_amdgcn_s_setprio(0); } while (0)
#define PG8_WAIT_V(n) asm volatile("s_waitcnt vmcnt(" #n ")" ::: "memory")
#define PG8_WAIT_L(n) asm volatile("s_waitcnt lgkmcnt(" #n ")" ::: "memory")
#define PG8_BAR __builtin_amdgcn_s_barrier()
#define PG8_SCHED __builtin_amdgcn_sched_barrier(0)
    Unit cur, nxt; int ui = 0;
    if (!S.next(0, cur)) return;
    f32x4 acc[2][2][4][2];
#pragma unroll
    for (int a = 0; a < 2; ++a)
#pragma unroll
        for (int b = 0; b < 2; ++b)
#pragma unroll
            for (int m = 0; m < 4; ++m)
#pragma unroll
                for (int n = 0; n < 2; ++n) acc[a][b][m][n] = (f32x4){0.f, 0.f, 0.f, 0.f};
    bf16x8 At[4][2], B0[2][2], B1[2][2];
    const char* cA = (const char*)g.A + (size_t)cur.pm * tstep; const char* cB = (const char*)g.Bt + (size_t)cur.pn * tstep;
    S.a_ready(cur);
    if constexpr (SP2) {
        PG8_STAGE(PG8_SB(0, 0), cB, voffB); PG8_STAGE(PG8_SB(0, 1), cB + hstep, voffB); PG8_STAGE(PG8_SA(0, 0), cA, voffA); PG8_STAGE(PG8_SA(0, 1), cA + hstep, voffA);
        if (wr == 1) PG8_BAR;
        PG8_WAIT_V(2); PG8_BAR;
        PG8_STAGE(PG8_SB(1, 0), cB + kstep, voffB); PG8_STAGE(PG8_SA(1, 0), cA + kstep, voffA); PG8_STAGE(PG8_SB(1, 1), cB + hstep + kstep, voffB);
        PG8_WAIT_V(6); PG8_BAR;
    } else {
        PG8_STAGE(PG8_SB(0, 0), cB, voffB); PG8_STAGE(PG8_SA(0, 0), cA, voffA); PG8_STAGE(PG8_SB(0, 1), cB + hstep, voffB); PG8_STAGE(PG8_SA(0, 1), cA + hstep, voffA);
        if (wr == 1) PG8_BAR;
        PG8_WAIT_V(4); PG8_BAR;
        PG8_STAGE(PG8_SB(1, 0), cB + kstep, voffB); PG8_STAGE(PG8_SA(1, 0), cA + kstep, voffA); PG8_STAGE(PG8_SB(1, 1), cB + hstep + kstep, voffB);
        PG8_WAIT_V(6); PG8_BAR;
    }
    for (;;) {
        const bool has_next = S.next(ui + 1, nxt);
        const char* nA = has_next ? (const char*)g.A + (size_t)nxt.pm * tstep : cA; const char* nB = has_next ? (const char*)g.Bt + (size_t)nxt.pn * tstep : cB;
        for (int t = 0; t < nt; t += 2) {
            const bool last = (t == nt - 2);
            const char* a1 = cA + (size_t)(t + 1) * kstep;
            const char* a2 = last ? nA : cA + (size_t)(t + 2) * kstep; const char* b2 = last ? nB : cB + (size_t)(t + 2) * kstep;
            const char* a3 = a2 + kstep; const char* b3 = b2 + kstep;
            if (last && has_next) S.a_ready(nxt);
            if constexpr (SP2) {
            PG8_LDB(B0, 0, 0); PG8_LDB(B1, 0, 1); PG8_SCHED; PG8_LDA(At, 0, 0); PG8_STAGE(PG8_SA(1, 1), a1 + hstep, voffA);
            PG8_WAIT_V(8); PG8_WAIT_L(0); PG8_BAR; PG8_MMA(0, 0, At, B0); PG8_MMA(0, 1, At, B1); PG8_BAR; PG8_SCHED;
            PG8_LDA(At, 0, 1); PG8_STAGE(PG8_SB(0, 0), b2, voffB); PG8_STAGE(PG8_SB(0, 1), b2 + hstep, voffB); PG8_STAGE(PG8_SA(0, 0), a2, voffA);
            PG8_WAIT_V(8); PG8_WAIT_L(0); PG8_BAR; PG8_MMA(1, 0, At, B0); PG8_MMA(1, 1, At, B1); PG8_BAR; PG8_SCHED;
            PG8_LDB(B0, 1, 0); PG8_LDB(B1, 1, 1); PG8_SCHED; PG8_LDA(At, 1, 0); PG8_STAGE(PG8_SA(0, 1), a2 + hstep, voffA);
            PG8_WAIT_V(8); PG8_WAIT_L(0); PG8_BAR; PG8_MMA(0, 0, At, B0); PG8_MMA(0, 1, At, B1); PG8_BAR; PG8_SCHED;
            PG8_LDA(At, 1, 1); PG8_STAGE(PG8_SB(1, 0), b3, voffB); PG8_STAGE(PG8_SB(1, 1), b3 + hstep, voffB); PG8_STAGE(PG8_SA(1, 0), a3, voffA);
            PG8_WAIT_V(8); PG8_WAIT_L(0); PG8_BAR; PG8_MMA(1, 0, At, B0); PG8_MMA(1, 1, At, B1); PG8_BAR; PG8_SCHED;
            } else {
            PG8_LDB(B0, 0, 0); PG8_SCHED; PG8_LDA(At, 0, 0); PG8_STAGE(PG8_SA(1, 1), a1 + hstep, voffA);
            PG8_WAIT_L(8); PG8_BAR; PG8_WAIT_L(0); PG8_MMA(0, 0, At, B0); PG8_BAR; PG8_SCHED;
            PG8_LDB(B1, 0, 1); PG8_STAGE(PG8_SB(0, 0), b2, voffB);
            PG8_BAR; PG8_WAIT_L(0); PG8_MMA(0, 1, At, B1); PG8_BAR;
            PG8_LDA(At, 0, 1); PG8_STAGE(PG8_SA(0, 0), a2, voffA);
            PG8_BAR; PG8_WAIT_L(0); PG8_MMA(1, 0, At, B0); PG8_BAR; PG8_SCHED;
            PG8_STAGE(PG8_SB(0, 1), b2 + hstep, voffB);
            PG8_WAIT_V(6); PG8_BAR; PG8_MMA(1, 1, At, B1); PG8_BAR;
            PG8_LDB(B0, 1, 0); PG8_SCHED; PG8_LDA(At, 1, 0); PG8_STAGE(PG8_SA(0, 1), a2 + hstep, voffA);
            PG8_WAIT_L(8); PG8_BAR; PG8_WAIT_L(0); PG8_MMA(0, 0, At, B0); PG8_BAR; PG8_SCHED;
            PG8_LDB(B1, 1, 1); PG8_STAGE(PG8_SB(1, 0), b3, voffB);
            PG8_BAR; PG8_WAIT_L(0); PG8_MMA(0, 1, At, B1); PG8_BAR;
            PG8_LDA(At, 1, 1); PG8_STAGE(PG8_SA(1, 0), a3, voffA);
            PG8_BAR; PG8_WAIT_L(0); PG8_MMA(1, 0, At, B0); PG8_BAR; PG8_SCHED;
            PG8_STAGE(PG8_SB(1, 1), b3 + hstep, voffB);
            PG8_WAIT_V(6); PG8_BAR; PG8_MMA(1, 1, At, B1); PG8_BAR;
            }
        }
        if constexpr (ALIGN_EPI) { if (wr == 0) PG8_BAR; }
        if constexpr (!Epi::AFTER_DRAIN) { E(acc, cur, wr, wc, fr, fq); S.done(cur); }
        if (!has_next) break;
#pragma unroll
        for (int a = 0; a < 2; ++a)
#pragma unroll
            for (int b = 0; b < 2; ++b)
#pragma unroll
                for (int m = 0; m < 4; ++m)
#pragma unroll
                    for (int n = 0; n < 2; ++n) acc[a][b][m][n] = (f32x4){0.f, 0.f, 0.f, 0.f};
        cur = nxt; cA = nA; cB = nB; ++ui;
        if constexpr (ALIGN_EPI) { if (wr == 1) PG8_BAR; }
    }
    PG8_WAIT_V(0);
    if constexpr (!ALIGN_EPI) { if (wr == 0) PG8_BAR; }
    PG8_BAR;
    if constexpr (Epi::AFTER_DRAIN) { E.fused(acc, cur, wr, wc, fr, fq, lds, wid, lane); S.done(cur); }
#undef PG8_SA
#undef PG8_SB
#undef PG8_STAGE
#undef PG8_LDA
#undef PG8_LDB
#undef PG8_MMA
#undef PG8_WAIT_V
#undef PG8_WAIT_L
#undef PG8_BAR
#undef PG8_SCHED
}
}

namespace pg8 {
struct EpiResGate {
    static constexpr bool PERM = false, AFTER_DRAIN = false;
    const float* base; float* out; int ldc; const float* gate; int gate_bstride; int rows_per_batch;
    __device__ __forceinline__ void operator()(const f32x4 (&acc)[2][2][4][2], const Unit& u, int wr, int wc, int fr, int fq) const {
        const int b = (u.pm * BM) / rows_per_batch;
        const int col0 = u.pn * BM + wc * 32 + 4 * fq;
        f32x4 gv[2][2];
#pragma unroll
        for (int bj = 0; bj < 2; ++bj)
#pragma unroll
            for (int n = 0; n < 2; ++n) gv[bj][n] = *(const f32x4*)(gate + (size_t)b * gate_bstride + col0 + bj * HALF + n * 16);
#pragma unroll
        for (int ai = 0; ai < 2; ++ai)
#pragma unroll
            for (int m = 0; m < 4; ++m) { const size_t off = (size_t)(u.pm * BM + ai * HALF + wr * 64 + m * 16 + fr) * ldc + col0;
#pragma unroll
                for (int bj = 0; bj < 2; ++bj)
#pragma unroll
                    for (int n = 0; n < 2; ++n) { const f32x4 bs = *(const f32x4*)(base + off + bj * HALF + n * 16);
                        *(f32x4*)(out + off + bj * HALF + n * 16) = bs + gv[bj][n] * acc[ai][bj][m][n]; } }
    }
};
struct EpiSwiglu {
    static constexpr bool PERM = true, AFTER_DRAIN = false;
    bf16_t* O; const float* bgu;
    __device__ __forceinline__ float act1(float g, float u) const {
        g = __builtin_fminf(g, 7.0f); u = __builtin_fminf(__builtin_fmaxf(u, -7.0f), 7.0f);
        const float s = __builtin_amdgcn_rcpf(1.0f + __builtin_amdgcn_exp2f(g * (-1.702f * 1.4426950408889634f)));
        return (u + 1.0f) * (g * s);
    }
    __device__ __forceinline__ void operator()(const f32x4 (&acc)[2][2][4][2], const Unit& u, int wr, int wc, int fr, int fq) const {
        const int e = u.pn >> 3, pnl = u.pn & 7;
        const int row0 = u.pm * BM + wr * 64 + fr;
        const int ocol0 = pnl * 128 + wc * 32 + 8 * fq;
        f32x4 bg[2], bu[2];
#pragma unroll
        for (int n = 0; n < 2; ++n) { bg[n] = *(const f32x4*)(bgu + (size_t)e * 2048 + ocol0 + 4 * n); bu[n] = *(const f32x4*)(bgu + (size_t)e * 2048 + 1024 + ocol0 + 4 * n); }
#pragma unroll
        for (int ai = 0; ai < 2; ++ai)
#pragma unroll
            for (int m = 0; m < 4; ++m) { bf16_t* rowp = O + (size_t)(row0 + ai * HALF + m * 16) * 1024 + ocol0;
                const f32x4 g0 = acc[ai][0][m][0] + bg[0], g1 = acc[ai][0][m][1] + bg[1], u0 = acc[ai][1][m][0] + bu[0], u1 = acc[ai][1][m][1] + bu[1];
                u32x4 w; w.x = cvt_pk_bf16(act1(g0[0], u0[0]), act1(g0[1], u0[1])); w.y = cvt_pk_bf16(act1(g0[2], u0[2]), act1(g0[3], u0[3]));
                w.z = cvt_pk_bf16(act1(g1[0], u1[0]), act1(g1[1], u1[1])); w.w = cvt_pk_bf16(act1(g1[2], u1[2]), act1(g1[3], u1[3]));
                *(u32x4*)rowp = w; }
    }
};
struct GroupedOrder {
    const int* tile_e; int nM, nNl, nwg, G, c;
    __device__ void init(const int* te, int ntm, int nNl_, int G_, int c_) { tile_e = te; nM = ntm; nNl = nNl_; nwg = ntm * nNl_; G = G_; c = c_; }
    __device__ bool next(int i, Unit& u) const {
        const long L = (long)i * G + c; if (L >= nwg) return false;
        int wgid = (int)L; { const int q = nwg / NXCD, r = nwg % NXCD, xcd = wgid % NXCD, off = wgid / NXCD; wgid = (xcd < r ? xcd * (q + 1) : r * (q + 1) + (xcd - r) * q) + off; }
        const int nig = WGM * nNl, gid = wgid / nig, fm = gid * WGM, gsz = (nM - fm) < WGM ? (nM - fm) : WGM;
        u.pm = fm + ((wgid % nig) % gsz); const int pl = (wgid % nig) / gsz;
        u.pn = __builtin_amdgcn_readfirstlane(tile_e[u.pm]) * nNl + pl; return true;
    }
    __device__ __forceinline__ void a_ready(const Unit&) const {}
    __device__ __forceinline__ void done(const Unit&) const {}
};
}

constexpr int NWAVES = 8;
constexpr int NB = 4, SEQ = 4096, DM = 1024, TT = NB * SEQ, DH = 512, NHEAD = 8, HD = 64, NEXP = 32, TOPK = 4, INCOLS = 2560, NMOD = 6 * DM, DE2 = 2048;
constexpr float NORM_EPS = 1e-6f;
constexpr float C2 = 0.125f * 1.4426950408889634f;
constexpr int MAXSLOT = TT * TOPK + NEXP * 256, MAXTILE = MAXSLOT / 256;
#ifndef MK_N_LAUNCHES
#define MK_N_LAUNCHES 1
#endif
constexpr int PER_PHASE = 11;
constexpr int N_LAUNCHES = MK_N_LAUNCHES;

constexpr size_t MiB = 1u << 20;
constexpr size_t WS_CTL = 0, CTL_ZERO_BYTES = 1 * MiB;
constexpr size_t WS_MISC = 1 * MiB;
constexpr size_t WS_WRT = 2 * MiB;
constexpr size_t WS_WIN = 3 * MiB, WS_WOUT = 8 * MiB, WS_WGU = 16 * MiB, WS_WD = 144 * MiB;
constexpr size_t WS_XN = 208 * MiB, WS_QKV = 240 * MiB, WS_OP = 320 * MiB, WS_LSE = 368 * MiB, WS_MIX = 370 * MiB, WS_X1 = 402 * MiB;
constexpr size_t WS_ROUTE = 466 * MiB;
constexpr size_t WS_XG = 468 * MiB, WS_ACT = 612 * MiB, WS_MODP = 756 * MiB, WS_END = 757 * MiB;
constexpr int CW_TMO = 0, CW_CODE = 1, CW_BAR = 4096, CW_CNT = 8192, CW_MODC = 12288, CW_MOD = 16384;
static_assert((CW_MOD + NB * NMOD) * 4 <= (int)CTL_ZERO_BYTES, "ctl");
constexpr int RING_OFF = 0, RING_BYTES = 131072, LDSCTL_OFF = RING_BYTES, MISC_OFF = LDSCTL_OFF + 320, SUMM_OFF = RING_BYTES + 1024, TILE_OFF = SUMM_OFF + 4096, LDS_BYTES = 147456;
static_assert(TILE_OFF + 1024 <= LDS_BYTES, "lds");
#define GAS __attribute__((address_space(1)))
#define LAS __attribute__((address_space(3)))
typedef unsigned short bf16;
typedef unsigned v4u __attribute__((ext_vector_type(4)));
typedef float f32x4 __attribute__((ext_vector_type(4)));
typedef short bf16x8 __attribute__((ext_vector_type(8)));
typedef GAS unsigned gu32;
typedef GAS unsigned long long gu64;
#define RLX_AGENT __ATOMIC_RELAXED, __HIP_MEMORY_SCOPE_AGENT
#define LDS_WAIT() asm volatile("s_waitcnt lgkmcnt(0)" ::: "memory")
#define VM_WAIT() asm volatile("s_waitcnt vmcnt(0)" ::: "memory")
__device__ __forceinline__ unsigned long long rt() { return __builtin_amdgcn_s_memrealtime(); }
__device__ __forceinline__ unsigned f2bf(float f) { unsigned u = __builtin_bit_cast(unsigned, f); return (u + 0x7fffu + ((u >> 16) & 1u)) >> 16; }
__device__ __forceinline__ unsigned pk2(float lo, float hi) { return f2bf(lo) | (f2bf(hi) << 16); }

#define XB_TMO      128
#define XB_XCNT(j)  (256  + 64 * (j))
#define XB_XSUB(j)  (1280 + 64 * (j))
#define XB_XGEN(j)  (2304 + 64 * (j))
#define XB_TOP      3328
#define XB_TOPGEN   3392
#define XCD_BAR_WORDS 3456
#define XB_SPIN_CAP (1u << 18)

__device__ __forceinline__ unsigned xb_ld(unsigned* p)              { return __hip_atomic_load(p, __ATOMIC_RELAXED, __HIP_MEMORY_SCOPE_AGENT); }
__device__ __forceinline__ unsigned xb_add(unsigned* p, unsigned v) { return __hip_atomic_fetch_add(p, v, __ATOMIC_RELAXED, __HIP_MEMORY_SCOPE_AGENT); }
__device__ __forceinline__ unsigned xb_xcc_id() { return (unsigned)__builtin_amdgcn_s_getreg((3 << 11) | 20) & 0xFu; }
#define XB_SPIN(cond, bar) do { unsigned _sp = 0; while (cond) { __builtin_amdgcn_s_sleep(1); \
    if ((++_sp & 255u) == 0u) { if (xb_ld(&(bar)[XB_TMO])) break; if (_sp > XB_SPIN_CAP) { atomicAdd(&(bar)[XB_TMO], 1u); break; } } } } while (0)

struct XcdBarrier {
    unsigned* bar; unsigned x;
    volatile LAS unsigned* st;
};

__device__ __forceinline__ XcdBarrier xcd_barrier_post(unsigned* bar, volatile LAS unsigned* st) {
    XcdBarrier b; b.bar = bar; b.x = xb_xcc_id(); b.st = st;
    if (threadIdx.x == 0) (void)xb_add(&bar[XB_XCNT(b.x)], 1u);
    return b;
}
__device__ __forceinline__ void xcd_barrier_complete(unsigned* bar, unsigned x, unsigned& nloc, unsigned& nx) {
    const unsigned G = gridDim.x * gridDim.y * gridDim.z;
    unsigned sum, cnt, mine, sp = 0u;
    for (;;) {
        sum = 0u; cnt = 0u; mine = 0u;
#pragma unroll
        for (unsigned j = 0; j < 16; ++j) { const unsigned c = xb_ld(&bar[XB_XCNT(j)]); sum += c; cnt += (c > 0u) ? 1u : 0u; mine = (j == x) ? c : mine; }
        if (sum == G) break;
        __builtin_amdgcn_s_sleep(1);
        if ((++sp & 255u) == 0u) { if (xb_ld(&bar[XB_TMO])) break; if (sp > XB_SPIN_CAP) { atomicAdd(&bar[XB_TMO], 1u); break; } }
    }
    nloc = mine > 0u ? mine : 1u; nx = cnt > 0u ? cnt : 1u;
}

__device__ __forceinline__ void xcd_barrier(const XcdBarrier& b) {
    asm volatile("s_waitcnt vmcnt(0)" ::: "memory");
    __syncthreads();
    if (threadIdx.x == 0) {
        unsigned* bar = b.bar;
        __builtin_amdgcn_s_waitcnt(0);
        unsigned nloc = b.st[0], nx = b.st[1];
        if (nloc == 0u) { xcd_barrier_complete(bar, b.x, nloc, nx); b.st[0] = nloc; b.st[1] = nx; }
        const unsigned old = xb_add(&bar[XB_XSUB(b.x)], 1u);
        const unsigned gen = old / nloc;
        if (old + 1u == (gen + 1u) * nloc) {
            __builtin_amdgcn_fence(__ATOMIC_RELEASE, "agent");
            asm volatile("s_waitcnt vmcnt(0)" ::: "memory");
            const unsigned og = xb_add(&bar[XB_TOP], 1u);
            const unsigned tg = og / nx;
            if (og + 1u == (tg + 1u) * nx) xb_add(&bar[XB_TOPGEN], 1u);
            else XB_SPIN(xb_ld(&bar[XB_TOPGEN]) == tg, bar);
            __builtin_amdgcn_fence(__ATOMIC_ACQUIRE, "agent");
            xb_add(&bar[XB_XGEN(b.x)], 1u);
            asm volatile("s_waitcnt vmcnt(0)" ::: "memory");
        } else {
            XB_SPIN(xb_ld(&bar[XB_XGEN(b.x)]) == gen, bar);
            __builtin_amdgcn_fence(__ATOMIC_ACQUIRE, "agent");
            asm volatile("s_waitcnt vmcnt(0)" ::: "memory");
        }
    }
    __syncthreads();
}

typedef float f32x16 __attribute__((ext_vector_type(16)));
typedef short v4i16_t __attribute__((ext_vector_type(4)));
typedef unsigned v2u __attribute__((ext_vector_type(2)));
struct Frame {
    LAS unsigned char* lds;
    volatile LAS unsigned* MISC;
    gu32* ctl;
    int tid, lane, wave, vcu, G;
    const float *x, *c, *w_ada, *b_ada, *g_mix, *w_in, *conv_w, *conv_b, *w_rg_a, *b_rg_a, *w_rg_x, *b_rg_x, *lam, *w_out, *g_ffn, *w_router, *b_router, *w_gate_up, *b_gate_up, *w_down, *b_down, *g_final;
    float* out;
    float* mod; float* modp; int* modc; int* cnt;
    int* tile_e; int* tile_n; float* rsum;
    float* wr_t; bf16 *Wa_t, *Wx_t, *Win_t, *Wout_t, *Wgu_t, *Wd_t;
    bf16 *XN, *QB, *KB, *VB, *XR, *GR, *OP, *MIX, *XG, *ACT;
    float *LSE, *X1;
    int *tok_e, *tok_pos, *tok_slot; float* tok_gate;
};
__device__ __forceinline__ float bf2f(unsigned short v) { return __uint_as_float(((unsigned)v) << 16); }
__device__ __forceinline__ float wave_sum(float v) {
#pragma unroll
    for (int o = 1; o < 64; o <<= 1) v += __shfl_xor(v, o);
    return v;
}
__device__ __forceinline__ float wave_max(float v) {
#pragma unroll
    for (int o = 1; o < 64; o <<= 1) v = fmaxf(v, __shfl_xor(v, o));
    return v;
}
__device__ __forceinline__ int crow(int r, int hi) { return (r & 3) + 8 * (r >> 2) + 4 * hi; }

__device__ __forceinline__ void p0_transpose_item(const float* W, int K, int N, bf16* WT, int k0, int n0, int drow0, LAS float* scr, int lane) {
#pragma unroll 8
    for (int i = 0; i < 32; ++i) { const int kk = 2 * i + (lane >> 5); scr[kk * 33 + (lane & 31)] = W[(size_t)(k0 + kk) * N + n0 + (lane & 31)]; }
    LDS_WAIT(); asm volatile("" ::: "memory");
    const int c = lane & 7;
#pragma unroll
    for (int j = 0; j < 4; ++j) { const int n = (lane >> 3) + 8 * j; const LAS float* s = scr + (8 * c) * 33 + n;
        v4u o; o.x = pk2(s[0 * 33], s[1 * 33]); o.y = pk2(s[2 * 33], s[3 * 33]); o.z = pk2(s[4 * 33], s[5 * 33]); o.w = pk2(s[6 * 33], s[7 * 33]);
        *(GAS v4u*)(WT + (size_t)(drow0 + n) * K + k0 + 8 * c) = o; }
    LDS_WAIT(); asm volatile("" ::: "memory");
}
__device__ __forceinline__ void p0_prologue(Frame& F) {
    LAS float* scr = (LAS float*)(F.lds + RING_OFF + F.wave * 16384);
    const int lane = F.lane;
    const int gw = F.vcu * NWAVES + F.wave, NGW = F.G * NWAVES;
    constexpr int I_MOD = 96 * 8, I_WIN = 16 * 80, I_WOUT = 16 * 32, I_WGU = NEXP * 16 * 64, I_WD = NEXP * 16 * 32, I_RG = 32, I_WR = 512;
    constexpr int NITEMS = I_MOD + I_WIN + I_WOUT + I_WGU + I_WD + I_RG + I_WR;
    for (int it = gw; it < NITEMS; it += NGW) {
        int r = it;
        if (r < I_MOD) {
            const int cg = r % 96, kc = r / 96, col = cg * 64 + lane; float a0 = 0.f, a1 = 0.f, a2 = 0.f, a3 = 0.f;
            const float* wp = F.w_ada + (size_t)(kc * 128) * NMOD + col; const float* cp = F.c + kc * 128;
#pragma unroll 8
            for (int k = 0; k < 128; ++k) { const float w = wp[(size_t)k * NMOD]; a0 += cp[k] * w; a1 += cp[DM + k] * w; a2 += cp[2 * DM + k] * w; a3 += cp[3 * DM + k] * w; }
            { float* pp = F.modp + (size_t)(kc * 4) * NMOD + col; pp[0] = a0; pp[NMOD] = a1; pp[2 * NMOD] = a2; pp[3 * NMOD] = a3; }
            __threadfence();
            unsigned old = 0u; if (lane == 0) old = __hip_atomic_fetch_add((unsigned*)F.modc + cg, 1u, __ATOMIC_RELAXED, __HIP_MEMORY_SCOPE_AGENT);
            old = (unsigned)__builtin_amdgcn_readfirstlane((int)old);
            if (old == 7u) { __threadfence();
                const float bb = F.b_ada[col];
#pragma unroll
                for (int b4 = 0; b4 < 4; ++b4) { float s = 0.f;
#pragma unroll
                    for (int q = 0; q < 8; ++q) s += __builtin_bit_cast(float, __hip_atomic_load((const unsigned*)(F.modp + (size_t)(q * 4 + b4) * NMOD + col), __ATOMIC_RELAXED, __HIP_MEMORY_SCOPE_AGENT));
                    F.mod[(size_t)b4 * NMOD + col] = s + bb; } }
            continue; }
        r -= I_MOD;
        if (r < I_WIN) { const int kb = r / 80, nb = r % 80; p0_transpose_item(F.w_in, DM, INCOLS, F.Win_t, 64 * kb, 32 * nb, 32 * nb, scr, lane); continue; } r -= I_WIN;
        if (r < I_WOUT) { const int kb = r / 32, nb = r % 32; p0_transpose_item(F.w_out, DM, DM, F.Wout_t, 64 * kb, 32 * nb, 32 * nb, scr, lane); continue; } r -= I_WOUT;
        if (r < I_WGU) { const int e = r >> 10, rr = r & 1023, kb = rr >> 6, nb = rr & 63, n0 = 32 * nb;
            const int j = n0 & 1023, drow0 = (j >> 7) * 256 + (n0 >= 1024 ? 128 : 0) + (j & 127);
            p0_transpose_item(F.w_gate_up + (size_t)e * DM * DE2, DM, DE2, F.Wgu_t + (size_t)e * DE2 * DM, 64 * kb, n0, drow0, scr, lane); continue; } r -= I_WGU;
        if (r < I_WD) { const int e = r >> 9, rr = r & 511, kb = rr >> 5, nb = rr & 31;
            p0_transpose_item(F.w_down + (size_t)e * DM * DM, DM, DM, F.Wd_t + (size_t)e * DM * DM, 64 * kb, 32 * nb, 32 * nb, scr, lane); continue; } r -= I_WD;
        if (r < I_RG) { const int which = r >> 4, rr = r & 15, n = rr >> 1, nb = rr & 1;
            p0_transpose_item((which ? F.w_rg_x : F.w_rg_a) + n * 4096, 64, 64, (which ? F.Wx_t : F.Wa_t) + n * 4096, 0, 32 * nb, 32 * nb, scr, lane); continue; } r -= I_RG;
        { const int idx = r * 64 + lane, e = idx >> 10, k = idx & 1023; F.wr_t[idx] = F.w_router[k * NEXP + e]; }
    }
}
__device__ __forceinline__ void p1_norm(Frame& F) {
    const int gw = F.vcu * NWAVES + F.wave, NGW = F.G * NWAVES, lane = F.lane;
    for (int m = gw; m < TT; m += NGW) {
        const int b = m / SEQ;
        const GAS f32x4* xr = (const GAS f32x4*)(F.x + (size_t)m * DM) + lane;
        f32x4 v[4]; float ss = 0.f;
#pragma unroll
        for (int j = 0; j < 4; ++j) { v[j] = xr[64 * j]; ss += (v[j].x * v[j].x + v[j].y * v[j].y) + (v[j].z * v[j].z + v[j].w * v[j].w); }
        const float rstd = 1.0f / sqrtf(wave_sum(ss) * (1.0f / DM) + NORM_EPS);
        const float* mb = F.mod + (size_t)b * NMOD;
#pragma unroll
        for (int j = 0; j < 4; ++j) { const int col = 4 * lane + 256 * j;
            const f32x4 g = *(const f32x4*)(F.g_mix + col), sc = *(const f32x4*)(mb + DM + col), sh = *(const f32x4*)(mb + col);
            const f32x4 h = (v[j] * rstd) * g * (sc + 1.0f) + sh;
            v2u o; o.x = pk2(h.x, h.y); o.y = pk2(h.z, h.w); *(GAS v2u*)(F.XN + (size_t)m * DM + col) = o; }
    }
}
template <bool FINAL> __device__ __forceinline__ void rglru_items(Frame& F) {
    LAS unsigned char* wl = F.lds + RING_OFF + F.wave * 16384;
    LAS float* summ = (LAS float*)(F.lds + SUMM_OFF);
    const int lane = F.lane, w = F.wave;
    for (int it = F.vcu; it < NB * 8 * 16; it += F.G) {
        const int sp = it & 15, n = (it >> 4) & 7, b = it >> 7;
        const int gc = n * 64 + lane, t0 = sp * 256 + w * 32;
        const bf16* xrp = F.XR + ((size_t)b * SEQ) * DH + gc;
        float xin[35];
#pragma unroll
        for (int i = 0; i < 35; ++i) { const int tt = t0 - 3 + i, tc = tt < 0 ? 0 : tt; const float v = bf2f(xrp[(size_t)tc * DH]); xin[i] = tt < 0 ? 0.f : v; }
        const float cw0 = F.conv_w[gc], cw1 = F.conv_w[DH + gc], cw2 = F.conv_w[2 * DH + gc], cw3 = F.conv_w[3 * DH + gc], cb = F.conv_b[gc];
        float xc[32];
#pragma unroll
        for (int t = 0; t < 32; ++t) xc[t] = ((cw0 * xin[t] + cw1 * xin[t + 1]) + (cw2 * xin[t + 2] + cw3 * xin[t + 3])) + cb;
        LAS unsigned short* w16 = (LAS unsigned short*)wl;
#pragma unroll
        for (int t = 0; t < 32; ++t) w16[t * 64 + lane] = (unsigned short)f2bf(xc[t]);
        LDS_WAIT(); asm volatile("" ::: "memory");
        const int tok = lane & 31, hh = lane >> 5;
        bf16x8 af[4];
#pragma unroll
        for (int s = 0; s < 4; ++s) af[s] = *(const LAS bf16x8*)(wl + (tok * 64 + 16 * s + 8 * hh) * 2);
        f32x16 ga[2], gx[2];
#pragma unroll
        for (int nt = 0; nt < 2; ++nt) { ga[nt] = f32x16{}; gx[nt] = f32x16{};
            const size_t wo = ((size_t)(n * 64 + tok + 32 * nt)) * 64 + 8 * hh;
#pragma unroll
            for (int s = 0; s < 4; ++s) { const bf16x8 ba = *(const GAS bf16x8*)(F.Wa_t + wo + 16 * s), bx = *(const GAS bf16x8*)(F.Wx_t + wo + 16 * s);
                ga[nt] = __builtin_amdgcn_mfma_f32_32x32x16_bf16(af[s], ba, ga[nt], 0, 0, 0); gx[nt] = __builtin_amdgcn_mfma_f32_32x32x16_bf16(af[s], bx, gx[nt], 0, 0, 0); } }
        LDS_WAIT(); asm volatile("" ::: "memory");
        LAS float* wf = (LAS float*)wl;
#pragma unroll
        for (int nt = 0; nt < 2; ++nt)
#pragma unroll
            for (int rr = 0; rr < 16; ++rr) { const int tr = crow(rr, hh); wf[tr * 64 + tok + 32 * nt] = ga[nt][rr]; wf[2048 + tr * 64 + tok + 32 * nt] = gx[nt][rr]; }
        LDS_WAIT(); asm volatile("" ::: "memory");
        const float ba_ = F.b_rg_a[gc], bx_ = F.b_rg_x[gc], spc = log1pf(expf(-F.lam[gc]));
        float av[32], uv[32];
#pragma unroll
        for (int t = 0; t < 32; ++t) { const float pa = wf[t * 64 + lane] + ba_, px = wf[2048 + t * 64 + lane] + bx_;
            const float rg = 1.0f / (1.0f + expf(-pa)), ig = 1.0f / (1.0f + expf(-px)); const float la = -8.0f * rg * spc;
            av[t] = expf(la); uv[t] = sqrtf(-expm1f(2.0f * la)) * (ig * xc[t]); }
        LDS_WAIT(); asm volatile("" ::: "memory");
        float h = 0.f, P = 1.f;
#pragma unroll
        for (int t = 0; t < 32; ++t) { h = av[t] * h + uv[t]; P *= av[t]; }
        summ[(w * 64 + lane) * 2] = P; summ[(w * 64 + lane) * 2 + 1] = h;
        LDS_WAIT(); __syncthreads();
        if (!FINAL) {
            if (w == 0) { float Pt = 1.f, Ht = 0.f;
#pragma unroll
                for (int q = 0; q < 8; ++q) { const float p = summ[(q * 64 + lane) * 2], hq = summ[(q * 64 + lane) * 2 + 1]; Ht = p * Ht + hq; Pt *= p; }
                float* o = F.rsum + ((size_t)(b * 16 + sp) * DH + gc) * 2; o[0] = Pt; o[1] = Ht; }
        } else {
            float hc = 0.f;
            for (int q = 0; q < sp; ++q) { const float* o = F.rsum + ((size_t)(b * 16 + q) * DH + gc) * 2; hc = o[0] * hc + o[1]; }
            for (int q = 0; q < w; ++q) hc = summ[(q * 64 + lane) * 2] * hc + summ[(q * 64 + lane) * 2 + 1];
            h = hc;
            const bf16* grp = F.GR + ((size_t)b * SEQ + t0) * DH + gc; bf16* op = F.MIX + ((size_t)b * SEQ + t0) * DM + DH + gc;
            float gv[32];
#pragma unroll
            for (int t = 0; t < 32; ++t) gv[t] = bf2f(grp[(size_t)t * DH]);
#pragma unroll
            for (int t = 0; t < 32; ++t) { h = av[t] * h + uv[t]; const float g = gv[t]; const float y = 0.7978845608028654f * (g + 0.044715f * g * g * g);
                const float th = 1.0f - 2.0f / (1.0f + expf(2.0f * y)); op[(size_t)t * DM] = (bf16)f2bf(h * (0.5f * g * (1.0f + th))); }
        }
        LDS_WAIT(); __syncthreads();
    }
}
__device__ __forceinline__ void attn_items(Frame& F) {
    LAS unsigned char* wl = F.lds + RING_OFF + F.wave * 16384;
    const int lane = F.lane, c = lane & 31, hh = lane >> 5;
    const int gw = F.vcu * NWAVES + F.wave, NGW = F.G * NWAVES;
    const float NEG = -1e30f;
    const int gi = lane >> 4, li = lane & 15;
    const int tr_base = (4 * hh + (li >> 2)) * 192 + (16 * (gi & 1) + 4 * (li & 3)) * 2;
    for (int item = gw; item < 3 * NB * NHEAD * 128; item += NGW) {
        const int p = item >> 12; int rem = item & 4095; const int b = rem >> 10; rem &= 1023; const int h = rem >> 7, qt = rem & 127;
        const int dsh = 2 * p, tps = 128 >> dsh;
        const int r = qt / tps, l0 = (qt % tps) * 32;
        const size_t hb = ((size_t)b * SEQ) * DH + h * HD;
        const int tq = ((l0 + c) << dsh) + r;
        bf16x8 qf[4];
#pragma unroll
        for (int s = 0; s < 4; ++s) qf[s] = *(const GAS bf16x8*)(F.QB + hb + (size_t)tq * DH + 16 * s + 8 * hh);
        float m = NEG, l = 0.f; f32x16 o0 = f32x16{}, o1 = f32x16{};
        for (int j = 0; j < 5; ++j) {
            const int kt0 = l0 - 128 + 32 * j; if (kt0 < 0) continue;
            const int tk = ((kt0 + c) << dsh) + r;
            bf16x8 kf[4];
#pragma unroll
            for (int s = 0; s < 4; ++s) kf[s] = *(const GAS bf16x8*)(F.KB + hb + (size_t)tk * DH + 16 * s + 8 * hh);
            v4u vv[4];
#pragma unroll
            for (int i = 0; i < 4; ++i) { const int key = (lane >> 3) + 8 * i; const int tv = ((kt0 + key) << dsh) + r; vv[i] = *(const GAS v4u*)(F.VB + hb + (size_t)tv * DH + (lane & 7) * 8); }
            f32x16 sc = f32x16{};
#pragma unroll
            for (int s = 0; s < 4; ++s) sc = __builtin_amdgcn_mfma_f32_32x32x16_bf16(kf[s], qf[s], sc, 0, 0, 0);
            if (j == 0) {
#pragma unroll
                for (int rr = 0; rr < 16; ++rr) if (crow(rr, hh) < c) sc[rr] = NEG;
            }
            if (j == 4) {
#pragma unroll
                for (int rr = 0; rr < 16; ++rr) if (crow(rr, hh) > c) sc[rr] = NEG;
            }
            float mx = sc[0];
#pragma unroll
            for (int rr = 1; rr < 16; ++rr) mx = fmaxf(mx, sc[rr]);
            mx = fmaxf(mx, __shfl_xor(mx, 32));
            const float mn = fmaxf(m, mx), alpha = __builtin_amdgcn_exp2f(m - mn); m = mn;
            float ps = 0.f;
#pragma unroll
            for (int rr = 0; rr < 16; ++rr) { sc[rr] = __builtin_amdgcn_exp2f(sc[rr] - mn); ps += sc[rr]; }
            l = l * alpha + ps;
#pragma unroll
            for (int rr = 0; rr < 16; ++rr) { o0[rr] *= alpha; o1[rr] *= alpha; }
            v4u pb0, pb1;
            pb0.x = pk2(sc[0], sc[1]); pb0.y = pk2(sc[2], sc[3]); pb0.z = pk2(sc[4], sc[5]); pb0.w = pk2(sc[6], sc[7]);
            pb1.x = pk2(sc[8], sc[9]); pb1.y = pk2(sc[10], sc[11]); pb1.z = pk2(sc[12], sc[13]); pb1.w = pk2(sc[14], sc[15]);
#pragma unroll
            for (int i = 0; i < 4; ++i) { const int key = (lane >> 3) + 8 * i; *(LAS v4u*)(wl + key * 192 + (lane & 7) * 16) = vv[i]; }
            LDS_WAIT(); asm volatile("" ::: "memory");
#pragma unroll
            for (int dt = 0; dt < 2; ++dt)
#pragma unroll
                for (int s = 0; s < 2; ++s) {
                    const v4i16_t lo = __builtin_amdgcn_ds_read_tr16_b64_v4i16((LAS v4i16_t*)(wl + tr_base + (16 * s) * 192 + 64 * dt));
                    const v4i16_t hi = __builtin_amdgcn_ds_read_tr16_b64_v4i16((LAS v4i16_t*)(wl + tr_base + (16 * s + 8) * 192 + 64 * dt));
                    const bf16x8 af = (bf16x8){lo[0], lo[1], lo[2], lo[3], hi[0], hi[1], hi[2], hi[3]};
                    const bf16x8 pf = __builtin_bit_cast(bf16x8, s ? pb1 : pb0);
                    if (dt == 0) o0 = __builtin_amdgcn_mfma_f32_32x32x16_bf16(af, pf, o0, 0, 0, 0); else o1 = __builtin_amdgcn_mfma_f32_32x32x16_bf16(af, pf, o1, 0, 0, 0);
                }
            LDS_WAIT(); asm volatile("" ::: "memory");
        }
        l += __shfl_xor(l, 32);
        const float inv = 1.0f / l;
        bf16* op = F.OP + ((size_t)p * TT + (size_t)b * SEQ + tq) * DH + h * HD;
#pragma unroll
        for (int g4 = 0; g4 < 4; ++g4) {
            v2u w0, w1; w0.x = pk2(o0[4 * g4] * inv, o0[4 * g4 + 1] * inv); w0.y = pk2(o0[4 * g4 + 2] * inv, o0[4 * g4 + 3] * inv);
            w1.x = pk2(o1[4 * g4] * inv, o1[4 * g4 + 1] * inv); w1.y = pk2(o1[4 * g4 + 2] * inv, o1[4 * g4 + 3] * inv);
            *(GAS v2u*)(op + 8 * g4 + 4 * hh) = w0; *(GAS v2u*)(op + 32 + 8 * g4 + 4 * hh) = w1; }
        if (hh == 0) F.LSE[((size_t)p * TT + (size_t)b * SEQ + tq) * NHEAD + h] = m + __builtin_amdgcn_logf(l);
    }
}
__device__ __forceinline__ void attn_merge(Frame& F) {
    const int gt = F.vcu * (NWAVES * 64) + F.tid, NGT = F.G * NWAVES * 64;
    for (int idx = gt; idx < TT * 64; idx += NGT) {
        const int t = idx >> 6, ch = idx & 63, h = ch >> 3;
        const float l0 = F.LSE[(size_t)t * NHEAD + h], l1 = F.LSE[((size_t)TT + t) * NHEAD + h], l2 = F.LSE[((size_t)2 * TT + t) * NHEAD + h];
        const float mx = fmaxf(l0, fmaxf(l1, l2));
        float w0 = __builtin_amdgcn_exp2f(l0 - mx), w1 = __builtin_amdgcn_exp2f(l1 - mx), w2 = __builtin_amdgcn_exp2f(l2 - mx);
        const float inv = 1.0f / (w0 + w1 + w2); w0 *= inv; w1 *= inv; w2 *= inv;
        const v4u a = *(const GAS v4u*)(F.OP + (size_t)t * DH + ch * 8), bq = *(const GAS v4u*)(F.OP + ((size_t)TT + t) * DH + ch * 8), cq = *(const GAS v4u*)(F.OP + ((size_t)2 * TT + t) * DH + ch * 8);
        v4u o;
#pragma unroll
        for (int k = 0; k < 4; ++k) {
            const float lo = w0 * bf2f((unsigned short)(a[k] & 0xffffu)) + w1 * bf2f((unsigned short)(bq[k] & 0xffffu)) + w2 * bf2f((unsigned short)(cq[k] & 0xffffu));
            const float hi = w0 * bf2f((unsigned short)(a[k] >> 16)) + w1 * bf2f((unsigned short)(bq[k] >> 16)) + w2 * bf2f((unsigned short)(cq[k] >> 16));
            o[k] = pk2(lo, hi); }
        *(GAS v4u*)(F.MIX + (size_t)t * DM + ch * 8) = o;
    }
}

__device__ __forceinline__ void p6_rows(Frame& F) {
    LAS float* wl = (LAS float*)(F.lds + RING_OFF);
    for (int i = F.tid; i < NEXP * DM / 4; i += NWAVES * 64) ((LAS f32x4*)wl)[i] = ((const GAS f32x4*)F.wr_t)[i];
    LDS_WAIT(); __syncthreads();
    const int gw = F.vcu * NWAVES + F.wave, NGW = F.G * NWAVES, lane = F.lane;
    for (int m = gw; m < TT; m += NGW) {
        const int b = m / SEQ;
        const GAS f32x4* xr = (const GAS f32x4*)(F.X1 + (size_t)m * DM) + lane;
        f32x4 v[4]; float ss = 0.f;
#pragma unroll
        for (int j = 0; j < 4; ++j) { v[j] = xr[64 * j]; ss += (v[j].x * v[j].x + v[j].y * v[j].y) + (v[j].z * v[j].z + v[j].w * v[j].w); }
        const float rstd = 1.0f / sqrtf(wave_sum(ss) * (1.0f / DM) + NORM_EPS);
        const float* mb = F.mod + (size_t)b * NMOD;
#pragma unroll
        for (int j = 0; j < 4; ++j) { const int col = 4 * lane + 256 * j;
            const f32x4 g = *(const f32x4*)(F.g_ffn + col), sc = *(const f32x4*)(mb + 4 * DM + col), sh = *(const f32x4*)(mb + 3 * DM + col);
            v[j] = (v[j] * rstd) * g * (sc + 1.0f) + sh;
            v2u o; o.x = pk2(v[j].x, v[j].y); o.y = pk2(v[j].z, v[j].w); *(GAS v2u*)(F.XN + (size_t)m * DM + col) = o; }
        float p[32];
#pragma unroll
        for (int e = 0; e < 32; ++e) { float a = 0.f;
#pragma unroll
            for (int j = 0; j < 4; ++j) { const f32x4 w4 = *(const LAS f32x4*)(wl + e * DM + 4 * lane + 256 * j); a += (v[j].x * w4.x + v[j].y * w4.y) + (v[j].z * w4.z + v[j].w * w4.w); }
            p[e] = a; if ((e & 3) == 3) asm volatile("" ::: "memory"); }
        float k16[16], k8[8], k4[4], k2[2], k1;
        { const bool up = (lane & 32) != 0;
#pragma unroll
          for (int i = 0; i < 16; ++i) { const float keep = up ? p[16 + i] : p[i], send = up ? p[i] : p[16 + i]; k16[i] = keep + __shfl_xor(send, 32); } }
        { const bool up = (lane & 16) != 0;
#pragma unroll
          for (int i = 0; i < 8; ++i) { const float keep = up ? k16[8 + i] : k16[i], send = up ? k16[i] : k16[8 + i]; k8[i] = keep + __shfl_xor(send, 16); } }
        { const bool up = (lane & 8) != 0;
#pragma unroll
          for (int i = 0; i < 4; ++i) { const float keep = up ? k8[4 + i] : k8[i], send = up ? k8[i] : k8[4 + i]; k4[i] = keep + __shfl_xor(send, 8); } }
        { const bool up = (lane & 4) != 0;
#pragma unroll
          for (int i = 0; i < 2; ++i) { const float keep = up ? k4[2 + i] : k4[i], send = up ? k4[i] : k4[2 + i]; k2[i] = keep + __shfl_xor(send, 4); } }
        { const bool up = (lane & 2) != 0; const float keep = up ? k2[1] : k2[0], send = up ? k2[0] : k2[1]; k1 = keep + __shfl_xor(send, 2); }
        k1 += __shfl_xor(k1, 1);
        float val = k1 + F.b_router[lane >> 1];
        float tv[4]; int te[4];
#pragma unroll
        for (int r = 0; r < 4; ++r) { const float mx = wave_max(val); const unsigned long long bal = __ballot(val == mx); const int src = __ffsll((long long)bal) - 1;
            te[r] = src >> 1; tv[r] = mx; if ((lane >> 1) == te[r]) val = -INFINITY; }
        const float e1 = expf(tv[1] - tv[0]), e2 = expf(tv[2] - tv[0]), e3 = expf(tv[3] - tv[0]); const float inv = 1.0f / (1.0f + e1 + e2 + e3);
        if (lane < 4) { const int e = lane == 0 ? te[0] : lane == 1 ? te[1] : lane == 2 ? te[2] : te[3];
            const float g = (lane == 0 ? 1.0f : lane == 1 ? e1 : lane == 2 ? e2 : e3) * inv;
            const int pos = atomicAdd(F.cnt + e, 1);
            F.tok_e[m * 4 + lane] = e; F.tok_pos[m * 4 + lane] = pos; F.tok_gate[m * 4 + lane] = g; }
    }
}
__device__ __forceinline__ void p7_gather(Frame& F) {
    volatile LAS int* lb = (volatile LAS int*)(F.lds + TILE_OFF);
    if (F.tid == 0) { int acc = 0, nt = 0;
        for (int e = 0; e < NEXP; ++e) { const int c = F.cnt[e]; lb[e] = acc; lb[64 + e] = c; const int tiles = (c + 255) >> 8;
            if (blockIdx.x == 0) for (int k = 0; k < tiles; ++k) F.tile_e[nt + k] = e;
            nt += tiles; acc += tiles * 256; }
        lb[32] = acc; if (blockIdx.x == 0) F.tile_n[0] = nt; }
    LDS_WAIT(); __syncthreads();
    const int gw = F.vcu * NWAVES + F.wave, NGW = F.G * NWAVES, lane = F.lane;
    for (int idx = gw; idx < TT * TOPK + NEXP * 256; idx += NGW) {
        if (idx < TT * TOPK) { const int e = F.tok_e[idx], pos = F.tok_pos[idx]; const int slot = lb[e] + pos; if (lane == 0) F.tok_slot[idx] = slot;
            const GAS v4u* s = (const GAS v4u*)(F.XN + (size_t)(idx >> 2) * DM) + lane; GAS v4u* d = (GAS v4u*)(F.XG + (size_t)slot * DM) + lane;
            const v4u a = s[0], bq = s[64]; d[0] = a; d[64] = bq;
        } else { const int q = idx - TT * TOPK, e = q >> 8, i = q & 255; const int c = lb[64 + e]; const int padded = ((c + 255) >> 8) << 8;
            if (c + i < padded) { GAS v4u* d = (GAS v4u*)(F.XG + (size_t)(lb[e] + c + i) * DM) + lane; const v4u z = (v4u){0u, 0u, 0u, 0u}; d[0] = z; d[64] = z; } }
    }
}
__device__ __forceinline__ void p10_final(Frame& F) {
    const int gw = F.vcu * NWAVES + F.wave, NGW = F.G * NWAVES, lane = F.lane;
    const bf16* Y2 = F.XG;
    for (int m = gw; m < TT; m += NGW) {
        const int b = m / SEQ;
        const GAS f32x4* xr = (const GAS f32x4*)(F.X1 + (size_t)m * DM) + lane;
        f32x4 v[4], a[4];
#pragma unroll
        for (int j = 0; j < 4; ++j) { v[j] = xr[64 * j]; a[j] = (f32x4){0.f, 0.f, 0.f, 0.f}; }
#pragma unroll
        for (int k = 0; k < 4; ++k) { const int slot = F.tok_slot[m * 4 + k]; const float g = F.tok_gate[m * 4 + k];
            const GAS v2u* yr = (const GAS v2u*)(Y2 + (size_t)slot * DM) + lane;
#pragma unroll
            for (int j = 0; j < 4; ++j) { const v2u y = yr[64 * j];
                a[j].x += g * bf2f((unsigned short)(y.x & 0xffffu)); a[j].y += g * bf2f((unsigned short)(y.x >> 16)); a[j].z += g * bf2f((unsigned short)(y.y & 0xffffu)); a[j].w += g * bf2f((unsigned short)(y.y >> 16)); } }
        const float* gf = F.mod + (size_t)b * NMOD + 5 * DM; float ss = 0.f;
#pragma unroll
        for (int j = 0; j < 4; ++j) { const f32x4 gt = *(const f32x4*)(gf + 4 * lane + 256 * j); v[j] = v[j] + gt * a[j]; ss += (v[j].x * v[j].x + v[j].y * v[j].y) + (v[j].z * v[j].z + v[j].w * v[j].w); }
        const float rstd = 1.0f / sqrtf(wave_sum(ss) * (1.0f / DM) + NORM_EPS);
        GAS f32x4* orow = (GAS f32x4*)(F.out + (size_t)m * DM) + lane;
#pragma unroll
        for (int j = 0; j < 4; ++j) { const f32x4 g = *(const f32x4*)(F.g_final + 4 * lane + 256 * j); orow[64 * j] = (v[j] * rstd) * g; }
    }
}

struct Args { const float* in[22]; float* out; unsigned char* ws; int ph_lo, ph_hi, li, pad; };
__global__ void __launch_bounds__(NWAVES * 64, 2) hymba_fwd(Args args) {
    extern __shared__ __attribute__((aligned(16))) unsigned char lds[];
    Frame F;
    F.lds = (LAS unsigned char*)lds;
    F.MISC = (volatile LAS unsigned*)(F.lds + MISC_OFF);
    F.tid = threadIdx.x; F.lane = F.tid & 63; F.wave = __builtin_amdgcn_readfirstlane(F.tid >> 6);
    F.G = gridDim.x; { const int bx = blockIdx.x; F.vcu = (F.G % 8 == 0) ? (bx % 8) * (F.G / 8) + bx / 8 : bx; }
    unsigned char* ws = args.ws;
    F.ctl = (gu32*)(ws + WS_CTL);
    F.x = args.in[0]; F.c = args.in[1]; F.w_ada = args.in[2]; F.b_ada = args.in[3]; F.g_mix = args.in[4]; F.w_in = args.in[5]; F.conv_w = args.in[6]; F.conv_b = args.in[7];
    F.w_rg_a = args.in[8]; F.b_rg_a = args.in[9]; F.w_rg_x = args.in[10]; F.b_rg_x = args.in[11]; F.lam = args.in[12]; F.w_out = args.in[13]; F.g_ffn = args.in[14];
    F.w_router = args.in[15]; F.b_router = args.in[16]; F.w_gate_up = args.in[17]; F.b_gate_up = args.in[18]; F.w_down = args.in[19]; F.b_down = args.in[20]; F.g_final = args.in[21];
    F.out = args.out;
    F.mod = (float*)(ws + WS_CTL) + CW_MOD; F.cnt = (int*)(ws + WS_CTL) + CW_CNT; F.modp = (float*)(ws + WS_MODP); F.modc = (int*)(ws + WS_CTL) + CW_MODC;
    F.tile_e = (int*)(ws + WS_MISC); F.tile_n = (int*)(ws + WS_MISC + 4096); F.rsum = (float*)(ws + WS_MISC + 65536);
    F.wr_t = (float*)(ws + WS_WRT); F.Wa_t = (bf16*)(ws + WS_WRT + 262144); F.Wx_t = (bf16*)(ws + WS_WRT + 393216);
    F.Win_t = (bf16*)(ws + WS_WIN); F.Wout_t = (bf16*)(ws + WS_WOUT); F.Wgu_t = (bf16*)(ws + WS_WGU); F.Wd_t = (bf16*)(ws + WS_WD);
    F.XN = (bf16*)(ws + WS_XN); F.QB = (bf16*)(ws + WS_QKV); F.KB = F.QB + (size_t)TT * DH; F.VB = F.KB + (size_t)TT * DH; F.XR = F.VB + (size_t)TT * DH; F.GR = F.XR + (size_t)TT * DH;
    F.OP = (bf16*)(ws + WS_OP); F.LSE = (float*)(ws + WS_LSE); F.MIX = (bf16*)(ws + WS_MIX); F.X1 = (float*)(ws + WS_X1);
    F.tok_e = (int*)(ws + WS_ROUTE); F.tok_pos = F.tok_e + TT * TOPK; F.tok_gate = (float*)(F.tok_pos + TT * TOPK); F.tok_slot = (int*)(F.tok_gate + TT * TOPK);
    F.XG = (bf16*)(ws + WS_XG); F.ACT = (bf16*)(ws + WS_ACT);
    for (int u = F.tid; u < (LDS_BYTES - LDSCTL_OFF) / 4; u += NWAVES * 64) ((LAS unsigned*)(F.lds + LDSCTL_OFF))[u] = 0u;
    __syncthreads();
    XcdBarrier bar; bar.bar = (unsigned*)(F.ctl + CW_BAR); bar.x = 0; bar.st = nullptr;
    if (N_LAUNCHES != PER_PHASE) bar = xcd_barrier_post((unsigned*)(F.ctl + CW_BAR), F.MISC + 8);
#define GRID_BAR(seam) do { if (N_LAUNCHES == PER_PHASE) { if (F.tid == 0) __hip_atomic_store(F.ctl + CW_TMO, 0xBADBA0u | (unsigned)(seam), RLX_AGENT); } else { xcd_barrier(bar); } } while (0)
    const int lo = args.ph_lo, hi = args.ph_hi;
#ifndef PHASE_MASK
#define PHASE_MASK 0x7ff
#endif
#define IN(k) (((PHASE_MASK >> (k)) & 1) && lo <= (k) && (k) < hi)
#define BOTH(k) (IN(k) && IN((k) + 1))
    if (IN(0)) { p0_prologue(F); if (BOTH(0)) GRID_BAR(0); }
    if (IN(1)) { p1_norm(F); if (BOTH(1)) GRID_BAR(1); }
    if (IN(2)) {
        pg8::Gemm g{F.XN, F.Win_t, TT, INCOLS, DM}; pg8::StaticOrder S; S.init(TT, INCOLS, F.G, (int)blockIdx.x);
        pg8::EpiBf16<0> E{F.QB, DH, nullptr, DH, (size_t)TT * DH, C2};
        pg8::gemm_phase<pg8::EpiBf16<0>, pg8::StaticOrder, true, true>(F.lds + RING_OFF, g, S, E);
        if (BOTH(2)) GRID_BAR(2);
    }
    if (IN(3)) { rglru_items<false>(F); attn_items(F); if (BOTH(3)) GRID_BAR(3); }
    if (IN(4)) { rglru_items<true>(F); attn_merge(F); if (BOTH(4)) GRID_BAR(4); }
    if (IN(5)) {
        pg8::Gemm g{F.MIX, F.Wout_t, TT, DM, DM}; pg8::StaticOrder S; S.init(TT, DM, F.G, (int)blockIdx.x);
        pg8::EpiResGate E{F.x, F.X1, DM, F.mod + 2 * DM, NMOD, SEQ};
        pg8::gemm_phase<pg8::EpiResGate, pg8::StaticOrder, true, true>(F.lds + RING_OFF, g, S, E);
        if (BOTH(5)) GRID_BAR(5);
    }
    if (IN(6)) { p6_rows(F); if (BOTH(6)) GRID_BAR(6); }
    if (IN(7)) { p7_gather(F); if (BOTH(7)) GRID_BAR(7); }
    if (IN(8)) {
        const int ntm = F.tile_n[0];
        pg8::Gemm g{F.XG, F.Wgu_t, ntm * 256, DE2, DM}; pg8::GroupedOrder S; S.init(F.tile_e, ntm, 8, F.G, (int)blockIdx.x);
        pg8::EpiSwiglu E{F.ACT, F.b_gate_up};
        pg8::gemm_phase<pg8::EpiSwiglu, pg8::GroupedOrder, true, true>(F.lds + RING_OFF, g, S, E);
        if (BOTH(8)) GRID_BAR(8);
    }
    if (IN(9)) {
        const int ntm = F.tile_n[0];
        pg8::Gemm g{F.ACT, F.Wd_t, ntm * 256, DM, DM}; pg8::GroupedOrder S; S.init(F.tile_e, ntm, 4, F.G, (int)blockIdx.x);
        pg8::EpiBf16<0> E{F.XG, DM, F.b_down, DM, 0, 1.0f};
        pg8::gemm_phase<pg8::EpiBf16<0>, pg8::GroupedOrder, true, true>(F.lds + RING_OFF, g, S, E);
        if (BOTH(9)) GRID_BAR(9);
    }
    if (IN(10)) { p10_final(F); }
#undef IN
#undef BOTH
}

extern "C" void kernel_launch(void* const* d_in, const int* in_sizes, int n_in, void* d_out, int out_size, void* d_ws, size_t ws_size, hipStream_t stream) {
    static int grid = 0;
    if (grid == 0) {
        if (n_in != 22 || in_sizes[0] != TT * DM || out_size != TT * DM || ws_size < WS_END) { fprintf(stderr, "kernel_launch: unexpected shapes (n_in %d, in0 %d, out %d, ws %zu); nothing launched\n", n_in, n_in > 0 ? in_sizes[0] : -1, out_size, ws_size); grid = -1; return; }
        int dev = 0, cus = 0, per_cu = 0;
        if (hipGetDevice(&dev) != hipSuccess || hipDeviceGetAttribute(&cus, hipDeviceAttributeMultiprocessorCount, dev) != hipSuccess) { fprintf(stderr, "kernel_launch: device query failed\n"); grid = -1; return; }
        if (hipFuncSetAttribute((const void*)hymba_fwd, hipFuncAttributeMaxDynamicSharedMemorySize, LDS_BYTES) != hipSuccess) { fprintf(stderr, "kernel_launch: hipFuncSetAttribute failed\n"); grid = -1; return; }
        if (hipOccupancyMaxActiveBlocksPerMultiprocessor(&per_cu, (const void*)hymba_fwd, NWAVES * 64, LDS_BYTES) != hipSuccess || per_cu < 1) { fprintf(stderr, "kernel_launch: occupancy query reports %d workgroups per CU\n", per_cu); per_cu = 1; }
        (void)hipGetLastError();
        grid = cus;
    }
    if (grid < 0) return;
    if (hipMemsetAsync((char*)d_ws + WS_CTL, 0, CTL_ZERO_BYTES, stream) != hipSuccess) { fprintf(stderr, "kernel_launch: memset failed\n"); return; }
    Args a{};
    for (int i = 0; i < 22; ++i) a.in[i] = (const float*)d_in[i];
    a.out = (float*)d_out; a.ws = (unsigned char*)d_ws;
    for (int li = 0; li < N_LAUNCHES; ++li) {
        a.ph_lo = (N_LAUNCHES == PER_PHASE) ? li : 0; a.ph_hi = (N_LAUNCHES == PER_PHASE) ? li + 1 : PER_PHASE; a.li = li;
        hipLaunchKernelGGL(hymba_fwd, dim3(grid), dim3(NWAVES * 64), LDS_BYTES, stream, a);
        const hipError_t le = hipPeekAtLastError();
        if (le != hipSuccess) { fprintf(stderr, "kernel_launch: launch %d failed: %s\n", li, hipGetErrorName(le)); break; }
    }
}
```

```cpp
#include <hip/hip_runtime.h>
#include <cstdio>
#include <cstdint>
#define MK_N_LAUNCHES 1
#define DUP_MASK 0
namespace pg8 {
#define PG8_LAS __attribute__((address_space(3)))
typedef unsigned short bf16_t;
typedef short bf16x8 __attribute__((ext_vector_type(8)));
typedef float f32x4 __attribute__((ext_vector_type(4)));
typedef unsigned u32x4 __attribute__((ext_vector_type(4)));
constexpr int BM = 256, BK = 64, HALF = 128, HTB = HALF * BK * 2  , STAGE_BYTES = 8 * HTB, NXCD = 8, WGM = 8;

__host__ __device__ __forceinline__ int lds_byte(int r, int c) { const int st = (r >> 4) * 2 + (c >> 5), rr = r & 15, cc = c & 31, ob = rr * 64 + cc * 2; return st * 1024 + (ob ^ (((ob >> 9) & 1) << 5)); }
__host__ __device__ __forceinline__ void stage_rc(int b, int& R, int& C) { const int st = b / 1024, sb = b % 1024, swz = sb ^ (((sb >> 9) & 1) << 5); R = (st >> 1) * 16 + swz / 64; C = (st & 1) * 32 + (swz % 64) / 2; }
__host__ __device__ __forceinline__ int perm32(int rho) { const int n = rho >> 4, i = rho & 15; return 8 * (i >> 2) + 4 * n + (i & 3); }

struct Unit { int pm, pn; };
struct Gemm { const bf16_t* A; const bf16_t* Bt; int M, N, K; };

struct StaticOrder {
    int nM, nN, nwg, G, c;
    __host__ __device__ void init(int M, int N, int G_, int c_) { nM = M / BM; nN = N / BM; nwg = nM * nN; G = G_; c = c_; }
    __host__ __device__ bool next(int i, Unit& u) const {
        const long L = (long)i * G + c; if (L >= nwg) return false;
        int wgid = (int)L; { const int q = nwg / NXCD, r = nwg % NXCD, xcd = wgid % NXCD, off = wgid / NXCD; wgid = (xcd < r ? xcd * (q + 1) : r * (q + 1) + (xcd - r) * q) + off; }
        const int nig = WGM * nN, gid = wgid / nig, fm = gid * WGM, gsz = (nM - fm) < WGM ? (nM - fm) : WGM;
        u.pm = fm + ((wgid % nig) % gsz); u.pn = (wgid % nig) / gsz; return true;
    }
    __device__ __forceinline__ void a_ready(const Unit&) const {}
    __device__ __forceinline__ void done(const Unit&) const {}
};

typedef float cvtf32x2_t __attribute__((ext_vector_type(2))); typedef __bf16 cvtbf16x2_t __attribute__((ext_vector_type(2)));
__device__ __forceinline__ unsigned cvt_pk_bf16(float lo, float hi) { const cvtf32x2_t v = {lo, hi}; return __builtin_bit_cast(unsigned, __builtin_convertvector(v, cvtbf16x2_t)); }
typedef float f32x2 __attribute__((ext_vector_type(2)));
__device__ __forceinline__ f32x2 gelu_pk(f32x2 v) {
    const f32x2 av = __builtin_elementwise_abs(v), d = av * 0.2316418882f + 1.0f;
    f32x2 t; t.x = __builtin_amdgcn_rcpf(d.x); t.y = __builtin_amdgcn_rcpf(d.y);
    f32x2 q = t * 0.5307027145f + (-0.7265760135f); q = q * t + 0.7107068705f; q = q * t + (-0.142248368f); q = q * t + 0.127414796f; q = q * t;
    const f32x2 s = (v * v) * (-0.72134752044f);
    f32x2 e; e.x = __builtin_amdgcn_exp2f(s.x); e.y = __builtin_amdgcn_exp2f(s.y);
    const f32x2 m = v * (q * e), r = v - m;
    f32x2 o; o.x = v.x < 0.f ? m.x : r.x; o.y = v.y < 0.f ? m.y : r.y; return o;
}

template <int ACT  > struct EpiBf16 {
    static constexpr bool PERM = true, AFTER_DRAIN = false; static_assert(ACT == 0 || ACT == 1, "EpiBf16: ACT is 0 (none) or 1 (gelu_pk)");
    bf16_t* O; int ldc; const float* bias; int split_cols; size_t split_stride; float scale0;
    __device__ __forceinline__ void operator()(const f32x4 (&acc)[2][2][4][2], const Unit& u, int wr, int wc, int fr, int fq) const {
        const int row0 = u.pm * BM + wr * 64 + fr; int colt = u.pn * BM; bf16_t* base = O;
        float sc = 1.f; if (split_cols) { const int t = colt / split_cols; base += (size_t)t * split_stride; colt -= t * split_cols; if (t == 0) sc = scale0; }
        const int col0 = colt + wc * 32 + 8 * fq, bcol0 = u.pn * BM + wc * 32 + 8 * fq;
        f32x4 bv[2][2];
#pragma unroll
        for (int bj = 0; bj < 2; ++bj)
#pragma unroll
            for (int n = 0; n < 2; ++n) bv[bj][n] = bias ? *(const f32x4*)(bias + bcol0 + bj * HALF + 4 * n) : (f32x4){0.f, 0.f, 0.f, 0.f};
#pragma unroll
        for (int ai = 0; ai < 2; ++ai)
#pragma unroll
            for (int m = 0; m < 4; ++m) { bf16_t* rowp = base + (size_t)(row0 + ai * HALF + m * 16) * ldc + col0;
#pragma unroll
                for (int bj = 0; bj < 2; ++bj) { f32x4 v0 = acc[ai][bj][m][0] + bv[bj][0], v1 = acc[ai][bj][m][1] + bv[bj][1];
                    if (ACT == 1) { f32x2 a = gelu_pk((f32x2){v0[0], v0[1]}), b = gelu_pk((f32x2){v0[2], v0[3]}), c = gelu_pk((f32x2){v1[0], v1[1]}), d = gelu_pk((f32x2){v1[2], v1[3]});
                        v0 = (f32x4){a.x, a.y, b.x, b.y}; v1 = (f32x4){c.x, c.y, d.x, d.y}; }
                    v0 = v0 * sc; v1 = v1 * sc; u32x4 w; w.x = cvt_pk_bf16(v0[0], v0[1]); w.y = cvt_pk_bf16(v0[2], v0[3]); w.z = cvt_pk_bf16(v1[0], v1[1]); w.w = cvt_pk_bf16(v1[2], v1[3]);
                    *(u32x4*)(rowp + bj * HALF) = w; } }
    }
};
template <class Epi, class Sched, bool ALIGN_EPI = false, bool SP2 = false, bool FP8 = false, bool GATHER = false>
__device__ __forceinline__ void gemm_phase(PG8_LAS unsigned char* lds, const Gemm g, const Sched& S, const Epi& E, const PG8_LAS int* rowtab = nullptr) {
    int tid_ = threadIdx.x; asm volatile("" : "+v"(tid_));
    const int tid = tid_, wid = __builtin_amdgcn_readfirstlane(tid >> 6), lane = tid & 63, wr = wid >> 2, wc = wid & 3, fr = lane & 15, fq = lane >> 4;
    const int K = g.K, nt = K / BK;
    unsigned voffA, voffB;
    { int R, C; stage_rc(tid * 16, R, C); const int Rb = Epi::PERM ? ((R & ~31) + perm32(R & 31)) : R; voffA = (unsigned)(R * K + C) * 2u; voffB = (unsigned)(Rb * K + C) * 2u; }
    const unsigned qstep = 64u * K * 2;
    const unsigned kstep = (unsigned)(BK * 2);
    const unsigned hstep = (unsigned)HALF * K * 2;
    const unsigned tstep = 2 * hstep;
    const unsigned ldsw = (unsigned)wid * 1024u;
    const int aoff = lds_byte(wr * 64 + fr, fq * 8), boff = lds_byte(wc * 32 + fr, fq * 8);
#define PG8_SA(b, h) (((b) * 2 + (h)) * HTB)
#define PG8_SB(b, h) ((4 + (b) * 2 + (h)) * HTB)
#define PG8_STAGE(bufoff, goff, voff) do { _Pragma("unroll") for (int _i = 0; _i < 2; ++_i) \
        __builtin_amdgcn_raw_ptr_buffer_load_lds(srd_##voff, (PG8_LAS unsigned*)(lds + (bufoff) + ldsw + _i * 8192), 16, (int)(voff), (int)((goff) + _i * qstep), 0, 0); } while (0)
#define PG8_STAGE_A(bufoff, goff, VS) do { _Pragma("unroll") for (int _i = 0; _i < 2; ++_i) \
        __builtin_amdgcn_raw_ptr_buffer_load_lds(srd_voffA, (PG8_LAS unsigned*)(lds + (bufoff) + ldsw + _i * 8192), 16, GATHER ? (int)VS[((bufoff) / HTB) & 1][_i] : (int)voffA, GATHER ? (int)(goff) : (int)((goff) + _i * qstep), 0, 0); } while (0)
#define PG8_LDA(dst, b, h) do { if constexpr (FP8) { _Pragma("unroll") for (int m = 0; m < 4; ++m) { const v4i_t l_ = *(const PG8_LAS v4i_t*)(lds + PG8_SA(b, h) + aoff + m * 2048), h_ = *(const PG8_LAS v4i_t*)(lds + PG8_SA(b, h) + aoff + m * 2048 + 1024); dst##8[m] = __builtin_shufflevector(l_, h_, 0, 1, 2, 3, 4, 5, 6, 7); } } else { _Pragma("unroll") for (int m = 0; m < 4; ++m) _Pragma("unroll") for (int k = 0; k < 2; ++k) dst[m][k] = *(const PG8_LAS bf16x8*)(lds + PG8_SA(b, h) + aoff + m * 2048 + k * 1024); } } while (0)
#define PG8_LDB(dst, b, h) do { if constexpr (FP8) { _Pragma("unroll") for (int n = 0; n < 2; ++n) { const v4i_t l_ = *(const PG8_LAS v4i_t*)(lds + PG8_SB(b, h) + boff + n * 2048), h_ = *(const PG8_LAS v4i_t*)(lds + PG8_SB(b, h) + boff + n * 2048 + 1024); dst##8[n] = __builtin_shufflevector(l_, h_, 0, 1, 2, 3, 4, 5, 6, 7); } } else { _Pragma("unroll") for (int n = 0; n < 2; ++n) _Pragma("unroll") for (int k = 0; k < 2; ++k) dst[n][k] = *(const PG8_LAS bf16x8*)(lds + PG8_SB(b, h) + boff + n * 2048 + k * 1024); } } while (0)
#define PG8_MMA(ai, bj, At, Bt) do { __builtin_amdgcn_s_setprio(1); if constexpr (FP8) { _Pragma("unroll") for (int m = 0; m < 4; ++m) _Pragma("unroll") for (int n = 0; n < 2; ++n) \
        asm volatile("v_mfma_f32_16x16x128_f8f6f4 %0, %1, %2, %0" : "+v"(acc[ai][bj][m][n]) : "v"(Bt##8[n]), "v"(At##8[m])); } else { \
        _Pragma("unroll") for (int m = 0; m < 4; ++m) _Pragma("unroll") for (int n = 0; n < 2; ++n) _Pragma("unroll") for (int k = 0; k < 2; ++k) \
        acc[ai][bj][m][n] = __builtin_amdgcn_mfma_f32_16x16x32_bf16(Bt[n][k], At[m][k], acc[ai][bj][m][n], 0, 0, 0); } __builtin_amdgcn_s_setprio(0); } while (0)
#define PG8_WAIT_V(n) asm volatile("s_waitcnt vmcnt(" #n ")" ::: "memory")
#define PG8_WAIT_L(n) asm volatile("s_waitcnt lgkmcnt(" #n ")" ::: "memory")
#define PG8_BAR __builtin_amdgcn_s_barrier()
#define PG8_SCHED __builtin_amdgcn_sched_barrier(0)
    Unit cur, nxt; int ui = 0;
    if (!S.next(0, cur)) return;
    f32x4 acc[2][2][4][2];
#pragma unroll
    for (int a = 0; a < 2; ++a)
#pragma unroll
        for (int b = 0; b < 2; ++b)
#pragma unroll
            for (int m = 0; m < 4; ++m)
#pragma unroll
                for (int n = 0; n < 2; ++n) acc[a][b][m][n] = (f32x4){0.f, 0.f, 0.f, 0.f};
    typedef int v8i_t __attribute__((ext_vector_type(8))); typedef int v4i_t __attribute__((ext_vector_type(4)));
    bf16x8 At[4][2], B0[2][2], B1[2][2]; v8i_t At8[4], B08[2], B18[2];
    const __amdgpu_buffer_rsrc_t srd_voffA = __builtin_amdgcn_make_buffer_rsrc((void*)g.A, 0, 0x7ffffff0, 0x00020000), srd_voffB = __builtin_amdgcn_make_buffer_rsrc((void*)g.Bt, 0, 0x7ffffff0, 0x00020000);
    unsigned cA = GATHER ? 0u : (unsigned)cur.pm * tstep, cB = (unsigned)cur.pn * tstep;
    const unsigned hstepA = GATHER ? 0u : hstep;
    unsigned ca_[2][2] = {{0u, 0u}, {0u, 0u}}, na_[2][2] = {{0u, 0u}, {0u, 0u}}, va2_[2][2] = {{0u, 0u}, {0u, 0u}};
    int gR_ = 0, gC2_ = 0;
    if constexpr (GATHER) { int R, C; stage_rc(tid * 16, R, C); gR_ = R; gC2_ = C * 2;
#pragma unroll
        for (int h = 0; h < 2; ++h)
#pragma unroll
            for (int i = 0; i < 2; ++i) ca_[h][i] = (unsigned)rowtab[128 * h + 64 * i + R] + (unsigned)gC2_; }
    S.a_ready(cur);
    if constexpr (SP2) {
        PG8_STAGE(PG8_SB(0, 0), cB, voffB); PG8_STAGE(PG8_SB(0, 1), cB + hstep, voffB); PG8_STAGE_A(PG8_SA(0, 0), cA, ca_); PG8_STAGE_A(PG8_SA(0, 1), cA + hstepA, ca_);
        if (wr == 1) PG8_BAR;
        PG8_WAIT_V(2); PG8_BAR;
        PG8_STAGE(PG8_SB(1, 0), cB + kstep, voffB); PG8_STAGE_A(PG8_SA(1, 0), cA + kstep, ca_); PG8_STAGE(PG8_SB(1, 1), cB + hstep + kstep, voffB);
        PG8_WAIT_V(6); PG8_BAR;
    } else {
        PG8_STAGE(PG8_SB(0, 0), cB, voffB); PG8_STAGE_A(PG8_SA(0, 0), cA, ca_); PG8_STAGE(PG8_SB(0, 1), cB + hstep, voffB); PG8_STAGE_A(PG8_SA(0, 1), cA + hstepA, ca_);
        if (wr == 1) PG8_BAR;
        PG8_WAIT_V(4); PG8_BAR;
        PG8_STAGE(PG8_SB(1, 0), cB + kstep, voffB); PG8_STAGE_A(PG8_SA(1, 0), cA + kstep, ca_); PG8_STAGE(PG8_SB(1, 1), cB + hstep + kstep, voffB);
        PG8_WAIT_V(6); PG8_BAR;
    }
    for (;;) {
        const bool has_next = S.next(ui + 1, nxt);
        const unsigned nA = GATHER ? 0u : (has_next ? (unsigned)nxt.pm * tstep : cA); const unsigned nB = has_next ? (unsigned)nxt.pn * tstep : cB;
        if constexpr (GATHER) {
#pragma unroll
            for (int h = 0; h < 2; ++h)
#pragma unroll
                for (int i = 0; i < 2; ++i) na_[h][i] = has_next ? (unsigned)rowtab[(ui + 1) * 256 + 128 * h + 64 * i + gR_] + (unsigned)gC2_ : ca_[h][i]; }
#pragma nounroll
        for (int t = 0; t < nt; t += 2) {
            const bool last = (t == nt - 2);
            const unsigned a1 = cA + (unsigned)(t + 1) * kstep;
            const unsigned a2 = last ? nA : cA + (unsigned)(t + 2) * kstep; const unsigned b2 = last ? nB : cB + (unsigned)(t + 2) * kstep;
            const unsigned a3 = a2 + kstep; const unsigned b3 = b2 + kstep;
            if constexpr (GATHER) {
#pragma unroll
                for (int h = 0; h < 2; ++h)
#pragma unroll
                    for (int i = 0; i < 2; ++i) va2_[h][i] = last ? na_[h][i] : ca_[h][i]; }
            if (last && has_next) S.a_ready(nxt);
            if constexpr (SP2) {
            PG8_LDB(B0, 0, 0); PG8_LDB(B1, 0, 1); PG8_SCHED; PG8_LDA(At, 0, 0); PG8_STAGE_A(PG8_SA(1, 1), a1 + hstepA, ca_);
            PG8_WAIT_V(8); PG8_WAIT_L(0); PG8_BAR; PG8_MMA(0, 0, At, B0); PG8_MMA(0, 1, At, B1); PG8_BAR; PG8_SCHED;
            PG8_LDA(At, 0, 1); PG8_STAGE(PG8_SB(0, 0), b2, voffB); PG8_STAGE(PG8_SB(0, 1), b2 + hstep, voffB); PG8_STAGE_A(PG8_SA(0, 0), a2, va2_);
            PG8_WAIT_V(8); PG8_WAIT_L(0); PG8_BAR; PG8_MMA(1, 0, At, B0); PG8_MMA(1, 1, At, B1); PG8_BAR; PG8_SCHED;
            PG8_LDB(B0, 1, 0); PG8_LDB(B1, 1, 1); PG8_SCHED; PG8_LDA(At, 1, 0); PG8_STAGE_A(PG8_SA(0, 1), a2 + hstepA, va2_);
            PG8_WAIT_V(8); PG8_WAIT_L(0); PG8_BAR; PG8_MMA(0, 0, At, B0); PG8_MMA(0, 1, At, B1); PG8_BAR; PG8_SCHED;
            PG8_LDA(At, 1, 1); PG8_STAGE(PG8_SB(1, 0), b3, voffB); PG8_STAGE(PG8_SB(1, 1), b3 + hstep, voffB); PG8_STAGE_A(PG8_SA(1, 0), a3, va2_);
            PG8_WAIT_V(8); PG8_WAIT_L(0); PG8_BAR; PG8_MMA(1, 0, At, B0); PG8_MMA(1, 1, At, B1); PG8_BAR; PG8_SCHED;
            } else {
            PG8_LDB(B0, 0, 0); PG8_SCHED; PG8_LDA(At, 0, 0); PG8_STAGE_A(PG8_SA(1, 1), a1 + hstepA, ca_);
            PG8_WAIT_L(8); PG8_BAR; PG8_WAIT_L(0); PG8_MMA(0, 0, At, B0); PG8_BAR; PG8_SCHED;
            PG8_LDB(B1, 0, 1); PG8_STAGE(PG8_SB(0, 0), b2, voffB);
            PG8_BAR; PG8_WAIT_L(0); PG8_MMA(0, 1, At, B1); PG8_BAR;
            PG8_LDA(At, 0, 1); PG8_STAGE_A(PG8_SA(0, 0), a2, va2_);
            PG8_BAR; PG8_WAIT_L(0); PG8_MMA(1, 0, At, B0); PG8_BAR; PG8_SCHED;
            PG8_STAGE(PG8_SB(0, 1), b2 + hstep, voffB);
            PG8_WAIT_V(6); PG8_BAR; PG8_MMA(1, 1, At, B1); PG8_BAR;
            PG8_LDB(B0, 1, 0); PG8_SCHED; PG8_LDA(At, 1, 0); PG8_STAGE_A(PG8_SA(0, 1), a2 + hstepA, va2_);
            PG8_WAIT_L(8); PG8_BAR; PG8_WAIT_L(0); PG8_MMA(0, 0, At, B0); PG8_BAR; PG8_SCHED;
            PG8_LDB(B1, 1, 1); PG8_STAGE(PG8_SB(1, 0), b3, voffB);
            PG8_BAR; PG8_WAIT_L(0); PG8_MMA(0, 1, At, B1); PG8_BAR;
            PG8_LDA(At, 1, 1); PG8_STAGE_A(PG8_SA(1, 0), a3, va2_);
            PG8_BAR; PG8_WAIT_L(0); PG8_MMA(1, 0, At, B0); PG8_BAR; PG8_SCHED;
            PG8_STAGE(PG8_SB(1, 1), b3 + hstep, voffB);
            PG8_WAIT_V(6); PG8_BAR; PG8_MMA(1, 1, At, B1); PG8_BAR;
            }
        }
        if constexpr (ALIGN_EPI) { if (wr == 0) PG8_BAR; }
        if constexpr (FP8) asm volatile("s_nop 15\n\ts_nop 15" ::: "memory");
        if constexpr (!Epi::AFTER_DRAIN) { E(acc, cur, wr, wc, fr, fq); S.done(cur); }
        if (!has_next) break;
#pragma unroll
        for (int a = 0; a < 2; ++a)
#pragma unroll
            for (int b = 0; b < 2; ++b)
#pragma unroll
                for (int m = 0; m < 4; ++m)
#pragma unroll
                    for (int n = 0; n < 2; ++n) acc[a][b][m][n] = (f32x4){0.f, 0.f, 0.f, 0.f};
        cur = nxt; cA = nA; cB = nB; ++ui;
        if constexpr (GATHER) {
#pragma unroll
            for (int h = 0; h < 2; ++h)
#pragma unroll
                for (int i = 0; i < 2; ++i) ca_[h][i] = na_[h][i]; }
        if constexpr (ALIGN_EPI) { if (wr == 1) PG8_BAR; }
    }
    PG8_WAIT_V(0);
    if constexpr (!ALIGN_EPI) { if (wr == 0) PG8_BAR; }
    PG8_BAR;
    if constexpr (Epi::AFTER_DRAIN) { E.fused(acc, cur, wr, wc, fr, fq, lds, wid, lane); S.done(cur); }
#undef PG8_SA
#undef PG8_SB
#undef PG8_STAGE
#undef PG8_LDA
#undef PG8_LDB
#undef PG8_MMA
#undef PG8_WAIT_V
#undef PG8_WAIT_L
#undef PG8_BAR
#undef PG8_SCHED
}
}

namespace pg8 {
struct EpiResGate {
    static constexpr bool PERM = false, AFTER_DRAIN = false;
    const float* base; float* out; int ldc; const float* gate; int gate_bstride; int rows_per_batch;
    __device__ __forceinline__ void operator()(const f32x4 (&acc)[2][2][4][2], const Unit& u, int wr, int wc, int fr, int fq) const {
        const int b = (u.pm * BM) / rows_per_batch;
        const int col0 = u.pn * BM + wc * 32 + 4 * fq;
        f32x4 gv[2][2];
#pragma unroll
        for (int bj = 0; bj < 2; ++bj)
#pragma unroll
            for (int n = 0; n < 2; ++n) gv[bj][n] = *(const f32x4*)(gate + (size_t)b * gate_bstride + col0 + bj * HALF + n * 16);
#pragma unroll
        for (int ai = 0; ai < 2; ++ai)
#pragma unroll
            for (int mp = 0; mp < 2; ++mp) {
                f32x4 bs[2][2][2];
#pragma unroll
                for (int mm = 0; mm < 2; ++mm) { const int m = 2 * mp + mm; const size_t off = (size_t)(u.pm * BM + ai * HALF + wr * 64 + m * 16 + fr) * ldc + col0;
#pragma unroll
                    for (int bj = 0; bj < 2; ++bj)
#pragma unroll
                        for (int n = 0; n < 2; ++n) bs[mm][bj][n] = *(const f32x4*)(base + off + bj * HALF + n * 16); }
                asm volatile("s_waitcnt vmcnt(0)" ::: "memory");
#pragma unroll
                for (int mm = 0; mm < 2; ++mm) { const int m = 2 * mp + mm; const size_t off = (size_t)(u.pm * BM + ai * HALF + wr * 64 + m * 16 + fr) * ldc + col0;
#pragma unroll
                    for (int bj = 0; bj < 2; ++bj)
#pragma unroll
                        for (int n = 0; n < 2; ++n) *(f32x4*)(out + off + bj * HALF + n * 16) = bs[mm][bj][n] + gv[bj][n] * acc[ai][bj][m][n]; }
                asm volatile("" ::: "memory");
            }
    }
};
__device__ __forceinline__ unsigned pk4_fp8(float a, float b, float c, float d) {
    a = __builtin_fminf(__builtin_fmaxf(a, -448.f), 448.f); b = __builtin_fminf(__builtin_fmaxf(b, -448.f), 448.f); c = __builtin_fminf(__builtin_fmaxf(c, -448.f), 448.f); d = __builtin_fminf(__builtin_fmaxf(d, -448.f), 448.f);
    int w = 0; w = __builtin_amdgcn_cvt_pk_fp8_f32(a, b, w, false); w = __builtin_amdgcn_cvt_pk_fp8_f32(c, d, w, true); return (unsigned)w; }
__device__ __forceinline__ unsigned pk4_fp8_nc(float a, float b, float c, float d) {
    int w = 0; w = __builtin_amdgcn_cvt_pk_fp8_f32(a, b, w, false); w = __builtin_amdgcn_cvt_pk_fp8_f32(c, d, w, true); return (unsigned)w; }
struct EpiSwiglu {
    static constexpr bool PERM = true, AFTER_DRAIN = false;
    unsigned char* O; const float* bgu; float asc, osc;
    __device__ __forceinline__ float act1(float g, float u) const {
        g = __builtin_fminf(g, 7.0f); u = __builtin_fminf(__builtin_fmaxf(u, -7.0f), 7.0f);
        const float s = __builtin_amdgcn_rcpf(1.0f + __builtin_amdgcn_exp2f(g * (-1.702f * 1.4426950408889634f)));
        return (u + 1.0f) * (g * s) * osc;
    }
    __device__ __forceinline__ void operator()(const f32x4 (&acc)[2][2][4][2], const Unit& u, int wr, int wc, int fr, int fq) const {
        const int e = u.pn >> 3, pnl = u.pn & 7;
        const int row0 = u.pm * BM + wr * 64 + fr;
        const int ocol0 = pnl * 128 + wc * 32 + 8 * fq;
        f32x4 bg[2], bu[2];
#pragma unroll
        for (int n = 0; n < 2; ++n) { bg[n] = *(const f32x4*)(bgu + (size_t)e * 2048 + ocol0 + 4 * n); bu[n] = *(const f32x4*)(bgu + (size_t)e * 2048 + 1024 + ocol0 + 4 * n); }
#pragma unroll
        for (int ai = 0; ai < 2; ++ai)
#pragma unroll
            for (int m = 0; m < 4; ++m) { unsigned char* rowp = O + (size_t)(row0 + ai * HALF + m * 16) * 1024 + ocol0;
                const f32x4 g0 = acc[ai][0][m][0] * asc + bg[0], g1 = acc[ai][0][m][1] * asc + bg[1], u0 = acc[ai][1][m][0] * asc + bu[0], u1 = acc[ai][1][m][1] * asc + bu[1];
                typedef unsigned u32x2 __attribute__((ext_vector_type(2)));
                u32x2 w; w.x = pk4_fp8_nc(act1(g0[0], u0[0]), act1(g0[1], u0[1]), act1(g0[2], u0[2]), act1(g0[3], u0[3]));
                w.y = pk4_fp8_nc(act1(g1[0], u1[0]), act1(g1[1], u1[1]), act1(g1[2], u1[2]), act1(g1[3], u1[3]));
                *(u32x2*)rowp = w; asm volatile("" ::: "memory"); }
    }
};
struct EpiDown {
    static constexpr bool PERM = true, AFTER_DRAIN = false;
    bf16_t* O; const float* bias; float asc;
    __device__ __forceinline__ void operator()(const f32x4 (&acc)[2][2][4][2], const Unit& u, int wr, int wc, int fr, int fq) const {
        const int row0 = u.pm * BM + wr * 64 + fr; const int pnl = u.pn & 3;
        const int col0 = pnl * BM + wc * 32 + 8 * fq, bcol0 = u.pn * BM + wc * 32 + 8 * fq;
        f32x4 bv[2][2];
#pragma unroll
        for (int bj = 0; bj < 2; ++bj)
#pragma unroll
            for (int n = 0; n < 2; ++n) bv[bj][n] = *(const f32x4*)(bias + bcol0 + bj * HALF + 4 * n);
#pragma unroll
        for (int ai = 0; ai < 2; ++ai)
#pragma unroll
            for (int m = 0; m < 4; ++m) { bf16_t* rowp = O + (size_t)(row0 + ai * HALF + m * 16) * 1024 + col0;
#pragma unroll
                for (int bj = 0; bj < 2; ++bj) { const f32x4 v0 = acc[ai][bj][m][0] * asc + bv[bj][0], v1 = acc[ai][bj][m][1] * asc + bv[bj][1];
                    u32x4 w; w.x = cvt_pk_bf16(v0[0], v0[1]); w.y = cvt_pk_bf16(v0[2], v0[3]); w.z = cvt_pk_bf16(v1[0], v1[1]); w.w = cvt_pk_bf16(v1[2], v1[3]);
                    *(u32x4*)(rowp + bj * HALF) = w; } }
    }
};
#ifndef GROUPED_WGM
#define GROUPED_WGM 16
#endif
struct GroupedOrder {
    const int* tile_e; int nM, nNl, nwg, G, c;
    __device__ void init(const int* te, int ntm, int nNl_, int G_, int c_) { tile_e = te; nM = ntm; nNl = nNl_; nwg = ntm * nNl_; G = G_; c = c_; }
    __device__ bool next(int i, Unit& u) const {
        const long L = (long)i * G + c; if (L >= nwg) return false;
        int wgid = (int)L; { const int q = nwg / NXCD, r = nwg % NXCD, xcd = wgid % NXCD, off = wgid / NXCD; wgid = (xcd < r ? xcd * (q + 1) : r * (q + 1) + (xcd - r) * q) + off; }
        constexpr int WG = GROUPED_WGM; const int nig = WG * nNl, gid = wgid / nig, fm = gid * WG, gsz = (nM - fm) < WG ? (nM - fm) : WG;
        u.pm = fm + ((wgid % nig) % gsz); const int pl = (wgid % nig) / gsz;
        u.pn = __builtin_amdgcn_readfirstlane(tile_e[u.pm]) * nNl + pl; return true;
    }
    __device__ __forceinline__ void a_ready(const Unit&) const {}
    __device__ __forceinline__ void done(const Unit&) const {}
};
}

constexpr int NWAVES = 8;
constexpr int NB = 4, SEQ = 4096, DM = 1024, TT = NB * SEQ, DH = 512, NHEAD = 8, HD = 64, NEXP = 32, TOPK = 4, INCOLS = 2560, NMOD = 6 * DM, DE2 = 2048;
constexpr float NORM_EPS = 1e-6f;
constexpr float C2 = 0.125f * 1.4426950408889634f;
constexpr float SC_H = 16.0f, SC_W = 512.0f, SC_ACT = 4.0f;
constexpr int MAXSLOT = TT * TOPK + NEXP * 256, MAXTILE = MAXSLOT / 256;
#ifndef MK_N_LAUNCHES
#define MK_N_LAUNCHES 1
#endif
constexpr int PER_PHASE = 11;
constexpr int N_LAUNCHES = MK_N_LAUNCHES;

constexpr size_t MiB = 1u << 20;
constexpr size_t WS_CTL = 0, CTL_ZERO_BYTES = 1 * MiB;
constexpr size_t WS_MISC = 1 * MiB;
constexpr size_t WS_WRT = 2 * MiB;
constexpr size_t WS_WIN = 3 * MiB, WS_WOUT = 8 * MiB, WS_WGU = 16 * MiB, WS_WD = 144 * MiB;
constexpr size_t WS_XN = 208 * MiB, WS_QKV = 240 * MiB, WS_OP = 320 * MiB, WS_LSE = 368 * MiB, WS_MIX = 370 * MiB, WS_X1 = 402 * MiB;
constexpr size_t WS_ROUTE = 466 * MiB;
constexpr size_t WS_XG = 468 * MiB, WS_ACT = 612 * MiB, WS_MODP = 756 * MiB, WS_END = 758 * MiB;
constexpr int CW_TMO = 0, CW_CODE = 1, CW_BAR = 4096, CW_CNT = 8192, CW_RFLAG = 12288, CW_MOD = 16384, CW_RX = 65536;
static_assert((size_t)CW_RX * 4 + (size_t)NB * 8 * 16 * 64 * 8 <= CTL_ZERO_BYTES, "ctl rx");
static_assert((CW_MOD + NB * NMOD) * 4 <= (int)CTL_ZERO_BYTES, "ctl");
constexpr int RING_OFF = 0, RING_BYTES = 131072, LDSCTL_OFF = RING_BYTES, MISC_OFF = LDSCTL_OFF + 320, SUMM_OFF = RING_BYTES + 1024, TILE_OFF = SUMM_OFF + 4096, ROWTAB_OFF = TILE_OFF + 1024, ROWTAB_UNITS = 9, LDS_BYTES = 147456;
static_assert(ROWTAB_OFF + ROWTAB_UNITS * 1024 <= LDS_BYTES && (MAXTILE * 8 + 255) / 256 <= ROWTAB_UNITS, "lds");
#define GAS __attribute__((address_space(1)))
#define LAS __attribute__((address_space(3)))
typedef unsigned short bf16;
typedef unsigned v4u __attribute__((ext_vector_type(4)));
typedef float f32x4 __attribute__((ext_vector_type(4)));
typedef short bf16x8 __attribute__((ext_vector_type(8)));
typedef GAS unsigned gu32;
typedef GAS unsigned long long gu64;
#define RLX_AGENT __ATOMIC_RELAXED, __HIP_MEMORY_SCOPE_AGENT
#define LDS_WAIT() asm volatile("s_waitcnt lgkmcnt(0)" ::: "memory")
#define VM_WAIT() asm volatile("s_waitcnt vmcnt(0)" ::: "memory")
__device__ __forceinline__ unsigned long long rt() { return __builtin_amdgcn_s_memrealtime(); }
__device__ __forceinline__ unsigned f2bf(float f) { unsigned u = __builtin_bit_cast(unsigned, f); return (u + 0x7fffu + ((u >> 16) & 1u)) >> 16; }
__device__ __forceinline__ unsigned pk2(float lo, float hi) { return f2bf(lo) | (f2bf(hi) << 16); }

#define XB_TMO      128
#define XB_XCNT(j)  (256  + 64 * (j))
#define XB_XSUB(j)  (1280 + 64 * (j))
#define XB_XGEN(j)  (2304 + 64 * (j))
#define XB_TOP      3328
#define XB_TOPGEN   3392
#define XCD_BAR_WORDS 3456
#define XB_SPIN_CAP (1u << 18)

__device__ __forceinline__ unsigned xb_ld(unsigned* p)              { return __hip_atomic_load(p, __ATOMIC_RELAXED, __HIP_MEMORY_SCOPE_AGENT); }
__device__ __forceinline__ unsigned xb_add(unsigned* p, unsigned v) { return __hip_atomic_fetch_add(p, v, __ATOMIC_RELAXED, __HIP_MEMORY_SCOPE_AGENT); }
__device__ __forceinline__ unsigned xb_xcc_id() { return (unsigned)__builtin_amdgcn_s_getreg((3 << 11) | 20) & 0xFu; }
#define XB_SPIN(cond, bar) do { unsigned _sp = 0; while (cond) { __builtin_amdgcn_s_sleep(1); \
    if ((++_sp & 255u) == 0u) { if (xb_ld(&(bar)[XB_TMO])) break; if (_sp > XB_SPIN_CAP) { atomicAdd(&(bar)[XB_TMO], 1u); break; } } } } while (0)

struct XcdBarrier {
    unsigned* bar; unsigned x;
    volatile LAS unsigned* st;
};

__device__ __forceinline__ XcdBarrier xcd_barrier_post(unsigned* bar, volatile LAS unsigned* st) {
    XcdBarrier b; b.bar = bar; b.x = xb_xcc_id(); b.st = st;
    if (threadIdx.x == 0) (void)xb_add(&bar[XB_XCNT(b.x)], 1u);
    return b;
}
__device__ __forceinline__ void xcd_barrier_complete(unsigned* bar, unsigned x, unsigned& nloc, unsigned& nx) {
    const unsigned G = gridDim.x * gridDim.y * gridDim.z;
    unsigned sum, cnt, mine, sp = 0u;
    for (;;) {
        sum = 0u; cnt = 0u; mine = 0u;
#pragma unroll
        for (unsigned j = 0; j < 16; ++j) { const unsigned c = xb_ld(&bar[XB_XCNT(j)]); sum += c; cnt += (c > 0u) ? 1u : 0u; mine = (j == x) ? c : mine; }
        if (sum == G) break;
        __builtin_amdgcn_s_sleep(1);
        if ((++sp & 255u) == 0u) { if (xb_ld(&bar[XB_TMO])) break; if (sp > XB_SPIN_CAP) { atomicAdd(&bar[XB_TMO], 1u); break; } }
    }
    nloc = mine > 0u ? mine : 1u; nx = cnt > 0u ? cnt : 1u;
}

__device__ __forceinline__ void xcd_barrier(const XcdBarrier& b) {
    asm volatile("s_waitcnt vmcnt(0)" ::: "memory");
    __syncthreads();
    if (threadIdx.x == 0) {
        unsigned* bar = b.bar;
        __builtin_amdgcn_s_waitcnt(0);
        unsigned nloc = b.st[0], nx = b.st[1];
        if (nloc == 0u) { xcd_barrier_complete(bar, b.x, nloc, nx); b.st[0] = nloc; b.st[1] = nx; }
        const unsigned old = xb_add(&bar[XB_XSUB(b.x)], 1u);
        const unsigned gen = old / nloc;
        if (old + 1u == (gen + 1u) * nloc) {
            __builtin_amdgcn_fence(__ATOMIC_RELEASE, "agent");
            asm volatile("s_waitcnt vmcnt(0)" ::: "memory");
            const unsigned og = xb_add(&bar[XB_TOP], 1u);
            const unsigned tg = og / nx;
            if (og + 1u == (tg + 1u) * nx) xb_add(&bar[XB_TOPGEN], 1u);
            else XB_SPIN(xb_ld(&bar[XB_TOPGEN]) == tg, bar);
            __builtin_amdgcn_fence(__ATOMIC_ACQUIRE, "agent");
            xb_add(&bar[XB_XGEN(b.x)], 1u);
            asm volatile("s_waitcnt vmcnt(0)" ::: "memory");
        } else {
            XB_SPIN(xb_ld(&bar[XB_XGEN(b.x)]) == gen, bar);
            __builtin_amdgcn_fence(__ATOMIC_ACQUIRE, "agent");
            asm volatile("s_waitcnt vmcnt(0)" ::: "memory");
        }
    }
    __syncthreads();
}

typedef float f32x16 __attribute__((ext_vector_type(16)));
typedef short v4i16_t __attribute__((ext_vector_type(4)));
typedef unsigned v2u __attribute__((ext_vector_type(2)));
struct Frame {
    LAS unsigned char* lds;
    int tid, lane, wave, vcu, G;
    unsigned char* ws;
    const __attribute__((address_space(4))) void* ka;
    __device__ __forceinline__ const float* in(int k) const {
        const unsigned long long v = *(const volatile __attribute__((address_space(4))) unsigned long long*)((const __attribute__((address_space(4))) char*)ka + 8 * k);
        const unsigned lo = (unsigned)__builtin_amdgcn_readfirstlane((int)(unsigned)v), hi = (unsigned)__builtin_amdgcn_readfirstlane((int)(unsigned)(v >> 32));
        return (const float*)(const GAS float*)(((unsigned long long)hi << 32) | lo);
    }
};
enum InIdx { I_x = 0, I_c, I_w_ada, I_b_ada, I_g_mix, I_w_in, I_conv_w, I_conv_b, I_w_rg_a, I_b_rg_a, I_w_rg_x, I_b_rg_x, I_lam, I_w_out, I_g_ffn, I_w_router, I_b_router, I_w_gate_up, I_b_gate_up, I_w_down, I_b_down, I_g_final };
#define WSP(T, off) ((T*)(F.ws + (off)))
#define P_MOD   (WSP(float, WS_CTL) + CW_MOD)
#define P_BCNT  WSP(int, WS_MISC + 8192)
#define P_TILE_E WSP(int, WS_MISC)
#define P_TILE_N WSP(int, WS_MISC + 4096)
#define P_RSUM  WSP(float, WS_MISC + 65536)
#define P_WRT   WSP(float, WS_WRT)
#define P_WA_T  WSP(bf16, WS_WRT + 262144)
#define P_WX_T  WSP(bf16, WS_WRT + 393216)
#define P_WIN_T WSP(bf16, WS_WIN)
#define P_WOUT_T WSP(bf16, WS_WOUT)
#define P_WGU8 WSP(unsigned char, WS_WGU)
#define P_WD8  WSP(unsigned char, WS_WD)
#define P_XN    WSP(bf16, WS_XN)
#define P_QB    WSP(bf16, WS_QKV)
#define P_KB    (WSP(bf16, WS_QKV) + (size_t)TT * DH)
#define P_VB    (WSP(bf16, WS_QKV) + (size_t)2 * TT * DH)
#define P_XR    (WSP(bf16, WS_QKV) + (size_t)3 * TT * DH)
#define P_GR    (WSP(bf16, WS_QKV) + (size_t)4 * TT * DH)
#define P_OP    WSP(bf16, WS_OP)
#define P_LSE   WSP(float, WS_LSE)
#define P_MIX   WSP(bf16, WS_MIX)
#define P_X1    WSP(float, WS_X1)
#define P_TOK_E WSP(int, WS_ROUTE)
#define P_TOK_POS (WSP(int, WS_ROUTE) + TT * TOPK)
#define P_TOK_GATE (WSP(float, WS_ROUTE) + 2 * TT * TOPK)
#define P_TOK_SLOT (WSP(int, WS_ROUTE) + 3 * TT * TOPK)
#define P_SLOT_TOK (WSP(int, WS_ROUTE + 1048576))
#define P_Y2    WSP(bf16, WS_XG)
#define P_XN8   WSP(unsigned char, WS_XN)
#define P_ACT8  WSP(unsigned char, WS_ACT)
__device__ __forceinline__ float bf2f(unsigned short v) { return __uint_as_float(((unsigned)v) << 16); }
__device__ __forceinline__ float wave_sum(float v) {
#pragma unroll
    for (int o = 1; o < 64; o <<= 1) v += __shfl_xor(v, o);
    return v;
}
__device__ __forceinline__ float wave_max(float v) {
#pragma unroll
    for (int o = 1; o < 64; o <<= 1) v = fmaxf(v, __shfl_xor(v, o));
    return v;
}
__device__ __forceinline__ int crow(int r, int hi) { return (r & 3) + 8 * (r >> 2) + 4 * hi; }

__device__ __forceinline__ void p0_transpose_item(const float* W, int K, int N, bf16* WT, int k0, int n0, int drow0, LAS float* scr, int lane) {
#pragma unroll 8
    for (int i = 0; i < 32; ++i) { const int kk = 2 * i + (lane >> 5); scr[kk * 33 + (lane & 31)] = W[(size_t)(k0 + kk) * N + n0 + (lane & 31)]; }
    LDS_WAIT(); asm volatile("" ::: "memory");
    const int c = lane & 7;
#pragma unroll
    for (int j = 0; j < 4; ++j) { const int n = (lane >> 3) + 8 * j; const LAS float* s = scr + (8 * c) * 33 + n;
        v4u o; o.x = pk2(s[0 * 33], s[1 * 33]); o.y = pk2(s[2 * 33], s[3 * 33]); o.z = pk2(s[4 * 33], s[5 * 33]); o.w = pk2(s[6 * 33], s[7 * 33]);
        *(GAS v4u*)(WT + (size_t)(drow0 + n) * K + k0 + 8 * c) = o; }
    LDS_WAIT(); asm volatile("" ::: "memory");
}
__device__ __forceinline__ void p0_transpose_item8(const float* W, int K, int N, unsigned char* WT, int k0, int n0, int drow0, float sc, LAS float* scr, int lane) {
#pragma unroll 8
    for (int i = 0; i < 32; ++i) { const int kk = 2 * i + (lane >> 5); scr[kk * 33 + (lane & 31)] = W[(size_t)(k0 + kk) * N + n0 + (lane & 31)]; }
    LDS_WAIT(); asm volatile("" ::: "memory");
    const int c = lane & 7;
#pragma unroll
    for (int j = 0; j < 4; ++j) { const int n = (lane >> 3) + 8 * j; const LAS float* s = scr + (8 * c) * 33 + n;
        v2u o; o.x = pg8::pk4_fp8(s[0 * 33] * sc, s[1 * 33] * sc, s[2 * 33] * sc, s[3 * 33] * sc); o.y = pg8::pk4_fp8(s[4 * 33] * sc, s[5 * 33] * sc, s[6 * 33] * sc, s[7 * 33] * sc);
        *(GAS v2u*)(WT + (size_t)(drow0 + n) * K + k0 + 8 * c) = o; }
    LDS_WAIT(); asm volatile("" ::: "memory");
}
struct TDesc { const float* src; unsigned char* dst; int N, K, k0, n0, drow0, fp8; };
__device__ __forceinline__ void p0_dma_issue(const TDesc& d, LAS unsigned char* buf, int lane) {
    const __amdgpu_buffer_rsrc_t rs = __builtin_amdgcn_make_buffer_rsrc((void*)d.src, 0, 0x7ffffff0, 0x00020000);
#pragma unroll
    for (int j = 0; j < 16; ++j) { const int voff = ((lane >> 3) * d.N + 4 * ((lane & 7) ^ (j & 7))) * 4, soff = ((d.k0 + 8 * j) * d.N + d.n0) * 4;
        __builtin_amdgcn_raw_ptr_buffer_load_lds(rs, (LAS unsigned*)(buf + j * 1024), 16, voff, soff, 0, 0); }
}
__device__ __forceinline__ void p0_read(LAS unsigned char* buf, int lane, float (&f)[8][8]) {
    const int c = lane & 15;
#pragma unroll
    for (int jj = 0; jj < 8; ++jj) { const int n = (lane >> 4) + 4 * jj; const LAS unsigned char* s = buf + (8 * c) * 128 + ((((n >> 2) ^ (c & 7)) * 4 + (n & 3)) * 4);
#pragma unroll
        for (int i = 0; i < 8; ++i) f[jj][i] = *(const LAS float*)(s + i * 128); }
}
__device__ __forceinline__ void p0_emit(const TDesc& d, int lane, const float (&f)[8][8]) {
    const int c = lane & 15;
#pragma unroll
    for (int jj = 0; jj < 8; ++jj) { const int n = (lane >> 4) + 4 * jj;
        if (d.fp8) { v2u o; o.x = pg8::pk4_fp8(f[jj][0] * SC_W, f[jj][1] * SC_W, f[jj][2] * SC_W, f[jj][3] * SC_W); o.y = pg8::pk4_fp8(f[jj][4] * SC_W, f[jj][5] * SC_W, f[jj][6] * SC_W, f[jj][7] * SC_W);
            *(GAS v2u*)(d.dst + (size_t)(d.drow0 + n) * d.K + d.k0 + 8 * c) = o; }
        else { v4u o; o.x = pk2(f[jj][0], f[jj][1]); o.y = pk2(f[jj][2], f[jj][3]); o.z = pk2(f[jj][4], f[jj][5]); o.w = pk2(f[jj][6], f[jj][7]);
            *(GAS v4u*)((bf16*)d.dst + (size_t)(d.drow0 + n) * d.K + d.k0 + 8 * c) = o; } }
}
constexpr int PT_WGU = NEXP * 8 * 64, PT_WD = NEXP * 8 * 32, PT_WIN = 8 * 80, PT_WOUT = 8 * 32, P0T_EXPERTS = PT_WGU + PT_WD, P0T_ALL = P0T_EXPERTS + PT_WIN + PT_WOUT;
__device__ __forceinline__ void p0_transposes(Frame& F, int lo, int hi, int rank = -1, int nranks = 0) {
    const int lane = F.lane;
    const float *in_w_in = F.in(I_w_in), *in_w_out = F.in(I_w_out), *in_w_gate_up = F.in(I_w_gate_up), *in_w_down = F.in(I_w_down);
    const int gw = (rank < 0 ? F.vcu : rank) * NWAVES + F.wave, NGW = (rank < 0 ? F.G : nranks) * NWAVES;
    LAS unsigned char* lb = F.lds + RING_OFF + F.wave * 16384;
#define P0_DECODE(IT, D) do { int r = (IT); \
        if (r < PT_WGU) { const int e = r >> 9, rr = r & 511, kb = rr >> 6, nb = rr & 63, n0 = 32 * nb, j = n0 & 1023; \
            (D).src = in_w_gate_up + (size_t)e * DM * DE2; (D).dst = P_WGU8 + (size_t)e * DE2 * DM; (D).N = DE2; (D).K = DM; (D).k0 = 128 * kb; (D).n0 = n0; (D).drow0 = (j >> 7) * 256 + (n0 >= 1024 ? 128 : 0) + (j & 127); (D).fp8 = 1; break; } \
        r -= PT_WGU; \
        if (r < PT_WD) { const int e = r >> 8, rr = r & 255, kb = rr >> 5, nb = rr & 31; \
            (D).src = in_w_down + (size_t)e * DM * DM; (D).dst = P_WD8 + (size_t)e * DM * DM; (D).N = DM; (D).K = DM; (D).k0 = 128 * kb; (D).n0 = 32 * nb; (D).drow0 = 32 * nb; (D).fp8 = 1; break; } \
        r -= PT_WD; \
        if (r < PT_WIN) { const int kb = r / 80, nb = r % 80; (D).src = in_w_in; (D).dst = (unsigned char*)P_WIN_T; (D).N = INCOLS; (D).K = DM; (D).k0 = 128 * kb; (D).n0 = 32 * nb; (D).drow0 = 32 * nb; (D).fp8 = 0; break; } \
        r -= PT_WIN; \
        { const int kb = r / 32, nb = r % 32; (D).src = in_w_out; (D).dst = (unsigned char*)P_WOUT_T; (D).N = DM; (D).K = DM; (D).k0 = 128 * kb; (D).n0 = 32 * nb; (D).drow0 = 32 * nb; (D).fp8 = 0; } \
    } while (0)
    int it = lo + gw;
    if (it < hi) {
        TDesc d, d1; P0_DECODE(it, d); d1 = d;
        p0_dma_issue(d, lb, lane);
        asm volatile("s_waitcnt vmcnt(0)" ::: "memory");
        for (;;) {
            float f[8][8]; p0_read(lb, lane, f);
            LDS_WAIT(); asm volatile("" ::: "memory");
            const bool has = it + NGW < hi;
            if (has) { P0_DECODE(it + NGW, d1); p0_dma_issue(d1, lb, lane); }
            p0_emit(d, lane, f);
            asm volatile("" ::: "memory");
            if (!has) break;
            asm volatile("s_waitcnt vmcnt(8)" ::: "memory");
            it += NGW; d = d1;
        }
    }
#undef P0_DECODE
}
__device__ __forceinline__ void p0_prologue(Frame& F) {
    const int lane = F.lane;
    const float *in_w_ada = F.in(I_w_ada), *in_c = F.in(I_c), *in_b_ada = F.in(I_b_ada), *in_w_in = F.in(I_w_in), *in_w_out = F.in(I_w_out), *in_w_gate_up = F.in(I_w_gate_up), *in_w_down = F.in(I_w_down),
        *in_w_rg_a = F.in(I_w_rg_a), *in_w_rg_x = F.in(I_w_rg_x), *in_w_router = F.in(I_w_router);
    const int gw = F.vcu * NWAVES + F.wave, NGW = F.G * NWAVES;
    for (int cb = F.vcu; cb < NMOD / 24; cb += F.G) {
        LAS f32x4* part = (LAS f32x4*)(F.lds + RING_OFF);
        const int q = lane % 6, kk = lane / 6, col0 = cb * 24;
        if (kk < 8) { const int kb = F.wave * 128 + kk * 16;
            f32x4 a[4] = {(f32x4){0.f, 0.f, 0.f, 0.f}, (f32x4){0.f, 0.f, 0.f, 0.f}, (f32x4){0.f, 0.f, 0.f, 0.f}, (f32x4){0.f, 0.f, 0.f, 0.f}};
#pragma unroll
            for (int hf = 0; hf < 2; ++hf) {
                f32x4 wv[8];
#pragma unroll
                for (int t = 0; t < 8; ++t) wv[t] = *(const f32x4*)(in_w_ada + (size_t)(kb + 8 * hf + t) * NMOD + col0 + 4 * q);
#pragma unroll
                for (int b4 = 0; b4 < 4; ++b4) { const f32x4 c0 = *(const f32x4*)(in_c + b4 * DM + kb + 8 * hf), c1 = *(const f32x4*)(in_c + b4 * DM + kb + 8 * hf + 4);
                    a[b4] += c0.x * wv[0]; a[b4] += c0.y * wv[1]; a[b4] += c0.z * wv[2]; a[b4] += c0.w * wv[3]; a[b4] += c1.x * wv[4]; a[b4] += c1.y * wv[5]; a[b4] += c1.z * wv[6]; a[b4] += c1.w * wv[7]; }
                asm volatile("" ::: "memory"); }
#pragma unroll
            for (int b4 = 0; b4 < 4; ++b4) part[((F.wave * 8 + kk) * 6 + q) * 4 + b4] = a[b4]; }
        LDS_WAIT(); __syncthreads();
        if (F.tid < 96) { const int b4 = F.tid / 24, cc = F.tid % 24, qq = cc >> 2, comp = cc & 3; float s = 0.f;
            for (int p = 0; p < 64; ++p) s += part[(p * 6 + qq) * 4 + b4][comp];
            P_MOD[(size_t)b4 * NMOD + col0 + cc] = s + in_b_ada[col0 + cc]; }
        LDS_WAIT(); __syncthreads();
    }
    for (int r = gw; r < 512; r += NGW) { const int idx = r * 64 + lane, e = idx >> 10, k = idx & 1023; P_WRT[idx] = in_w_router[k * NEXP + e]; }
    asm volatile("s_waitcnt vmcnt(0)" ::: "memory");
    p0_transposes(F, P0T_EXPERTS, P0T_ALL);
    asm volatile("s_waitcnt vmcnt(0)" ::: "memory"); LDS_WAIT();
    for (int r = gw; r < 32; r += NGW) { const int which = r >> 4, rr = r & 15, n = rr >> 1, nb = rr & 1;
        p0_transpose_item((which ? in_w_rg_x : in_w_rg_a) + n * 4096, 64, 64, (which ? P_WX_T : P_WA_T) + n * 4096, 0, 32 * nb, 32 * nb, (LAS float*)(F.lds + RING_OFF + F.wave * 16384), lane); }
}
__device__ __forceinline__ void p1_norm(Frame& F) {
    const float* in_x = F.in(I_x); const float* in_g_mix = F.in(I_g_mix);
    const int gw = F.vcu * NWAVES + F.wave, NGW = F.G * NWAVES, lane = F.lane;
    for (int m = gw; m < TT; m += NGW) {
        const int b = m / SEQ;
        const GAS f32x4* xr = (const GAS f32x4*)(in_x + (size_t)m * DM) + lane;
        f32x4 v[4]; float ss = 0.f;
#pragma unroll
        for (int j = 0; j < 4; ++j) { v[j] = xr[64 * j]; ss += (v[j].x * v[j].x + v[j].y * v[j].y) + (v[j].z * v[j].z + v[j].w * v[j].w); }
        const float rstd = 1.0f / sqrtf(wave_sum(ss) * (1.0f / DM) + NORM_EPS);
        const float* mb = P_MOD + (size_t)b * NMOD;
#pragma unroll
        for (int j = 0; j < 4; ++j) { const int col = 4 * lane + 256 * j;
            const f32x4 g = *(const f32x4*)(in_g_mix + col), sc = *(const f32x4*)(mb + DM + col), sh = *(const f32x4*)(mb + col);
            const f32x4 h = (v[j] * rstd) * g * (sc + 1.0f) + sh;
            v2u o; o.x = pk2(h.x, h.y); o.y = pk2(h.z, h.w); *(GAS v2u*)(P_XN + (size_t)m * DM + col) = o; }
        asm volatile("" ::: "memory");
    }
}
template <bool FINAL> __device__ __forceinline__ void rglru_items(Frame& F) {
    LAS unsigned char* wl = F.lds + RING_OFF + F.wave * 16384;
    LAS float* summ = (LAS float*)(F.lds + SUMM_OFF);
    const float* in_conv_w = F.in(I_conv_w); const float* in_conv_b = F.in(I_conv_b); const float* in_b_rg_a = F.in(I_b_rg_a); const float* in_b_rg_x = F.in(I_b_rg_x); const float* in_lam = F.in(I_lam);
    const int lane = F.lane, w = F.wave;
    for (int it = F.vcu; it < NB * 8 * 16; it += F.G) {
        const int sp = it & 15, n = (it >> 4) & 7, b = it >> 7;
        const int gc = n * 64 + lane, t0 = sp * 256 + w * 32;
        const bf16* xrp = P_XR + ((size_t)b * SEQ) * DH + gc;
        float xin[35];
#pragma unroll
        for (int i = 0; i < 35; ++i) { const int tt = t0 - 3 + i, tc = tt < 0 ? 0 : tt; const float v = bf2f(xrp[(size_t)tc * DH]); xin[i] = tt < 0 ? 0.f : v; }
        const float cw0 = in_conv_w[gc], cw1 = in_conv_w[DH + gc], cw2 = in_conv_w[2 * DH + gc], cw3 = in_conv_w[3 * DH + gc], cb = in_conv_b[gc];
        float xc[32];
#pragma unroll
        for (int t = 0; t < 32; ++t) xc[t] = ((cw0 * xin[t] + cw1 * xin[t + 1]) + (cw2 * xin[t + 2] + cw3 * xin[t + 3])) + cb;
        LAS unsigned short* w16 = (LAS unsigned short*)wl;
#pragma unroll
        for (int t = 0; t < 32; ++t) w16[t * 64 + lane] = (unsigned short)f2bf(xc[t]);
        LDS_WAIT(); asm volatile("" ::: "memory");
        const int tok = lane & 31, hh = lane >> 5;
        bf16x8 af[4];
#pragma unroll
        for (int s = 0; s < 4; ++s) af[s] = *(const LAS bf16x8*)(wl + (tok * 64 + 16 * s + 8 * hh) * 2);
        f32x16 ga[2], gx[2];
#pragma unroll
        for (int nt = 0; nt < 2; ++nt) { ga[nt] = f32x16{}; gx[nt] = f32x16{};
            const size_t wo = ((size_t)(n * 64 + tok + 32 * nt)) * 64 + 8 * hh;
#pragma unroll
            for (int s = 0; s < 4; ++s) { const bf16x8 ba = *(const GAS bf16x8*)(P_WA_T + wo + 16 * s), bx = *(const GAS bf16x8*)(P_WX_T + wo + 16 * s);
                ga[nt] = __builtin_amdgcn_mfma_f32_32x32x16_bf16(af[s], ba, ga[nt], 0, 0, 0); gx[nt] = __builtin_amdgcn_mfma_f32_32x32x16_bf16(af[s], bx, gx[nt], 0, 0, 0); } }
        LDS_WAIT(); asm volatile("" ::: "memory");
        LAS float* wf = (LAS float*)wl;
#pragma unroll
        for (int nt = 0; nt < 2; ++nt)
#pragma unroll
            for (int rr = 0; rr < 16; ++rr) { const int tr = crow(rr, hh); wf[tr * 64 + tok + 32 * nt] = ga[nt][rr]; wf[2048 + tr * 64 + tok + 32 * nt] = gx[nt][rr]; }
        LDS_WAIT(); asm volatile("" ::: "memory");
        const float ba_ = in_b_rg_a[gc], bx_ = in_b_rg_x[gc], spc = log1pf(expf(-in_lam[gc]));
        float av[32], uv[32];
#pragma unroll
        for (int t = 0; t < 32; ++t) { const float pa = wf[t * 64 + lane] + ba_, px = wf[2048 + t * 64 + lane] + bx_;
            const float rg = __builtin_amdgcn_rcpf(1.0f + __builtin_amdgcn_exp2f(-1.4426950408889634f * pa)), ig = __builtin_amdgcn_rcpf(1.0f + __builtin_amdgcn_exp2f(-1.4426950408889634f * px));
            const float a = __builtin_amdgcn_exp2f((-8.0f * 1.4426950408889634f) * rg * spc);
            av[t] = a; uv[t] = __builtin_amdgcn_sqrtf(fmaxf(1.0f - a * a, 0.f)) * (ig * xc[t]); }
        LDS_WAIT(); asm volatile("" ::: "memory");
        float h = 0.f, P = 1.f;
#pragma unroll
        for (int t = 0; t < 32; ++t) { h = av[t] * h + uv[t]; P *= av[t]; }
        summ[(w * 64 + lane) * 2] = P; summ[(w * 64 + lane) * 2 + 1] = h;
        LDS_WAIT(); __syncthreads();
        if (!FINAL) {
            if (w == 0) { float Pt = 1.f, Ht = 0.f;
#pragma unroll
                for (int q = 0; q < 8; ++q) { const float p = summ[(q * 64 + lane) * 2], hq = summ[(q * 64 + lane) * 2 + 1]; Ht = p * Ht + hq; Pt *= p; }
                float* o = P_RSUM + ((size_t)(b * 16 + sp) * DH + gc) * 2; o[0] = Pt; o[1] = Ht; }
        } else {
            float hc = 0.f;
            { float pq[16], hq[16];
#pragma unroll
              for (int q = 0; q < 16; ++q) { const float* r2 = P_RSUM + ((size_t)(b * 16 + (q < sp ? q : 0)) * DH + gc) * 2; pq[q] = r2[0]; hq[q] = r2[1]; }
#pragma unroll
              for (int q = 0; q < 16; ++q) if (q < sp) hc = pq[q] * hc + hq[q]; }
            for (int q = 0; q < w; ++q) hc = summ[(q * 64 + lane) * 2] * hc + summ[(q * 64 + lane) * 2 + 1];
            h = hc;
            const bf16* grp = P_GR + ((size_t)b * SEQ + t0) * DH + gc; bf16* op = P_MIX + ((size_t)b * SEQ + t0) * DM + DH + gc;
            float gv[32];
#pragma unroll
            for (int t = 0; t < 32; ++t) gv[t] = bf2f(grp[(size_t)t * DH]);
            asm volatile("s_waitcnt vmcnt(0)" ::: "memory");
#pragma unroll
            for (int t = 0; t < 32; ++t) { h = av[t] * h + uv[t]; const float g = gv[t]; const float y = 0.7978845608028654f * (g + 0.044715f * g * g * g);
                const float th = 1.0f - 2.0f * __builtin_amdgcn_rcpf(1.0f + __builtin_amdgcn_exp2f((2.0f * 1.4426950408889634f) * y)); op[(size_t)t * DM] = (bf16)f2bf(h * (0.5f * g * (1.0f + th))); }
        }
        asm volatile("s_waitcnt vmcnt(0)" ::: "memory");
        LDS_WAIT(); __syncthreads();
    }
}
__device__ __forceinline__ void rglru_single(Frame& F) {
    LAS unsigned char* wl = F.lds + RING_OFF + F.wave * 16384;
    LAS float* summ = (LAS float*)(F.lds + SUMM_OFF);
    const float* in_conv_w = F.in(I_conv_w); const float* in_conv_b = F.in(I_conv_b); const float* in_b_rg_a = F.in(I_b_rg_a); const float* in_b_rg_x = F.in(I_b_rg_x); const float* in_lam = F.in(I_lam);
    const int lane = F.lane, w = F.wave;
    for (int it = F.vcu; it < NB * 8 * 16; it += F.G) {
        const int sp = it & 15, n = (it >> 4) & 7, b = it >> 7;
        const int gc = n * 64 + lane, t0 = sp * 256 + w * 32;
        const bf16* xrp = P_XR + ((size_t)b * SEQ) * DH + gc;
        float xin[35];
#pragma unroll
        for (int i = 0; i < 35; ++i) { const int tt = t0 - 3 + i, tc = tt < 0 ? 0 : tt; const float v = bf2f(xrp[(size_t)tc * DH]); xin[i] = tt < 0 ? 0.f : v; }
        const float cw0 = in_conv_w[gc], cw1 = in_conv_w[DH + gc], cw2 = in_conv_w[2 * DH + gc], cw3 = in_conv_w[3 * DH + gc], cb = in_conv_b[gc];
        float xc[32];
#pragma unroll
        for (int t = 0; t < 32; ++t) xc[t] = ((cw0 * xin[t] + cw1 * xin[t + 1]) + (cw2 * xin[t + 2] + cw3 * xin[t + 3])) + cb;
        LAS unsigned short* w16 = (LAS unsigned short*)wl;
#pragma unroll
        for (int t = 0; t < 32; ++t) w16[t * 64 + lane] = (unsigned short)f2bf(xc[t]);
        LDS_WAIT(); asm volatile("" ::: "memory");
        const int tok = lane & 31, hh = lane >> 5;
        bf16x8 af[4];
#pragma unroll
        for (int s = 0; s < 4; ++s) af[s] = *(const LAS bf16x8*)(wl + (tok * 64 + 16 * s + 8 * hh) * 2);
        f32x16 ga[2], gx[2];
#pragma unroll
        for (int nt = 0; nt < 2; ++nt) { ga[nt] = f32x16{}; gx[nt] = f32x16{};
            const size_t wo = ((size_t)(n * 64 + tok + 32 * nt)) * 64 + 8 * hh;
#pragma unroll
            for (int s = 0; s < 4; ++s) { const bf16x8 ba = *(const GAS bf16x8*)(P_WA_T + wo + 16 * s), bx = *(const GAS bf16x8*)(P_WX_T + wo + 16 * s);
                ga[nt] = __builtin_amdgcn_mfma_f32_32x32x16_bf16(af[s], ba, ga[nt], 0, 0, 0); gx[nt] = __builtin_amdgcn_mfma_f32_32x32x16_bf16(af[s], bx, gx[nt], 0, 0, 0); } }
        LDS_WAIT(); asm volatile("" ::: "memory");
        LAS float* wf = (LAS float*)wl;
#pragma unroll
        for (int nt = 0; nt < 2; ++nt)
#pragma unroll
            for (int rr = 0; rr < 16; ++rr) { const int tr = crow(rr, hh); wf[tr * 64 + tok + 32 * nt] = ga[nt][rr]; wf[2048 + tr * 64 + tok + 32 * nt] = gx[nt][rr]; }
        LDS_WAIT(); asm volatile("" ::: "memory");
        const float ba_ = in_b_rg_a[gc], bx_ = in_b_rg_x[gc], spc = log1pf(expf(-in_lam[gc]));
        float av[32], uv[32];
#pragma unroll
        for (int t = 0; t < 32; ++t) { const float pa = wf[t * 64 + lane] + ba_, px = wf[2048 + t * 64 + lane] + bx_;
            const float rg = __builtin_amdgcn_rcpf(1.0f + __builtin_amdgcn_exp2f(-1.4426950408889634f * pa)), ig = __builtin_amdgcn_rcpf(1.0f + __builtin_amdgcn_exp2f(-1.4426950408889634f * px));
            const float a = __builtin_amdgcn_exp2f((-8.0f * 1.4426950408889634f) * rg * spc);
            av[t] = a; uv[t] = __builtin_amdgcn_sqrtf(fmaxf(1.0f - a * a, 0.f)) * (ig * xc[t]); }
        LDS_WAIT(); asm volatile("" ::: "memory");
        float h = 0.f, P = 1.f;
#pragma unroll
        for (int t = 0; t < 32; ++t) { h = av[t] * h + uv[t]; P *= av[t]; }
        summ[(w * 64 + lane) * 2] = P; summ[(w * 64 + lane) * 2 + 1] = h;
        LDS_WAIT(); __syncthreads();
        const bf16* grp = P_GR + ((size_t)b * SEQ + t0) * DH + gc; bf16* op = P_MIX + ((size_t)b * SEQ + t0) * DM + DH + gc;
        float gv[32];
#pragma unroll
        for (int t = 0; t < 32; ++t) gv[t] = bf2f(grp[(size_t)t * DH]);
        LAS float* hspan = (LAS float*)(F.lds + TILE_OFF);
        if (w == 0) {
            float Pt = 1.f, Ht = 0.f;
#pragma unroll
            for (int q = 0; q < 8; ++q) { const float p = summ[(q * 64 + lane) * 2], hq = summ[(q * 64 + lane) * 2 + 1]; Ht = p * Ht + hq; Pt *= p; }
            unsigned long long* rx = (unsigned long long*)(F.ws + WS_CTL + (size_t)CW_RX * 4) + ((size_t)((b * 8 + n) * 16) * 64 + lane);
            __hip_atomic_store(rx + sp * 64, ((unsigned long long)__float_as_uint(Ht) << 32) | (unsigned long long)(__float_as_uint(Pt) | 1u), RLX_AGENT);
            unsigned long long v[15]; unsigned spins = 0u;
            for (;;) { bool ok = true;
#pragma unroll
                for (int q = 0; q < 15; ++q) { v[q] = q < sp ? __hip_atomic_load(rx + q * 64, RLX_AGENT) : 1ull; ok = ok && (v[q] != 0ull); }
                if (__all(ok)) break;
                __builtin_amdgcn_s_sleep(1); if (++spins > (1u << 20)) { if (lane == 0) __hip_atomic_store((unsigned*)(F.ws + WS_CTL) + CW_TMO, 0xA11u, RLX_AGENT); break; } }
            float hc = 0.f;
#pragma unroll
            for (int q = 0; q < 15; ++q) if (q < sp) hc = __uint_as_float((unsigned)v[q]) * hc + __uint_as_float((unsigned)(v[q] >> 32));
            hspan[lane] = hc;
        }
        LDS_WAIT(); __syncthreads();
        {   float hc = hspan[lane];
            for (int q = 0; q < w; ++q) hc = summ[(q * 64 + lane) * 2] * hc + summ[(q * 64 + lane) * 2 + 1];
            h = hc;
            asm volatile("s_waitcnt vmcnt(0)" ::: "memory");
#pragma unroll
            for (int t = 0; t < 32; ++t) { h = av[t] * h + uv[t]; const float g = gv[t]; const float y = 0.7978845608028654f * (g + 0.044715f * g * g * g);
                const float th = 1.0f - 2.0f * __builtin_amdgcn_rcpf(1.0f + __builtin_amdgcn_exp2f((2.0f * 1.4426950408889634f) * y)); op[(size_t)t * DM] = (bf16)f2bf(h * (0.5f * g * (1.0f + th))); }
        }
        asm volatile("s_waitcnt vmcnt(0)" ::: "memory");
        LDS_WAIT(); __syncthreads();
    }
}
typedef float cvt_f32x2 __attribute__((ext_vector_type(2))); typedef __bf16 cvt_bf16x2 __attribute__((ext_vector_type(2)));
__device__ __forceinline__ unsigned cvt2bf(float lo, float hi) { const cvt_f32x2 v = {lo, hi}; return __builtin_bit_cast(unsigned, __builtin_convertvector(v, cvt_bf16x2)); }
struct AttnUnit { int p, dsh, r, L0; size_t hb; };
__device__ __forceinline__ void attn_decode(int u, AttnUnit& a) {
    const int uu = u & 15, bh = (u >> 4) & 31; a.p = u >> 9; a.dsh = 2 * a.p;
    const int spr = 16 >> a.dsh;
    a.r = uu / spr; a.L0 = (uu % spr) * 256; a.hb = ((size_t)(bh >> 3) * SEQ) * DH + (bh & 7) * HD;
}
constexpr int ATT_KS = 144, ATT_VS = 192, ATT_VOFF = 384 * ATT_KS;
static_assert(ATT_VOFF + 384 * ATT_VS <= RING_BYTES, "attention LDS");
__device__ __forceinline__ void attn_items(Frame& F) {
    LAS unsigned char* kl = F.lds + RING_OFF; LAS unsigned char* vl = F.lds + RING_OFF + ATT_VOFF;
    const int lane = F.lane, c = lane & 31, hh = lane >> 5, w = F.wave, tid = F.tid;
    const float NEG = -1e30f;
    const int gi = lane >> 4, li = lane & 15;
    const int tr_base = (4 * hh + (li >> 2)) * ATT_VS + (16 * (gi & 1) + 4 * (li & 3)) * 2;
    const bf16 *QB = P_QB, *KB = P_KB, *VB = P_VB;
    constexpr int NUNIT = 3 * NB * NHEAD * 16;
    int u = F.vcu; if (u >= NUNIT) return;
    AttnUnit cu; attn_decode(u, cu);
    v4u kr[6], vr[6]; bf16x8 qn[4];
#define ATT_LOAD(A) do { _Pragma("unroll") for (int i = 0; i < 6; ++i) { const int cid = tid + 512 * i, rho = cid >> 3, ch = cid & 7; const int sub = (A).L0 - 128 + rho; \
        const int subc = sub < 0 ? 0 : sub; const size_t go = (A).hb + (size_t)((subc << (A).dsh) + (A).r) * DH + ch * 8; kr[i] = *(const GAS v4u*)(KB + go); vr[i] = *(const GAS v4u*)(VB + go); } \
        { const int tq = (((A).L0 + 32 * w + c) << (A).dsh) + (A).r; _Pragma("unroll") for (int s = 0; s < 4; ++s) qn[s] = *(const GAS bf16x8*)(QB + (A).hb + (size_t)tq * DH + 16 * s + 8 * hh); } } while (0)
    ATT_LOAD(cu);
    for (;;) {
#pragma unroll
        for (int i = 0; i < 6; ++i) { const int cid = tid + 512 * i, rho = cid >> 3, ch = cid & 7;
            *(LAS v4u*)(kl + rho * ATT_KS + ch * 16) = kr[i]; *(LAS v4u*)(vl + rho * ATT_VS + ch * 16) = vr[i]; }
        bf16x8 qf[4];
#pragma unroll
        for (int s = 0; s < 4; ++s) qf[s] = qn[s];
        const int un = u + F.G; const bool more = un < NUNIT; AttnUnit nx = cu;
        if (more) { attn_decode(un, nx); ATT_LOAD(nx); }
        LDS_WAIT(); __syncthreads();
        float m = NEG, l = 0.f; f32x16 o0 = f32x16{}, o1 = f32x16{};
        for (int j = 0; j < 5; ++j) {
            const int rho0 = 32 * w + 32 * j; if (cu.L0 - 128 + rho0 < 0) continue;
            bf16x8 kf[4];
#pragma unroll
            for (int s = 0; s < 4; ++s) kf[s] = *(const LAS bf16x8*)(kl + (rho0 + c) * ATT_KS + (16 * s + 8 * hh) * 2);
            f32x16 sc = f32x16{};
#pragma unroll
            for (int s = 0; s < 4; ++s) sc = __builtin_amdgcn_mfma_f32_32x32x16_bf16(kf[s], qf[s], sc, 0, 0, 0);
            if (j == 0) {
#pragma unroll
                for (int rr = 0; rr < 16; ++rr) if (crow(rr, hh) < c) sc[rr] = NEG;
            }
            if (j == 4) {
#pragma unroll
                for (int rr = 0; rr < 16; ++rr) if (crow(rr, hh) > c) sc[rr] = NEG;
            }
            float mx = fmaxf(fmaxf(sc[0], sc[1]), fmaxf(sc[2], sc[3]));
#pragma unroll
            for (int rr = 4; rr < 16; rr += 4) mx = fmaxf(mx, fmaxf(fmaxf(sc[rr], sc[rr + 1]), fmaxf(sc[rr + 2], sc[rr + 3])));
            mx = fmaxf(mx, __shfl_xor(mx, 32));
            if (__any(mx > m)) { const float mn = fmaxf(m, mx), alpha = __builtin_amdgcn_exp2f(m - mn); m = mn; l *= alpha;
#pragma unroll
                for (int rr = 0; rr < 16; ++rr) { o0[rr] *= alpha; o1[rr] *= alpha; } }
            float ps = 0.f;
#pragma unroll
            for (int rr = 0; rr < 16; ++rr) { sc[rr] = __builtin_amdgcn_exp2f(sc[rr] - m); ps += sc[rr]; }
            l += ps;
            v4u pb0, pb1;
            pb0.x = cvt2bf(sc[0], sc[1]); pb0.y = cvt2bf(sc[2], sc[3]); pb0.z = cvt2bf(sc[4], sc[5]); pb0.w = cvt2bf(sc[6], sc[7]);
            pb1.x = cvt2bf(sc[8], sc[9]); pb1.y = cvt2bf(sc[10], sc[11]); pb1.z = cvt2bf(sc[12], sc[13]); pb1.w = cvt2bf(sc[14], sc[15]);
            LAS unsigned char* vt = vl + rho0 * ATT_VS + tr_base;
#pragma unroll
            for (int dt = 0; dt < 2; ++dt)
#pragma unroll
                for (int s = 0; s < 2; ++s) {
                    const v4i16_t lo = __builtin_amdgcn_ds_read_tr16_b64_v4i16((LAS v4i16_t*)(vt + (16 * s) * ATT_VS + 64 * dt));
                    const v4i16_t hi = __builtin_amdgcn_ds_read_tr16_b64_v4i16((LAS v4i16_t*)(vt + (16 * s + 8) * ATT_VS + 64 * dt));
                    const bf16x8 af = (bf16x8){lo[0], lo[1], lo[2], lo[3], hi[0], hi[1], hi[2], hi[3]};
                    const bf16x8 pf = __builtin_bit_cast(bf16x8, s ? pb1 : pb0);
                    if (dt == 0) o0 = __builtin_amdgcn_mfma_f32_32x32x16_bf16(af, pf, o0, 0, 0, 0); else o1 = __builtin_amdgcn_mfma_f32_32x32x16_bf16(af, pf, o1, 0, 0, 0);
                }
        }
        asm volatile("s_waitcnt vmcnt(0)" ::: "memory");
        {   l += __shfl_xor(l, 32);
            const float inv = 1.0f / l;
            const int tq = ((cu.L0 + 32 * w + c) << cu.dsh) + cu.r;
            bf16* op = P_OP + (size_t)cu.p * TT * DH + cu.hb + (size_t)tq * DH;
#pragma unroll
            for (int g4 = 0; g4 < 4; ++g4) {
                v2u w0, w1; w0.x = cvt2bf(o0[4 * g4] * inv, o0[4 * g4 + 1] * inv); w0.y = cvt2bf(o0[4 * g4 + 2] * inv, o0[4 * g4 + 3] * inv);
                w1.x = cvt2bf(o1[4 * g4] * inv, o1[4 * g4 + 1] * inv); w1.y = cvt2bf(o1[4 * g4 + 2] * inv, o1[4 * g4 + 3] * inv);
                *(GAS v2u*)(op + 8 * g4 + 4 * hh) = w0; *(GAS v2u*)(op + 32 + 8 * g4 + 4 * hh) = w1; }
            if (hh == 0) P_LSE[(((size_t)cu.p * TT * DH + cu.hb + (size_t)tq * DH) >> 6)] = m + __builtin_amdgcn_logf(l); }
        LDS_WAIT(); __syncthreads();
        if (!more) break;
        u = un; cu = nx;
    }
#undef ATT_LOAD
}
__device__ __forceinline__ void attn_merge(Frame& F) {
    const int gt = F.vcu * (NWAVES * 64) + F.tid, NGT = F.G * NWAVES * 64;
    for (int idx = gt; idx < TT * 64; idx += NGT) {
        const int t = idx >> 6, ch = idx & 63, h = ch >> 3;
        const float l0 = P_LSE[(size_t)t * NHEAD + h], l1 = P_LSE[((size_t)TT + t) * NHEAD + h], l2 = P_LSE[((size_t)2 * TT + t) * NHEAD + h];
        const float mx = fmaxf(l0, fmaxf(l1, l2));
        float w0 = __builtin_amdgcn_exp2f(l0 - mx), w1 = __builtin_amdgcn_exp2f(l1 - mx), w2 = __builtin_amdgcn_exp2f(l2 - mx);
        const float inv = 1.0f / (w0 + w1 + w2); w0 *= inv; w1 *= inv; w2 *= inv;
        const v4u a = *(const GAS v4u*)(P_OP + (size_t)t * DH + ch * 8), bq = *(const GAS v4u*)(P_OP + ((size_t)TT + t) * DH + ch * 8), cq = *(const GAS v4u*)(P_OP + ((size_t)2 * TT + t) * DH + ch * 8);
        v4u o;
#pragma unroll
        for (int k = 0; k < 4; ++k) {
            const float lo = w0 * bf2f((unsigned short)(a[k] & 0xffffu)) + w1 * bf2f((unsigned short)(bq[k] & 0xffffu)) + w2 * bf2f((unsigned short)(cq[k] & 0xffffu));
            const float hi = w0 * bf2f((unsigned short)(a[k] >> 16)) + w1 * bf2f((unsigned short)(bq[k] >> 16)) + w2 * bf2f((unsigned short)(cq[k] >> 16));
            o[k] = pk2(lo, hi); }
        *(GAS v4u*)(P_MIX + (size_t)t * DM + ch * 8) = o;
        asm volatile("" ::: "memory");
    }
}

#ifndef ROUTER_SPLIT
#define ROUTER_SPLIT 2
#endif
__device__ __forceinline__ void p6_rows(Frame& F, int only = 0) {
    typedef float f32x2 __attribute__((ext_vector_type(2)));
    const float* in_g_ffn = F.in(I_g_ffn); const float* in_b_router = F.in(I_b_router);
    constexpr int RS = ROUTER_SPLIT;
    const bool split = (F.G % RS) == 0;
    if (split && (F.vcu % RS) != 0) { if (only != 1) p0_transposes(F, 0, PT_WGU, (F.vcu / RS) * (RS - 1) + (F.vcu % RS) - 1, (F.G / RS) * (RS - 1)); return; }
    const int rrank = split ? F.vcu / RS : F.vcu, rn = split ? F.G / RS : F.G;
    if (only >= 2) return;
    LAS float* wl = (LAS float*)(F.lds + RING_OFF);
    LAS int* wc = (LAS int*)(F.lds + SUMM_OFF);
    for (int i = F.tid; i < NEXP * DM / 4; i += NWAVES * 64) ((LAS f32x4*)wl)[i] = ((const GAS f32x4*)P_WRT)[i];
    LDS_WAIT(); __syncthreads();
    const int lane = F.lane, w = F.wave, el = lane & 15, qsh = lane & 48;
    const float biasA = in_b_router[el], biasB = in_b_router[16 + el];
    const __amdgpu_buffer_rsrc_t rs_x1 = __builtin_amdgcn_make_buffer_rsrc((void*)P_X1, 0, 0x7ffffff0, 0x00020000), rs_h8 = __builtin_amdgcn_make_buffer_rsrc((void*)P_XN8, 0, 0x7ffffff0, 0x00020000);
    typedef unsigned u32x4_t __attribute__((ext_vector_type(4)));
#define P6_LOADROW(dst, m) do { _Pragma("unroll") for (int j_ = 0; j_ < 4; ++j_) (dst)[j_] = __builtin_bit_cast(f32x4, __builtin_amdgcn_raw_buffer_load_b128(rs_x1, lane * 16 + j_ * 1024, (m) * (DM * 4), 0)); } while (0)
    f32x4 xa[4][4];
    if (rrank < TT / 64) {
#pragma unroll
      for (int q = 0; q < 4; ++q) P6_LOADROW(xa[q], rrank * 64 + w * 8 + q); }
    for (int chunk = rrank; chunk < TT / 64; chunk += rn) {
      int wcount = 0;
      const int b = (chunk * 64) / SEQ;
      const float* mb = P_MOD + (size_t)b * NMOD;
      const int m0 = chunk * 64 + w * 8;
#pragma nounroll
      for (int st = 0; st < 2; ++st) {
        const int m4 = m0 + 4 * st;
        f32x4 v[4][4];
        { float ra[4];
#pragma unroll
          for (int q = 0; q < 4; ++q) { float sa = 0.f;
#pragma unroll
              for (int j = 0; j < 4; ++j) sa += (xa[q][j].x * xa[q][j].x + xa[q][j].y * xa[q][j].y) + (xa[q][j].z * xa[q][j].z + xa[q][j].w * xa[q][j].w);
              ra[q] = 1.0f / sqrtf(wave_sum(sa) * (1.0f / DM) + NORM_EPS); }
#pragma unroll
          for (int j = 0; j < 4; ++j) { const int col = 4 * lane + 256 * j;
              const f32x4 Gm = *(const f32x4*)(in_g_ffn + col) * (*(const f32x4*)(mb + 4 * DM + col) + 1.0f), Sm = *(const f32x4*)(mb + 3 * DM + col);
#pragma unroll
              for (int q = 0; q < 4; ++q) { v[q][j] = (xa[q][j] * ra[q]) * Gm + Sm;
                  __builtin_amdgcn_raw_buffer_store_b32(pg8::pk4_fp8(v[q][j].x * SC_H, v[q][j].y * SC_H, v[q][j].z * SC_H, v[q][j].w * SC_H), rs_h8, lane * 4 + j * 256, (m4 + q) * DM, 0); } } }
        float val[2];
#pragma unroll
        for (int hf = 0; hf < 2; ++hf) {
          float k16[16], k8[8], k4[4], k2[2], k1;
          const bool up32 = (lane & 32) != 0, up16 = (lane & 16) != 0;
#pragma unroll
          for (int e16 = 0; e16 < 16; ++e16) { const int e = hf * 16 + e16; f32x4 w4[4]; float p[4];
#pragma unroll
              for (int j = 0; j < 4; ++j) w4[j] = *(const LAS f32x4*)(wl + e * DM + 4 * lane + 256 * j);
#pragma unroll
              for (int q = 0; q < 4; ++q) { f32x2 a0 = (f32x2){0.f, 0.f};
#pragma unroll
                  for (int j = 0; j < 4; ++j) { a0 += (f32x2){v[q][j].x, v[q][j].y} * (f32x2){w4[j].x, w4[j].y}; a0 += (f32x2){v[q][j].z, v[q][j].w} * (f32x2){w4[j].z, w4[j].w}; }
                  p[q] = a0.x + a0.y; }
              const float sA = (up32 ? p[2] : p[0]) + __shfl_xor(up32 ? p[0] : p[2], 32), sB = (up32 ? p[3] : p[1]) + __shfl_xor(up32 ? p[1] : p[3], 32);
              k16[e16] = (up16 ? sB : sA) + __shfl_xor(up16 ? sA : sB, 16);
              if (e16 > 1) asm volatile("" : "+v"(k16[e16 - 2]));
              if ((e16 & 3) == 3) asm volatile("" ::: "memory"); }
          { const bool up = (lane & 8) != 0;
#pragma unroll
            for (int i = 0; i < 8; ++i) { const float keep = up ? k16[8 + i] : k16[i], send = up ? k16[i] : k16[8 + i]; k8[i] = keep + __shfl_xor(send, 8); } }
          { const bool up = (lane & 4) != 0;
#pragma unroll
            for (int i = 0; i < 4; ++i) { const float keep = up ? k8[4 + i] : k8[i], send = up ? k8[i] : k8[4 + i]; k4[i] = keep + __shfl_xor(send, 4); } }
          { const bool up = (lane & 2) != 0;
#pragma unroll
            for (int i = 0; i < 2; ++i) { const float keep = up ? k4[2 + i] : k4[i], send = up ? k4[i] : k4[2 + i]; k2[i] = keep + __shfl_xor(send, 2); } }
          { const bool up = (lane & 1) != 0; const float keep = up ? k2[1] : k2[0], send = up ? k2[0] : k2[1]; k1 = keep + __shfl_xor(send, 1); }
          val[hf] = k1 + (hf ? biasB : biasA);
        }
        {
            const int mn = st == 0 ? m4 + 4 : (chunk + rn < TT / 64 ? (chunk + rn) * 64 + w * 8 : m0);
#pragma unroll
            for (int q = 0; q < 4; ++q) P6_LOADROW(xa[q], mn + q); }
        float tv[4]; int te[4];
#pragma unroll
        for (int r = 0; r < 4; ++r) { float mx = fmaxf(val[0], val[1]);
            mx = fmaxf(mx, __shfl_xor(mx, 1)); mx = fmaxf(mx, __shfl_xor(mx, 2)); mx = fmaxf(mx, __shfl_xor(mx, 4)); mx = fmaxf(mx, __shfl_xor(mx, 8));
            const unsigned long long bA = __ballot(val[0] == mx), bB = __ballot(val[1] == mx);
            const unsigned mA = (unsigned)(bA >> qsh) & 0xffffu, mB = (unsigned)(bB >> qsh) & 0xffffu;
            const int e = mA ? __builtin_ctz(mA) : 16 + __builtin_ctz(mB | 0x10000u);
            te[r] = e; tv[r] = mx;
            if (el == (e & 15)) { if (e < 16) val[0] = -INFINITY; else val[1] = -INFINITY; } }
        const float e1 = expf(tv[1] - tv[0]), e2 = expf(tv[2] - tv[0]), e3 = expf(tv[3] - tv[0]); const float inv = 1.0f / (1.0f + e1 + e2 + e3);
        int lpv = 0;
#pragma unroll
        for (int q = 0; q < 4; ++q)
#pragma unroll
          for (int r = 0; r < 4; ++r) { const int es = __builtin_amdgcn_readlane(te[r], 16 * q); const int lp = __builtin_amdgcn_readlane(wcount, es);
              if (lane == es) ++wcount; if (lane == 16 * q + r) lpv = lp; }
        if (el < 4) { const int q = lane >> 4, m = m4 + q, ti = 4 * st + q;
            const int e = el == 0 ? te[0] : el == 1 ? te[1] : el == 2 ? te[2] : te[3];
            const float g = (el == 0 ? 1.0f : el == 1 ? e1 : el == 2 ? e2 : e3) * inv;
            P_TOK_E[m * 4 + el] = e; P_TOK_GATE[m * 4 + el] = g;
            wc[512 + ((w * 8 + ti) * 4 + el) * 2] = e; wc[512 + ((w * 8 + ti) * 4 + el) * 2 + 1] = lpv; }
      }
      if (lane < 32) wc[w * 32 + lane] = wcount;
      LDS_WAIT(); __syncthreads();
      if (lane < 32) { int pre = 0; for (int q = 0; q < w; ++q) pre += wc[q * 32 + lane]; wc[256 + w * 32 + lane] = pre;
          if (w == 7) P_BCNT[chunk * 32 + lane] = pre + wcount; }
      LDS_WAIT(); asm volatile("" ::: "memory");
      if (lane < 32) { const int ti = lane >> 2, r = lane & 3; const int e = wc[512 + ((w * 8 + ti) * 4 + r) * 2], l = wc[512 + ((w * 8 + ti) * 4 + r) * 2 + 1];
          P_TOK_POS[(chunk * 64 + w * 8 + ti) * 4 + r] = wc[256 + w * 32 + e] + l; }
      asm volatile("s_waitcnt vmcnt(0)" ::: "memory");
      LDS_WAIT(); __syncthreads();
    }
#undef P6_LOADROW
}
__device__ __forceinline__ void p7_gather(Frame& F) {
    LAS int* pt = (LAS int*)(F.lds + RING_OFF);
    volatile LAS int* lb = (volatile LAS int*)(F.lds + TILE_OFF);
    { const int e = F.tid & 31, seg = F.tid >> 5; int s = 0;
      for (int j = 0; j < 16; ++j) s += P_BCNT[(seg * 16 + j) * 32 + e];
      pt[8192 + seg * 32 + e] = s; LDS_WAIT(); __syncthreads();
      int base = 0, tot = 0; for (int q = 0; q < 16; ++q) { const int x = pt[8192 + q * 32 + e]; if (q < seg) base += x; tot += x; }
      for (int j = 0; j < 16; ++j) { pt[(seg * 16 + j) * 32 + e] = base; base += P_BCNT[(seg * 16 + j) * 32 + e]; }
      if (seg == 0) lb[64 + e] = tot; }
    LDS_WAIT(); __syncthreads();
    if (F.tid == 0) { int acc = 0, nt = 0;
        for (int e = 0; e < NEXP; ++e) { const int c = lb[64 + e]; lb[e] = acc; const int tiles = (c + 255) >> 8;
            if (blockIdx.x == 0) for (int k = 0; k < tiles; ++k) P_TILE_E[nt + k] = e;
            nt += tiles; acc += tiles * 256; }
        lb[32] = acc; if (blockIdx.x == 0) P_TILE_N[0] = nt; }
    LDS_WAIT(); __syncthreads();
    const int gt = F.vcu * (NWAVES * 64) + F.tid, NGT = F.G * NWAVES * 64;
    for (int idx = gt; idx < TT * TOPK + NEXP * 256; idx += NGT) {
        if (idx < TT * TOPK) { const int e = P_TOK_E[idx], pos = P_TOK_POS[idx]; const int slot = lb[e] + pt[(idx >> 8) * 32 + e] + pos; P_TOK_SLOT[idx] = slot; P_SLOT_TOK[slot] = idx >> 2; }
        else { const int q = idx - TT * TOPK, e = q >> 8, i = q & 255; const int c = lb[64 + e]; const int padded = ((c + 255) >> 8) << 8; if (c + i < padded) P_SLOT_TOK[lb[e] + c + i] = TT; }
    }
    if (blockIdx.x == 0 && F.tid < 64) ((GAS v4u*)(P_XN8 + (size_t)TT * DM))[F.tid] = (v4u){0u, 0u, 0u, 0u};
    asm volatile("s_waitcnt vmcnt(0)" ::: "memory");
    LDS_WAIT(); __syncthreads();
    if (F.G % ROUTER_SPLIT) p0_transposes(F, 0, PT_WGU);
}
__device__ __forceinline__ void p10_final(Frame& F) {
    const float* in_g_final = F.in(I_g_final); float* out_p = (float*)F.in(22);
    const int gw = F.vcu * NWAVES + F.wave, NGW = F.G * NWAVES, lane = F.lane;
    const bf16* Y2 = P_Y2;
    for (int m = gw; m < TT; m += NGW) {
        const int b = m / SEQ;
        const GAS f32x4* xr = (const GAS f32x4*)(P_X1 + (size_t)m * DM) + lane;
        f32x4 v[4], a[4];
#pragma unroll
        for (int j = 0; j < 4; ++j) { v[j] = xr[64 * j]; a[j] = (f32x4){0.f, 0.f, 0.f, 0.f}; }
#pragma unroll
        for (int k = 0; k < 4; ++k) { const int slot = P_TOK_SLOT[m * 4 + k]; const float g = P_TOK_GATE[m * 4 + k];
            const GAS v2u* yr = (const GAS v2u*)(Y2 + (size_t)slot * DM) + lane;
#pragma unroll
            for (int j = 0; j < 4; ++j) { const v2u y = yr[64 * j];
                a[j].x += g * bf2f((unsigned short)(y.x & 0xffffu)); a[j].y += g * bf2f((unsigned short)(y.x >> 16)); a[j].z += g * bf2f((unsigned short)(y.y & 0xffffu)); a[j].w += g * bf2f((unsigned short)(y.y >> 16)); } }
        const float* gf = P_MOD + (size_t)b * NMOD + 5 * DM; float ss = 0.f;
#pragma unroll
        for (int j = 0; j < 4; ++j) { const f32x4 gt = *(const f32x4*)(gf + 4 * lane + 256 * j); v[j] = v[j] + gt * a[j]; ss += (v[j].x * v[j].x + v[j].y * v[j].y) + (v[j].z * v[j].z + v[j].w * v[j].w); }
        const float rstd = 1.0f / sqrtf(wave_sum(ss) * (1.0f / DM) + NORM_EPS);
        GAS f32x4* orow = (GAS f32x4*)(out_p + (size_t)m * DM) + lane;
#pragma unroll
        for (int j = 0; j < 4; ++j) { const f32x4 g = *(const f32x4*)(in_g_final + 4 * lane + 256 * j); orow[64 * j] = (v[j] * rstd) * g; }        asm volatile("" ::: "memory");
    }
}

#ifndef DUP_MASK
#define DUP_MASK 0
#endif
struct Args { const float* in[22]; float* out; unsigned char* ws; int ph_lo, ph_hi, li, pad; };
__global__ void __launch_bounds__(NWAVES * 64, 2) hymba_fwd(Args args) {
    extern __shared__ __attribute__((aligned(16))) unsigned char lds[];
    Frame F;
    F.lds = (LAS unsigned char*)lds;
    F.tid = threadIdx.x; F.lane = F.tid & 63; F.wave = __builtin_amdgcn_readfirstlane(F.tid >> 6);
    F.G = gridDim.x; { const int bx = blockIdx.x; F.vcu = (F.G % 8 == 0) ? (bx % 8) * (F.G / 8) + bx / 8 : bx; }
    unsigned char* ws = args.ws;
    F.ws = ws; F.ka = (const __attribute__((address_space(4))) void*)__builtin_amdgcn_kernarg_segment_ptr();
    for (int u = F.tid; u < (LDS_BYTES - LDSCTL_OFF) / 4; u += NWAVES * 64) ((LAS unsigned*)(F.lds + LDSCTL_OFF))[u] = 0u;
    __syncthreads();
#define CTLP ((gu32*)(F.ws + WS_CTL))
#define MISCP ((volatile LAS unsigned*)(F.lds + MISC_OFF))
    if (N_LAUNCHES != PER_PHASE) (void)xcd_barrier_post((unsigned*)(CTLP + CW_BAR), MISCP + 8);
#define GRID_BAR(seam) do { if (N_LAUNCHES == PER_PHASE) { if (F.tid == 0) __hip_atomic_store(CTLP + CW_TMO, 0xBADBA0u | (unsigned)(seam), RLX_AGENT); } \
    else { XcdBarrier bar_; bar_.bar = (unsigned*)(CTLP + CW_BAR); bar_.x = xb_xcc_id(); bar_.st = MISCP + 8; xcd_barrier(bar_); if (DUPK(13)) xcd_barrier(bar_); } asm volatile("" : "+v"(F.tid), "+v"(F.lane)); } while (0)
    const int lo = (N_LAUNCHES == 1) ? 0 : args.ph_lo, hi = (N_LAUNCHES == 1) ? PER_PHASE : args.ph_hi;
#ifndef PHASE_MASK
#define PHASE_MASK 0x7ff
#endif
#define IN(k) (((PHASE_MASK >> (k)) & 1) && lo <= (k) && (k) < hi)
#define BOTH(k) (IN(k) && IN((k) + 1))
#define DUPK(k) ((DUP_MASK >> (k)) & 1)
#define RUN_P2() do { pg8::Gemm g{P_XN, P_WIN_T, TT, INCOLS, DM}; pg8::StaticOrder S; S.init(TT, INCOLS, F.G, (int)blockIdx.x); \
        pg8::EpiBf16<0> E{P_QB, DH, nullptr, DH, (size_t)TT * DH, C2}; \
        pg8::gemm_phase<pg8::EpiBf16<0>, pg8::StaticOrder, true, true>(F.lds + RING_OFF, g, S, E); } while (0)
#define RUN_P5() do { pg8::Gemm g{P_MIX, P_WOUT_T, TT, DM, DM}; pg8::StaticOrder S; S.init(TT, DM, F.G, (int)blockIdx.x); \
        pg8::EpiResGate E{F.in(I_x), P_X1, DM, P_MOD + 2 * DM, NMOD, SEQ}; \
        pg8::gemm_phase<pg8::EpiResGate, pg8::StaticOrder, true, true>(F.lds + RING_OFF, g, S, E); } while (0)
#define RUN_P8() do { const int ntm = P_TILE_N[0]; \
        pg8::Gemm g{(const pg8::bf16_t*)P_XN8, (const pg8::bf16_t*)P_WGU8, ntm * 256, DE2, DM / 2}; pg8::GroupedOrder S; S.init(P_TILE_E, ntm, 8, F.G, (int)blockIdx.x); \
        LAS int* rt = (LAS int*)(F.lds + ROWTAB_OFF); { pg8::Unit u_; for (int i_ = 0; i_ < ROWTAB_UNITS && S.next(i_, u_); ++i_) if (F.tid < 256) rt[i_ * 256 + F.tid] = P_SLOT_TOK[u_.pm * 256 + F.tid] * DM; } \
        LDS_WAIT(); __syncthreads(); \
        pg8::EpiSwiglu E{P_ACT8, F.in(I_b_gate_up), 1.0f / (SC_H * SC_W), SC_ACT}; \
        pg8::gemm_phase<pg8::EpiSwiglu, pg8::GroupedOrder, true, true, true, true>(F.lds + RING_OFF, g, S, E, rt); \
        asm volatile("s_waitcnt vmcnt(0)" ::: "memory"); __syncthreads(); p0_transposes(F, PT_WGU, P0T_EXPERTS); } while (0)
#define RUN_P9() do { const int ntm = P_TILE_N[0]; \
        pg8::Gemm g{(const pg8::bf16_t*)P_ACT8, (const pg8::bf16_t*)P_WD8, ntm * 256, DM, DM / 2}; pg8::GroupedOrder S; S.init(P_TILE_E, ntm, 4, F.G, (int)blockIdx.x); \
        pg8::EpiDown E{P_Y2, F.in(I_b_down), 1.0f / (SC_ACT * SC_W)}; \
        pg8::gemm_phase<pg8::EpiDown, pg8::GroupedOrder, true, true, true>(F.lds + RING_OFF, g, S, E); } while (0)
    if (IN(0)) { p0_prologue(F); if (BOTH(0)) GRID_BAR(0); if (DUPK(0)) { p0_prologue(F); GRID_BAR(0); } }
    if (IN(1)) { p1_norm(F); if (BOTH(1)) GRID_BAR(1); if (DUPK(1)) { p1_norm(F); GRID_BAR(1); } }
    if (IN(2)) { RUN_P2(); if (BOTH(2)) GRID_BAR(2); if (DUPK(2)) { RUN_P2(); GRID_BAR(2); } }
    if (IN(3)) { rglru_single(F); attn_items(F); if (BOTH(3)) GRID_BAR(3);  if (DUPK(11)) { attn_items(F); GRID_BAR(3); }  }
    if (IN(4)) { attn_merge(F); if (BOTH(4)) GRID_BAR(4); if (DUPK(4)) { attn_merge(F); GRID_BAR(4); } }
    if (IN(5)) { RUN_P5(); if (BOTH(5)) GRID_BAR(5); if (DUPK(5)) { RUN_P5(); GRID_BAR(5); } }
    if (IN(6)) { p6_rows(F); if (BOTH(6)) GRID_BAR(6); if (DUPK(6)) { p6_rows(F); GRID_BAR(6); } if (DUPK(14)) { p6_rows(F, 1); GRID_BAR(6); } if (DUPK(15)) { p6_rows(F, 2); GRID_BAR(6); } }
    if (IN(7)) { p7_gather(F); if (BOTH(7)) GRID_BAR(7); if (DUPK(7)) { p7_gather(F); GRID_BAR(7); } }
    if (IN(8)) { RUN_P8(); if (BOTH(8)) GRID_BAR(8); if (DUPK(8)) { RUN_P8(); GRID_BAR(8); } }
    if (IN(9)) { RUN_P9(); if (BOTH(9)) GRID_BAR(9); if (DUPK(9)) { RUN_P9(); GRID_BAR(9); } }
    if (IN(10)) { p10_final(F); if (DUPK(10)) { GRID_BAR(10); p10_final(F); } }
#undef IN
#undef BOTH
}

extern "C" void kernel_launch(void* const* d_in, const int* in_sizes, int n_in, void* d_out, int out_size, void* d_ws, size_t ws_size, hipStream_t stream) {
    static int grid = 0;
    if (grid == 0) {
        if (n_in != 22 || in_sizes[0] != TT * DM || out_size != TT * DM || ws_size < WS_END) { fprintf(stderr, "kernel_launch: unexpected shapes (n_in %d, in0 %d, out %d, ws %zu); nothing launched\n", n_in, n_in > 0 ? in_sizes[0] : -1, out_size, ws_size); grid = -1; return; }
        int dev = 0, cus = 0, per_cu = 0;
        if (hipGetDevice(&dev) != hipSuccess || hipDeviceGetAttribute(&cus, hipDeviceAttributeMultiprocessorCount, dev) != hipSuccess) { fprintf(stderr, "kernel_launch: device query failed\n"); grid = -1; return; }
        if (hipFuncSetAttribute((const void*)hymba_fwd, hipFuncAttributeMaxDynamicSharedMemorySize, LDS_BYTES) != hipSuccess) { fprintf(stderr, "kernel_launch: hipFuncSetAttribute failed\n"); grid = -1; return; }
        if (hipOccupancyMaxActiveBlocksPerMultiprocessor(&per_cu, (const void*)hymba_fwd, NWAVES * 64, LDS_BYTES) != hipSuccess || per_cu < 1) { fprintf(stderr, "kernel_launch: occupancy query reports %d workgroups per CU\n", per_cu); per_cu = 1; }
        (void)hipGetLastError();
        if (cus < 256) { fprintf(stderr, "kernel_launch: built for a 256-CU device (one workgroup per CU), found %d CUs; nothing launched\n", cus); grid = -1; return; }
        grid = 256;
    }
    if (grid < 0) return;
    if (hipMemsetAsync((char*)d_ws + WS_CTL, 0, CTL_ZERO_BYTES, stream) != hipSuccess) { fprintf(stderr, "kernel_launch: memset failed\n"); return; }
    Args a{};
    for (int i = 0; i < 22; ++i) a.in[i] = (const float*)d_in[i];
    a.out = (float*)d_out; a.ws = (unsigned char*)d_ws; a.pad = DUP_MASK;
    for (int li = 0; li < N_LAUNCHES; ++li) {
        a.ph_lo = (N_LAUNCHES == PER_PHASE) ? li : 0; a.ph_hi = (N_LAUNCHES == PER_PHASE) ? li + 1 : PER_PHASE; a.li = li;
        hipLaunchKernelGGL(hymba_fwd, dim3(grid), dim3(NWAVES * 64), LDS_BYTES, stream, a);
        const hipError_t le = hipPeekAtLastError();
        if (le != hipSuccess) { fprintf(stderr, "kernel_launch: launch %d failed: %s\n", li, hipGetErrorName(le)); break; }
    }
}
```

```cpp
#include <hip/hip_runtime.h>
#include <cstdio>
#include <cstdint>
#define MK_N_LAUNCHES 1
#define DUP_MASK 0
namespace pg8 {
#define PG8_LAS __attribute__((address_space(3)))
typedef unsigned short bf16_t;
typedef short bf16x8 __attribute__((ext_vector_type(8)));
typedef float f32x4 __attribute__((ext_vector_type(4)));
typedef unsigned u32x4 __attribute__((ext_vector_type(4)));
constexpr int BM = 256, BK = 64, HALF = 128, HTB = HALF * BK * 2  , STAGE_BYTES = 8 * HTB, NXCD = 8, WGM = 8;

__host__ __device__ __forceinline__ int lds_byte(int r, int c) { const int st = (r >> 4) * 2 + (c >> 5), rr = r & 15, cc = c & 31, ob = rr * 64 + cc * 2; return st * 1024 + (ob ^ (((ob >> 9) & 1) << 5)); }
__host__ __device__ __forceinline__ void stage_rc(int b, int& R, int& C) { const int st = b / 1024, sb = b % 1024, swz = sb ^ (((sb >> 9) & 1) << 5); R = (st >> 1) * 16 + swz / 64; C = (st & 1) * 32 + (swz % 64) / 2; }
__host__ __device__ __forceinline__ int perm32(int rho) { const int n = rho >> 4, i = rho & 15; return 8 * (i >> 2) + 4 * n + (i & 3); }

struct Unit { int pm, pn; };
struct Gemm { const bf16_t* A; const bf16_t* Bt; int M, N, K; };

struct StaticOrder {
    int nM, nN, nwg, G, c;
    __host__ __device__ void init(int M, int N, int G_, int c_) { nM = M / BM; nN = N / BM; nwg = nM * nN; G = G_; c = c_; }
    __host__ __device__ bool next(int i, Unit& u) const {
        const long L = (long)i * G + c; if (L >= nwg) return false;
        int wgid = (int)L; { const int q = nwg / NXCD, r = nwg % NXCD, xcd = wgid % NXCD, off = wgid / NXCD; wgid = (xcd < r ? xcd * (q + 1) : r * (q + 1) + (xcd - r) * q) + off; }
        const int nig = WGM * nN, gid = wgid / nig, fm = gid * WGM, gsz = (nM - fm) < WGM ? (nM - fm) : WGM;
        u.pm = fm + ((wgid % nig) % gsz); u.pn = (wgid % nig) / gsz; return true;
    }
    __device__ __forceinline__ void a_ready(const Unit&) const {}
    __device__ __forceinline__ void done(const Unit&) const {}
};

typedef float cvtf32x2_t __attribute__((ext_vector_type(2))); typedef __bf16 cvtbf16x2_t __attribute__((ext_vector_type(2)));
__device__ __forceinline__ unsigned cvt_pk_bf16(float lo, float hi) { const cvtf32x2_t v = {lo, hi}; return __builtin_bit_cast(unsigned, __builtin_convertvector(v, cvtbf16x2_t)); }
typedef float f32x2 __attribute__((ext_vector_type(2)));
__device__ __forceinline__ f32x2 gelu_pk(f32x2 v) {
    const f32x2 av = __builtin_elementwise_abs(v), d = av * 0.2316418882f + 1.0f;
    f32x2 t; t.x = __builtin_amdgcn_rcpf(d.x); t.y = __builtin_amdgcn_rcpf(d.y);
    f32x2 q = t * 0.5307027145f + (-0.7265760135f); q = q * t + 0.7107068705f; q = q * t + (-0.142248368f); q = q * t + 0.127414796f; q = q * t;
    const f32x2 s = (v * v) * (-0.72134752044f);
    f32x2 e; e.x = __builtin_amdgcn_exp2f(s.x); e.y = __builtin_amdgcn_exp2f(s.y);
    const f32x2 m = v * (q * e), r = v - m;
    f32x2 o; o.x = v.x < 0.f ? m.x : r.x; o.y = v.y < 0.f ? m.y : r.y; return o;
}

template <int ACT  > struct EpiBf16 {
    static constexpr bool PERM = true, AFTER_DRAIN = false; static_assert(ACT == 0 || ACT == 1, "EpiBf16: ACT is 0 (none) or 1 (gelu_pk)");
    bf16_t* O; int ldc; const float* bias; int split_cols; size_t split_stride; float scale0;
    __device__ __forceinline__ void operator()(const f32x4 (&acc)[2][2][4][2], const Unit& u, int wr, int wc, int fr, int fq) const {
        const int row0 = u.pm * BM + wr * 64 + fr; int colt = u.pn * BM; bf16_t* base = O;
        float sc = 1.f; if (split_cols) { const int t = colt / split_cols; base += (size_t)t * split_stride; colt -= t * split_cols; if (t == 0) sc = scale0; }
        const int col0 = colt + wc * 32 + 8 * fq, bcol0 = u.pn * BM + wc * 32 + 8 * fq;
        f32x4 bv[2][2];
#pragma unroll
        for (int bj = 0; bj < 2; ++bj)
#pragma unroll
            for (int n = 0; n < 2; ++n) bv[bj][n] = bias ? *(const f32x4*)(bias + bcol0 + bj * HALF + 4 * n) : (f32x4){0.f, 0.f, 0.f, 0.f};
#pragma unroll
        for (int ai = 0; ai < 2; ++ai)
#pragma unroll
            for (int m = 0; m < 4; ++m) { bf16_t* rowp = base + (size_t)(row0 + ai * HALF + m * 16) * ldc + col0;
#pragma unroll
                for (int bj = 0; bj < 2; ++bj) { f32x4 v0 = acc[ai][bj][m][0] + bv[bj][0], v1 = acc[ai][bj][m][1] + bv[bj][1];
                    if (ACT == 1) { f32x2 a = gelu_pk((f32x2){v0[0], v0[1]}), b = gelu_pk((f32x2){v0[2], v0[3]}), c = gelu_pk((f32x2){v1[0], v1[1]}), d = gelu_pk((f32x2){v1[2], v1[3]});
                        v0 = (f32x4){a.x, a.y, b.x, b.y}; v1 = (f32x4){c.x, c.y, d.x, d.y}; }
                    v0 = v0 * sc; v1 = v1 * sc; u32x4 w; w.x = cvt_pk_bf16(v0[0], v0[1]); w.y = cvt_pk_bf16(v0[2], v0[3]); w.z = cvt_pk_bf16(v1[0], v1[1]); w.w = cvt_pk_bf16(v1[2], v1[3]);
                    *(u32x4*)(rowp + bj * HALF) = w; } }
    }
};
template <class Epi, class Sched, bool ALIGN_EPI = false, bool SP2 = false, bool FP8 = false, bool GATHER = false>
__device__ __forceinline__ void gemm_phase(PG8_LAS unsigned char* lds, const Gemm g, const Sched& S, const Epi& E, const PG8_LAS int* rowtab = nullptr) {
    int tid_ = threadIdx.x; asm volatile("" : "+v"(tid_));
    const int tid = tid_, wid = __builtin_amdgcn_readfirstlane(tid >> 6), lane = tid & 63, wr = wid >> 2, wc = wid & 3, fr = lane & 15, fq = lane >> 4;
    const int K = g.K, nt = K / BK;
    unsigned voffA, voffB;
    { int R, C; stage_rc(tid * 16, R, C); const int Rb = Epi::PERM ? ((R & ~31) + perm32(R & 31)) : R; voffA = (unsigned)(R * K + C) * 2u; voffB = (unsigned)(Rb * K + C) * 2u; }
    const unsigned qstep = 64u * K * 2;
    const unsigned kstep = (unsigned)(BK * 2);
    const unsigned hstep = (unsigned)HALF * K * 2;
    const unsigned tstep = 2 * hstep;
    const unsigned ldsw = (unsigned)wid * 1024u;
    const int aoff = lds_byte(wr * 64 + fr, fq * 8), boff = lds_byte(wc * 32 + fr, fq * 8);
#define PG8_SA(b, h) (((b) * 2 + (h)) * HTB)
#define PG8_SB(b, h) ((4 + (b) * 2 + (h)) * HTB)
#define PG8_STAGE(bufoff, goff, voff) do { _Pragma("unroll") for (int _i = 0; _i < 2; ++_i) \
        __builtin_amdgcn_raw_ptr_buffer_load_lds(srd_##voff, (PG8_LAS unsigned*)(lds + (bufoff) + ldsw + _i * 8192), 16, (int)(voff), (int)((goff) + _i * qstep), 0, 0); } while (0)
#define PG8_STAGE_A(bufoff, goff, VS) do { _Pragma("unroll") for (int _i = 0; _i < 2; ++_i) \
        __builtin_amdgcn_raw_ptr_buffer_load_lds(srd_voffA, (PG8_LAS unsigned*)(lds + (bufoff) + ldsw + _i * 8192), 16, GATHER ? (int)VS[((bufoff) / HTB) & 1][_i] : (int)voffA, GATHER ? (int)(goff) : (int)((goff) + _i * qstep), 0, 0); } while (0)
#define PG8_LDA(dst, b, h) do { if constexpr (FP8) { _Pragma("unroll") for (int m = 0; m < 4; ++m) { const v4i_t l_ = *(const PG8_LAS v4i_t*)(lds + PG8_SA(b, h) + aoff + m * 2048), h_ = *(const PG8_LAS v4i_t*)(lds + PG8_SA(b, h) + aoff + m * 2048 + 1024); dst##8[m] = __builtin_shufflevector(l_, h_, 0, 1, 2, 3, 4, 5, 6, 7); } } else { _Pragma("unroll") for (int m = 0; m < 4; ++m) _Pragma("unroll") for (int k = 0; k < 2; ++k) dst[m][k] = *(const PG8_LAS bf16x8*)(lds + PG8_SA(b, h) + aoff + m * 2048 + k * 1024); } } while (0)
#define PG8_LDB(dst, b, h) do { if constexpr (FP8) { _Pragma("unroll") for (int n = 0; n < 2; ++n) { const v4i_t l_ = *(const PG8_LAS v4i_t*)(lds + PG8_SB(b, h) + boff + n * 2048), h_ = *(const PG8_LAS v4i_t*)(lds + PG8_SB(b, h) + boff + n * 2048 + 1024); dst##8[n] = __builtin_shufflevector(l_, h_, 0, 1, 2, 3, 4, 5, 6, 7); } } else { _Pragma("unroll") for (int n = 0; n < 2; ++n) _Pragma("unroll") for (int k = 0; k < 2; ++k) dst[n][k] = *(const PG8_LAS bf16x8*)(lds + PG8_SB(b, h) + boff + n * 2048 + k * 1024); } } while (0)
#define PG8_MMA(ai, bj, At, Bt) do { __builtin_amdgcn_s_setprio(1); if constexpr (FP8) { _Pragma("unroll") for (int m = 0; m < 4; ++m) _Pragma("unroll") for (int n = 0; n < 2; ++n) \
        asm volatile("v_mfma_f32_16x16x128_f8f6f4 %0, %1, %2, %0" : "+v"(acc[ai][bj][m][n]) : "v"(Bt##8[n]), "v"(At##8[m])); } else { \
        _Pragma("unroll") for (int m = 0; m < 4; ++m) _Pragma("unroll") for (int n = 0; n < 2; ++n) _Pragma("unroll") for (int k = 0; k < 2; ++k) \
        acc[ai][bj][m][n] = __builtin_amdgcn_mfma_f32_16x16x32_bf16(Bt[n][k], At[m][k], acc[ai][bj][m][n], 0, 0, 0); } __builtin_amdgcn_s_setprio(0); } while (0)
#define PG8_WAIT_V(n) asm volatile("s_waitcnt vmcnt(" #n ")" ::: "memory")
#define PG8_WAIT_L(n) asm volatile("s_waitcnt lgkmcnt(" #n ")" ::: "memory")
#define PG8_BAR __builtin_amdgcn_s_barrier()
#define PG8_SCHED __builtin_amdgcn_sched_barrier(0)
    Unit cur, nxt; int ui = 0;
    if (!S.next(0, cur)) return;
    f32x4 acc[2][2][4][2];
#pragma unroll
    for (int a = 0; a < 2; ++a)
#pragma unroll
        for (int b = 0; b < 2; ++b)
#pragma unroll
            for (int m = 0; m < 4; ++m)
#pragma unroll
                for (int n = 0; n < 2; ++n) acc[a][b][m][n] = (f32x4){0.f, 0.f, 0.f, 0.f};
    typedef int v8i_t __attribute__((ext_vector_type(8))); typedef int v4i_t __attribute__((ext_vector_type(4)));
    bf16x8 At[4][2], B0[2][2], B1[2][2]; v8i_t At8[4], B08[2], B18[2];
    const __amdgpu_buffer_rsrc_t srd_voffA = __builtin_amdgcn_make_buffer_rsrc((void*)g.A, 0, 0x7ffffff0, 0x00020000), srd_voffB = __builtin_amdgcn_make_buffer_rsrc((void*)g.Bt, 0, 0x7ffffff0, 0x00020000);
    unsigned cA = GATHER ? 0u : (unsigned)cur.pm * tstep, cB = (unsigned)cur.pn * tstep;
    const unsigned hstepA = GATHER ? 0u : hstep;
    unsigned ca_[2][2] = {{0u, 0u}, {0u, 0u}}, na_[2][2] = {{0u, 0u}, {0u, 0u}}, va2_[2][2] = {{0u, 0u}, {0u, 0u}};
    int gR_ = 0, gC2_ = 0;
    if constexpr (GATHER) { int R, C; stage_rc(tid * 16, R, C); gR_ = R; gC2_ = C * 2;
#pragma unroll
        for (int h = 0; h < 2; ++h)
#pragma unroll
            for (int i = 0; i < 2; ++i) ca_[h][i] = (unsigned)rowtab[128 * h + 64 * i + R] + (unsigned)gC2_; }
    S.a_ready(cur);
    if constexpr (SP2) {
        PG8_STAGE(PG8_SB(0, 0), cB, voffB); PG8_STAGE(PG8_SB(0, 1), cB + hstep, voffB); PG8_STAGE_A(PG8_SA(0, 0), cA, ca_); PG8_STAGE_A(PG8_SA(0, 1), cA + hstepA, ca_);
        if (wr == 1) PG8_BAR;
        PG8_WAIT_V(2); PG8_BAR;
        PG8_STAGE(PG8_SB(1, 0), cB + kstep, voffB); PG8_STAGE_A(PG8_SA(1, 0), cA + kstep, ca_); PG8_STAGE(PG8_SB(1, 1), cB + hstep + kstep, voffB);
        PG8_WAIT_V(6); PG8_BAR;
    } else {
        PG8_STAGE(PG8_SB(0, 0), cB, voffB); PG8_STAGE_A(PG8_SA(0, 0), cA, ca_); PG8_STAGE(PG8_SB(0, 1), cB + hstep, voffB); PG8_STAGE_A(PG8_SA(0, 1), cA + hstepA, ca_);
        if (wr == 1) PG8_BAR;
        PG8_WAIT_V(4); PG8_BAR;
        PG8_STAGE(PG8_SB(1, 0), cB + kstep, voffB); PG8_STAGE_A(PG8_SA(1, 0), cA + kstep, ca_); PG8_STAGE(PG8_SB(1, 1), cB + hstep + kstep, voffB);
        PG8_WAIT_V(6); PG8_BAR;
    }
    for (;;) {
        const bool has_next = S.next(ui + 1, nxt);
        const unsigned nA = GATHER ? 0u : (has_next ? (unsigned)nxt.pm * tstep : cA); const unsigned nB = has_next ? (unsigned)nxt.pn * tstep : cB;
        if constexpr (GATHER) {
#pragma unroll
            for (int h = 0; h < 2; ++h)
#pragma unroll
                for (int i = 0; i < 2; ++i) na_[h][i] = has_next ? (unsigned)rowtab[(ui + 1) * 256 + 128 * h + 64 * i + gR_] + (unsigned)gC2_ : ca_[h][i]; }
#pragma nounroll
        for (int t = 0; t < nt; t += 2) {
            const bool last = (t == nt - 2);
            const unsigned a1 = cA + (unsigned)(t + 1) * kstep;
            const unsigned a2 = last ? nA : cA + (unsigned)(t + 2) * kstep; const unsigned b2 = last ? nB : cB + (unsigned)(t + 2) * kstep;
            const unsigned a3 = a2 + kstep; const unsigned b3 = b2 + kstep;
            if constexpr (GATHER) {
#pragma unroll
                for (int h = 0; h < 2; ++h)
#pragma unroll
                    for (int i = 0; i < 2; ++i) va2_[h][i] = last ? na_[h][i] : ca_[h][i]; }
            if (last && has_next) S.a_ready(nxt);
            if constexpr (SP2) {
            PG8_LDB(B0, 0, 0); PG8_LDB(B1, 0, 1); PG8_SCHED; PG8_LDA(At, 0, 0); PG8_STAGE_A(PG8_SA(1, 1), a1 + hstepA, ca_);
            PG8_WAIT_V(8); PG8_WAIT_L(0); PG8_BAR; PG8_MMA(0, 0, At, B0); PG8_MMA(0, 1, At, B1); PG8_BAR; PG8_SCHED;
            PG8_LDA(At, 0, 1); PG8_STAGE(PG8_SB(0, 0), b2, voffB); PG8_STAGE(PG8_SB(0, 1), b2 + hstep, voffB); PG8_STAGE_A(PG8_SA(0, 0), a2, va2_);
            PG8_WAIT_V(8); PG8_WAIT_L(0); PG8_BAR; PG8_MMA(1, 0, At, B0); PG8_MMA(1, 1, At, B1); PG8_BAR; PG8_SCHED;
            PG8_LDB(B0, 1, 0); PG8_LDB(B1, 1, 1); PG8_SCHED; PG8_LDA(At, 1, 0); PG8_STAGE_A(PG8_SA(0, 1), a2 + hstepA, va2_);
            PG8_WAIT_V(8); PG8_WAIT_L(0); PG8_BAR; PG8_MMA(0, 0, At, B0); PG8_MMA(0, 1, At, B1); PG8_BAR; PG8_SCHED;
            PG8_LDA(At, 1, 1); PG8_STAGE(PG8_SB(1, 0), b3, voffB); PG8_STAGE(PG8_SB(1, 1), b3 + hstep, voffB); PG8_STAGE_A(PG8_SA(1, 0), a3, va2_);
            PG8_WAIT_V(8); PG8_WAIT_L(0); PG8_BAR; PG8_MMA(1, 0, At, B0); PG8_MMA(1, 1, At, B1); PG8_BAR; PG8_SCHED;
            } else {
            PG8_LDB(B0, 0, 0); PG8_SCHED; PG8_LDA(At, 0, 0); PG8_STAGE_A(PG8_SA(1, 1), a1 + hstepA, ca_);
            PG8_WAIT_L(8); PG8_BAR; PG8_WAIT_L(0); PG8_MMA(0, 0, At, B0); PG8_BAR; PG8_SCHED;
            PG8_LDB(B1, 0, 1); PG8_STAGE(PG8_SB(0, 0), b2, voffB);
            PG8_BAR; PG8_WAIT_L(0); PG8_MMA(0, 1, At, B1); PG8_BAR;
            PG8_LDA(At, 0, 1); PG8_STAGE_A(PG8_SA(0, 0), a2, va2_);
            PG8_BAR; PG8_WAIT_L(0); PG8_MMA(1, 0, At, B0); PG8_BAR; PG8_SCHED;
            PG8_STAGE(PG8_SB(0, 1), b2 + hstep, voffB);
            PG8_WAIT_V(6); PG8_BAR; PG8_MMA(1, 1, At, B1); PG8_BAR;
            PG8_LDB(B0, 1, 0); PG8_SCHED; PG8_LDA(At, 1, 0); PG8_STAGE_A(PG8_SA(0, 1), a2 + hstepA, va2_);
            PG8_WAIT_L(8); PG8_BAR; PG8_WAIT_L(0); PG8_MMA(0, 0, At, B0); PG8_BAR; PG8_SCHED;
            PG8_LDB(B1, 1, 1); PG8_STAGE(PG8_SB(1, 0), b3, voffB);
            PG8_BAR; PG8_WAIT_L(0); PG8_MMA(0, 1, At, B1); PG8_BAR;
            PG8_LDA(At, 1, 1); PG8_STAGE_A(PG8_SA(1, 0), a3, va2_);
            PG8_BAR; PG8_WAIT_L(0); PG8_MMA(1, 0, At, B0); PG8_BAR; PG8_SCHED;
            PG8_STAGE(PG8_SB(1, 1), b3 + hstep, voffB);
            PG8_WAIT_V(6); PG8_BAR; PG8_MMA(1, 1, At, B1); PG8_BAR;
            }
        }
        if constexpr (ALIGN_EPI) { if (wr == 0) PG8_BAR; }
        if constexpr (FP8) asm volatile("s_nop 15\n\ts_nop 15" ::: "memory");
        if constexpr (!Epi::AFTER_DRAIN) { E(acc, cur, wr, wc, fr, fq); S.done(cur); }
        if (!has_next) break;
#pragma unroll
        for (int a = 0; a < 2; ++a)
#pragma unroll
            for (int b = 0; b < 2; ++b)
#pragma unroll
                for (int m = 0; m < 4; ++m)
#pragma unroll
                    for (int n = 0; n < 2; ++n) acc[a][b][m][n] = (f32x4){0.f, 0.f, 0.f, 0.f};
        cur = nxt; cA = nA; cB = nB; ++ui;
        if constexpr (GATHER) {
#pragma unroll
            for (int h = 0; h < 2; ++h)
#pragma unroll
                for (int i = 0; i < 2; ++i) ca_[h][i] = na_[h][i]; }
        if constexpr (ALIGN_EPI) { if (wr == 1) PG8_BAR; }
    }
    PG8_WAIT_V(0);
    if constexpr (!ALIGN_EPI) { if (wr == 0) PG8_BAR; }
    PG8_BAR;
    if constexpr (Epi::AFTER_DRAIN) { E.fused(acc, cur, wr, wc, fr, fq, lds, wid, lane); S.done(cur); }
#undef PG8_SA
#undef PG8_SB
#undef PG8_STAGE
#undef PG8_LDA
#undef PG8_LDB
#undef PG8_MMA
#undef PG8_WAIT_V
#undef PG8_WAIT_L
#undef PG8_BAR
#undef PG8_SCHED
}
}

namespace pg8 {
struct EpiResGate {
    static constexpr bool PERM = false, AFTER_DRAIN = false;
    const float* base; unsigned short* out; int ldc; const float* gate; int gate_bstride; int rows_per_batch;
    __device__ __forceinline__ void operator()(const f32x4 (&acc)[2][2][4][2], const Unit& u, int wr, int wc, int fr, int fq) const {
        const int b = (u.pm * BM) / rows_per_batch;
        const int col0 = u.pn * BM + wc * 32 + 4 * fq;
        f32x4 gv[2][2];
#pragma unroll
        for (int bj = 0; bj < 2; ++bj)
#pragma unroll
            for (int n = 0; n < 2; ++n) gv[bj][n] = *(const f32x4*)(gate + (size_t)b * gate_bstride + col0 + bj * HALF + n * 16);
#pragma unroll
        for (int ai = 0; ai < 2; ++ai)
#pragma unroll
            for (int mp = 0; mp < 2; ++mp) {
                f32x4 bs[2][2][2];
#pragma unroll
                for (int mm = 0; mm < 2; ++mm) { const int m = 2 * mp + mm; const size_t off = (size_t)(u.pm * BM + ai * HALF + wr * 64 + m * 16 + fr) * ldc + col0;
#pragma unroll
                    for (int bj = 0; bj < 2; ++bj)
#pragma unroll
                        for (int n = 0; n < 2; ++n) bs[mm][bj][n] = *(const f32x4*)(base + off + bj * HALF + n * 16); }
                asm volatile("s_waitcnt vmcnt(0)" ::: "memory");
#pragma unroll
                for (int mm = 0; mm < 2; ++mm) { const int m = 2 * mp + mm; const size_t off = (size_t)(u.pm * BM + ai * HALF + wr * 64 + m * 16 + fr) * ldc + col0;
#pragma unroll
                    for (int bj = 0; bj < 2; ++bj)
#pragma unroll
                        for (int n = 0; n < 2; ++n) { const f32x4 r = bs[mm][bj][n] + gv[bj][n] * acc[ai][bj][m][n]; typedef unsigned u32x2_ __attribute__((ext_vector_type(2)));
                            u32x2_ w; w.x = cvt_pk_bf16(r[0], r[1]); w.y = cvt_pk_bf16(r[2], r[3]); *(u32x2_*)(out + off + bj * HALF + n * 16) = w; } }
                asm volatile("" ::: "memory");
            }
    }
};
__device__ __forceinline__ unsigned pk4_fp8(float a, float b, float c, float d) {
    a = __builtin_fminf(__builtin_fmaxf(a, -448.f), 448.f); b = __builtin_fminf(__builtin_fmaxf(b, -448.f), 448.f); c = __builtin_fminf(__builtin_fmaxf(c, -448.f), 448.f); d = __builtin_fminf(__builtin_fmaxf(d, -448.f), 448.f);
    int w = 0; w = __builtin_amdgcn_cvt_pk_fp8_f32(a, b, w, false); w = __builtin_amdgcn_cvt_pk_fp8_f32(c, d, w, true); return (unsigned)w; }
__device__ __forceinline__ unsigned pk4_fp8_nc(float a, float b, float c, float d) {
    int w = 0; w = __builtin_amdgcn_cvt_pk_fp8_f32(a, b, w, false); w = __builtin_amdgcn_cvt_pk_fp8_f32(c, d, w, true); return (unsigned)w; }
struct EpiSwiglu {
    static constexpr bool PERM = true, AFTER_DRAIN = false;
    unsigned char* O; const float* bgu; float asc, osc;
    __device__ __forceinline__ float act1(float g, float u) const {
        g = __builtin_fminf(g, 7.0f); u = __builtin_fminf(__builtin_fmaxf(u, -7.0f), 7.0f);
        const float s = __builtin_amdgcn_rcpf(1.0f + __builtin_amdgcn_exp2f(g * (-1.702f * 1.4426950408889634f)));
        return (u + 1.0f) * (g * s) * osc;
    }
    __device__ __forceinline__ void operator()(const f32x4 (&acc)[2][2][4][2], const Unit& u, int wr, int wc, int fr, int fq) const {
        const int e = u.pn >> 3, pnl = u.pn & 7;
        const int row0 = u.pm * BM + wr * 64 + fr;
        const int ocol0 = pnl * 128 + wc * 32 + 8 * fq;
        f32x4 bg[2], bu[2];
#pragma unroll
        for (int n = 0; n < 2; ++n) { bg[n] = *(const f32x4*)(bgu + (size_t)e * 2048 + ocol0 + 4 * n); bu[n] = *(const f32x4*)(bgu + (size_t)e * 2048 + 1024 + ocol0 + 4 * n); }
#pragma unroll
        for (int ai = 0; ai < 2; ++ai)
#pragma unroll
            for (int m = 0; m < 4; ++m) { unsigned char* rowp = O + (size_t)(row0 + ai * HALF + m * 16) * 1024 + ocol0;
                const f32x4 g0 = acc[ai][0][m][0] * asc + bg[0], g1 = acc[ai][0][m][1] * asc + bg[1], u0 = acc[ai][1][m][0] * asc + bu[0], u1 = acc[ai][1][m][1] * asc + bu[1];
                typedef unsigned u32x2 __attribute__((ext_vector_type(2)));
                u32x2 w; w.x = pk4_fp8_nc(act1(g0[0], u0[0]), act1(g0[1], u0[1]), act1(g0[2], u0[2]), act1(g0[3], u0[3]));
                w.y = pk4_fp8_nc(act1(g1[0], u1[0]), act1(g1[1], u1[1]), act1(g1[2], u1[2]), act1(g1[3], u1[3]));
                *(u32x2*)rowp = w; asm volatile("" ::: "memory"); }
    }
};
struct EpiDown {
    static constexpr bool PERM = true, AFTER_DRAIN = false;
    bf16_t* O; const float* bias; float asc;
    __device__ __forceinline__ void operator()(const f32x4 (&acc)[2][2][4][2], const Unit& u, int wr, int wc, int fr, int fq) const {
        const int row0 = u.pm * BM + wr * 64 + fr; const int pnl = u.pn & 3;
        const int col0 = pnl * BM + wc * 32 + 8 * fq, bcol0 = u.pn * BM + wc * 32 + 8 * fq;
        f32x4 bv[2][2];
#pragma unroll
        for (int bj = 0; bj < 2; ++bj)
#pragma unroll
            for (int n = 0; n < 2; ++n) bv[bj][n] = *(const f32x4*)(bias + bcol0 + bj * HALF + 4 * n);
#pragma unroll
        for (int ai = 0; ai < 2; ++ai)
#pragma unroll
            for (int m = 0; m < 4; ++m) { bf16_t* rowp = O + (size_t)(row0 + ai * HALF + m * 16) * 1024 + col0;
#pragma unroll
                for (int bj = 0; bj < 2; ++bj) { const f32x4 v0 = acc[ai][bj][m][0] * asc + bv[bj][0], v1 = acc[ai][bj][m][1] * asc + bv[bj][1];
                    u32x4 w; w.x = cvt_pk_bf16(v0[0], v0[1]); w.y = cvt_pk_bf16(v0[2], v0[3]); w.z = cvt_pk_bf16(v1[0], v1[1]); w.w = cvt_pk_bf16(v1[2], v1[3]);
                    *(u32x4*)(rowp + bj * HALF) = w; } }
    }
};
#ifndef GROUPED_WGM
#define GROUPED_WGM 16
#endif
struct GroupedOrder {
    const int* tile_e; int nM, nNl, nwg, G, c;
    __device__ void init(const int* te, int ntm, int nNl_, int G_, int c_) { tile_e = te; nM = ntm; nNl = nNl_; nwg = ntm * nNl_; G = G_; c = c_; }
    __device__ bool next(int i, Unit& u) const {
        const long L = (long)i * G + c; if (L >= nwg) return false;
        int wgid = (int)L; { const int q = nwg / NXCD, r = nwg % NXCD, xcd = wgid % NXCD, off = wgid / NXCD; wgid = (xcd < r ? xcd * (q + 1) : r * (q + 1) + (xcd - r) * q) + off; }
        constexpr int WG = GROUPED_WGM; const int nig = WG * nNl, gid = wgid / nig, fm = gid * WG, gsz = (nM - fm) < WG ? (nM - fm) : WG;
        u.pm = fm + ((wgid % nig) % gsz); const int pl = (wgid % nig) / gsz;
        u.pn = __builtin_amdgcn_readfirstlane(tile_e[u.pm]) * nNl + pl; return true;
    }
    __device__ __forceinline__ void a_ready(const Unit&) const {}
    __device__ __forceinline__ void done(const Unit&) const {}
};
}

constexpr int NWAVES = 8;
constexpr int NB = 4, SEQ = 4096, DM = 1024, TT = NB * SEQ, DH = 512, NHEAD = 8, HD = 64, NEXP = 32, TOPK = 4, INCOLS = 2560, NMOD = 6 * DM, DE2 = 2048;
constexpr float NORM_EPS = 1e-6f;
constexpr float C2 = 0.125f * 1.4426950408889634f;
constexpr float SC_H = 16.0f, SC_W = 512.0f, SC_ACT = 4.0f;
constexpr int MAXSLOT = TT * TOPK + NEXP * 256, MAXTILE = MAXSLOT / 256;
#ifndef MK_N_LAUNCHES
#define MK_N_LAUNCHES 1
#endif
constexpr int PER_PHASE = 11;
constexpr int N_LAUNCHES = MK_N_LAUNCHES;

constexpr size_t MiB = 1u << 20;
constexpr size_t WS_CTL = 0, CTL_ZERO_BYTES = 1 * MiB;
constexpr size_t WS_MISC = 1 * MiB;
constexpr size_t WS_WRT = 2 * MiB;
constexpr size_t WS_WIN = 3 * MiB, WS_WOUT = 8 * MiB, WS_WGU = 16 * MiB, WS_WD = 144 * MiB;
constexpr size_t WS_XN = 208 * MiB, WS_QKV = 240 * MiB, WS_OP = 320 * MiB, WS_LSE = 368 * MiB, WS_MIX = 370 * MiB, WS_X1 = 402 * MiB;
constexpr size_t WS_ROUTE = 466 * MiB;
constexpr size_t WS_XG = 468 * MiB, WS_ACT = 612 * MiB, WS_MODP = 756 * MiB, WS_END = 758 * MiB;
constexpr int CW_TMO = 0, CW_CODE = 1, CW_BAR = 4096, CW_CNT = 8192, CW_RFLAG = 12288, CW_MOD = 16384, CW_RX = 65536;
static_assert((size_t)CW_RX * 4 + (size_t)NB * 8 * 16 * 64 * 8 <= CTL_ZERO_BYTES, "ctl rx");
static_assert((CW_MOD + NB * NMOD) * 4 <= (int)CTL_ZERO_BYTES, "ctl");
constexpr int RING_OFF = 0, RING_BYTES = 131072, LDSCTL_OFF = RING_BYTES, MISC_OFF = LDSCTL_OFF + 320, SUMM_OFF = RING_BYTES + 1024, TILE_OFF = SUMM_OFF + 4096, ROWTAB_OFF = TILE_OFF + 1024, ROWTAB_UNITS = 9, LDS_BYTES = 147456;
static_assert(ROWTAB_OFF + ROWTAB_UNITS * 1024 <= LDS_BYTES && (MAXTILE * 8 + 255) / 256 <= ROWTAB_UNITS, "lds");
#define GAS __attribute__((address_space(1)))
#define LAS __attribute__((address_space(3)))
typedef unsigned short bf16;
typedef unsigned v4u __attribute__((ext_vector_type(4)));
typedef float f32x4 __attribute__((ext_vector_type(4)));
typedef short bf16x8 __attribute__((ext_vector_type(8)));
typedef GAS unsigned gu32;
typedef GAS unsigned long long gu64;
#define RLX_AGENT __ATOMIC_RELAXED, __HIP_MEMORY_SCOPE_AGENT
#define LDS_WAIT() asm volatile("s_waitcnt lgkmcnt(0)" ::: "memory")
#define VM_WAIT() asm volatile("s_waitcnt vmcnt(0)" ::: "memory")
__device__ __forceinline__ unsigned long long rt() { return __builtin_amdgcn_s_memrealtime(); }
__device__ __forceinline__ unsigned f2bf(float f) { unsigned u = __builtin_bit_cast(unsigned, f); return (u + 0x7fffu + ((u >> 16) & 1u)) >> 16; }
__device__ __forceinline__ unsigned pk2(float lo, float hi) { return f2bf(lo) | (f2bf(hi) << 16); }

#define XB_TMO      128
#define XB_XCNT(j)  (256  + 64 * (j))
#define XB_XSUB(j)  (1280 + 64 * (j))
#define XB_XGEN(j)  (2304 + 64 * (j))
#define XB_TOP      3328
#define XB_TOPGEN   3392
#define XCD_BAR_WORDS 3456
#define XB_SPIN_CAP (1u << 18)

__device__ __forceinline__ unsigned xb_ld(unsigned* p)              { return __hip_atomic_load(p, __ATOMIC_RELAXED, __HIP_MEMORY_SCOPE_AGENT); }
__device__ __forceinline__ unsigned xb_add(unsigned* p, unsigned v) { return __hip_atomic_fetch_add(p, v, __ATOMIC_RELAXED, __HIP_MEMORY_SCOPE_AGENT); }
__device__ __forceinline__ unsigned xb_xcc_id() { return (unsigned)__builtin_amdgcn_s_getreg((3 << 11) | 20) & 0xFu; }
#define XB_SPIN(cond, bar) do { unsigned _sp = 0; while (cond) { __builtin_amdgcn_s_sleep(1); \
    if ((++_sp & 255u) == 0u) { if (xb_ld(&(bar)[XB_TMO])) break; if (_sp > XB_SPIN_CAP) { atomicAdd(&(bar)[XB_TMO], 1u); break; } } } } while (0)

struct XcdBarrier {
    unsigned* bar; unsigned x;
    volatile LAS unsigned* st;
};

__device__ __forceinline__ XcdBarrier xcd_barrier_post(unsigned* bar, volatile LAS unsigned* st) {
    XcdBarrier b; b.bar = bar; b.x = xb_xcc_id(); b.st = st;
    if (threadIdx.x == 0) (void)xb_add(&bar[XB_XCNT(b.x)], 1u);
    return b;
}
__device__ __forceinline__ void xcd_barrier_complete(unsigned* bar, unsigned x, unsigned& nloc, unsigned& nx) {
    const unsigned G = gridDim.x * gridDim.y * gridDim.z;
    unsigned sum, cnt, mine, sp = 0u;
    for (;;) {
        sum = 0u; cnt = 0u; mine = 0u;
#pragma unroll
        for (unsigned j = 0; j < 16; ++j) { const unsigned c = xb_ld(&bar[XB_XCNT(j)]); sum += c; cnt += (c > 0u) ? 1u : 0u; mine = (j == x) ? c : mine; }
        if (sum == G) break;
        __builtin_amdgcn_s_sleep(1);
        if ((++sp & 255u) == 0u) { if (xb_ld(&bar[XB_TMO])) break; if (sp > XB_SPIN_CAP) { atomicAdd(&bar[XB_TMO], 1u); break; } }
    }
    nloc = mine > 0u ? mine : 1u; nx = cnt > 0u ? cnt : 1u;
}

__device__ __forceinline__ void xcd_barrier(const XcdBarrier& b) {
    asm volatile("s_waitcnt vmcnt(0)" ::: "memory");
    __syncthreads();
    if (threadIdx.x == 0) {
        unsigned* bar = b.bar;
        __builtin_amdgcn_s_waitcnt(0);
        unsigned nloc = b.st[0], nx = b.st[1];
        if (nloc == 0u) { xcd_barrier_complete(bar, b.x, nloc, nx); b.st[0] = nloc; b.st[1] = nx; }
        const unsigned old = xb_add(&bar[XB_XSUB(b.x)], 1u);
        const unsigned gen = old / nloc;
        if (old + 1u == (gen + 1u) * nloc) {
            __builtin_amdgcn_fence(__ATOMIC_RELEASE, "agent");
            asm volatile("s_waitcnt vmcnt(0)" ::: "memory");
            const unsigned og = xb_add(&bar[XB_TOP], 1u);
            const unsigned tg = og / nx;
            if (og + 1u == (tg + 1u) * nx) xb_add(&bar[XB_TOPGEN], 1u);
            else XB_SPIN(xb_ld(&bar[XB_TOPGEN]) == tg, bar);
            __builtin_amdgcn_fence(__ATOMIC_ACQUIRE, "agent");
            xb_add(&bar[XB_XGEN(b.x)], 1u);
            asm volatile("s_waitcnt vmcnt(0)" ::: "memory");
        } else {
            XB_SPIN(xb_ld(&bar[XB_XGEN(b.x)]) == gen, bar);
            __builtin_amdgcn_fence(__ATOMIC_ACQUIRE, "agent");
            asm volatile("s_waitcnt vmcnt(0)" ::: "memory");
        }
    }
    __syncthreads();
}

typedef float f32x16 __attribute__((ext_vector_type(16)));
typedef short v4i16_t __attribute__((ext_vector_type(4)));
typedef unsigned v2u __attribute__((ext_vector_type(2)));
struct Frame {
    LAS unsigned char* lds;
    int tid, lane, wave, vcu, G;
    unsigned char* ws;
    const __attribute__((address_space(4))) void* ka;
    __device__ __forceinline__ const float* in(int k) const {
        const unsigned long long v = *(const volatile __attribute__((address_space(4))) unsigned long long*)((const __attribute__((address_space(4))) char*)ka + 8 * k);
        const unsigned lo = (unsigned)__builtin_amdgcn_readfirstlane((int)(unsigned)v), hi = (unsigned)__builtin_amdgcn_readfirstlane((int)(unsigned)(v >> 32));
        return (const float*)(const GAS float*)(((unsigned long long)hi << 32) | lo);
    }
};
enum InIdx { I_x = 0, I_c, I_w_ada, I_b_ada, I_g_mix, I_w_in, I_conv_w, I_conv_b, I_w_rg_a, I_b_rg_a, I_w_rg_x, I_b_rg_x, I_lam, I_w_out, I_g_ffn, I_w_router, I_b_router, I_w_gate_up, I_b_gate_up, I_w_down, I_b_down, I_g_final };
#define WSP(T, off) ((T*)(F.ws + (off)))
#define P_MOD   (WSP(float, WS_CTL) + CW_MOD)
#define P_BCNT  WSP(int, WS_MISC + 8192)
#define P_TILE_E WSP(int, WS_MISC)
#define P_TILE_N WSP(int, WS_MISC + 4096)
#define P_RSUM  WSP(float, WS_MISC + 65536)
#define P_WRT   WSP(float, WS_WRT)
#define P_WA_T  WSP(bf16, WS_WRT + 262144)
#define P_WX_T  WSP(bf16, WS_WRT + 393216)
#define P_WIN_T WSP(bf16, WS_WIN)
#define P_WOUT_T WSP(bf16, WS_WOUT)
#define P_WGU8 WSP(unsigned char, WS_WGU)
#define P_WD8  WSP(unsigned char, WS_WD)
#define P_XN    WSP(bf16, WS_XN)
#define P_QB    WSP(bf16, WS_QKV)
#define P_KB    (WSP(bf16, WS_QKV) + (size_t)TT * DH)
#define P_VB    (WSP(bf16, WS_QKV) + (size_t)2 * TT * DH)
#define P_XR    (WSP(bf16, WS_QKV) + (size_t)3 * TT * DH)
#define P_GR    (WSP(bf16, WS_QKV) + (size_t)4 * TT * DH)
#define P_OP    WSP(bf16, WS_OP)
#define P_LSE   WSP(float, WS_LSE)
#define P_MIX   WSP(bf16, WS_MIX)
#define P_X1    WSP(bf16, WS_X1)
#define P_TOK_E WSP(int, WS_ROUTE)
#define P_TOK_POS (WSP(int, WS_ROUTE) + TT * TOPK)
#define P_TOK_GATE (WSP(float, WS_ROUTE) + 2 * TT * TOPK)
#define P_TOK_SLOT (WSP(int, WS_ROUTE) + 3 * TT * TOPK)
#define P_SLOT_TOK (WSP(int, WS_ROUTE + 1048576))
#define P_Y2    WSP(bf16, WS_XG)
#define P_XN8   WSP(unsigned char, WS_XN)
#define P_ACT8  WSP(unsigned char, WS_ACT)
__device__ __forceinline__ float bf2f(unsigned short v) { return __uint_as_float(((unsigned)v) << 16); }
__device__ __forceinline__ float wave_sum(float v) {
#pragma unroll
    for (int o = 1; o < 64; o <<= 1) v += __shfl_xor(v, o);
    return v;
}
__device__ __forceinline__ float wave_max(float v) {
#pragma unroll
    for (int o = 1; o < 64; o <<= 1) v = fmaxf(v, __shfl_xor(v, o));
    return v;
}
__device__ __forceinline__ int crow(int r, int hi) { return (r & 3) + 8 * (r >> 2) + 4 * hi; }

__device__ __forceinline__ void p0_transpose_item(const float* W, int K, int N, bf16* WT, int k0, int n0, int drow0, LAS float* scr, int lane) {
#pragma unroll 8
    for (int i = 0; i < 32; ++i) { const int kk = 2 * i + (lane >> 5); scr[kk * 33 + (lane & 31)] = W[(size_t)(k0 + kk) * N + n0 + (lane & 31)]; }
    LDS_WAIT(); asm volatile("" ::: "memory");
    const int c = lane & 7;
#pragma unroll
    for (int j = 0; j < 4; ++j) { const int n = (lane >> 3) + 8 * j; const LAS float* s = scr + (8 * c) * 33 + n;
        v4u o; o.x = pk2(s[0 * 33], s[1 * 33]); o.y = pk2(s[2 * 33], s[3 * 33]); o.z = pk2(s[4 * 33], s[5 * 33]); o.w = pk2(s[6 * 33], s[7 * 33]);
        *(GAS v4u*)(WT + (size_t)(drow0 + n) * K + k0 + 8 * c) = o; }
    LDS_WAIT(); asm volatile("" ::: "memory");
}
__device__ __forceinline__ void p0_transpose_item8(const float* W, int K, int N, unsigned char* WT, int k0, int n0, int drow0, float sc, LAS float* scr, int lane) {
#pragma unroll 8
    for (int i = 0; i < 32; ++i) { const int kk = 2 * i + (lane >> 5); scr[kk * 33 + (lane & 31)] = W[(size_t)(k0 + kk) * N + n0 + (lane & 31)]; }
    LDS_WAIT(); asm volatile("" ::: "memory");
    const int c = lane & 7;
#pragma unroll
    for (int j = 0; j < 4; ++j) { const int n = (lane >> 3) + 8 * j; const LAS float* s = scr + (8 * c) * 33 + n;
        v2u o; o.x = pg8::pk4_fp8(s[0 * 33] * sc, s[1 * 33] * sc, s[2 * 33] * sc, s[3 * 33] * sc); o.y = pg8::pk4_fp8(s[4 * 33] * sc, s[5 * 33] * sc, s[6 * 33] * sc, s[7 * 33] * sc);
        *(GAS v2u*)(WT + (size_t)(drow0 + n) * K + k0 + 8 * c) = o; }
    LDS_WAIT(); asm volatile("" ::: "memory");
}
struct TDesc { const float* src; unsigned char* dst; int N, K, k0, n0, drow0, fp8; };
__device__ __forceinline__ void p0_dma_issue(const TDesc& d, LAS unsigned char* buf, int lane) {
    const __amdgpu_buffer_rsrc_t rs = __builtin_amdgcn_make_buffer_rsrc((void*)d.src, 0, 0x7ffffff0, 0x00020000);
#pragma unroll
    for (int j = 0; j < 16; ++j) { const int voff = ((lane >> 3) * d.N + 4 * ((lane & 7) ^ (j & 7))) * 4, soff = ((d.k0 + 8 * j) * d.N + d.n0) * 4;
        __builtin_amdgcn_raw_ptr_buffer_load_lds(rs, (LAS unsigned*)(buf + j * 1024), 16, voff, soff, 0, 0); }
}
__device__ __forceinline__ void p0_read(LAS unsigned char* buf, int lane, float (&f)[8][8]) {
    const int c = lane & 15;
#pragma unroll
    for (int jj = 0; jj < 8; ++jj) { const int n = (lane >> 4) + 4 * jj; const LAS unsigned char* s = buf + (8 * c) * 128 + ((((n >> 2) ^ (c & 7)) * 4 + (n & 3)) * 4);
#pragma unroll
        for (int i = 0; i < 8; ++i) f[jj][i] = *(const LAS float*)(s + i * 128); }
}
__device__ __forceinline__ void p0_emit(const TDesc& d, int lane, const float (&f)[8][8]) {
    const int c = lane & 15;
#pragma unroll
    for (int jj = 0; jj < 8; ++jj) { const int n = (lane >> 4) + 4 * jj;
        if (d.fp8) { v2u o; o.x = pg8::pk4_fp8(f[jj][0] * SC_W, f[jj][1] * SC_W, f[jj][2] * SC_W, f[jj][3] * SC_W); o.y = pg8::pk4_fp8(f[jj][4] * SC_W, f[jj][5] * SC_W, f[jj][6] * SC_W, f[jj][7] * SC_W);
            *(GAS v2u*)(d.dst + (size_t)(d.drow0 + n) * d.K + d.k0 + 8 * c) = o; }
        else { v4u o; o.x = pk2(f[jj][0], f[jj][1]); o.y = pk2(f[jj][2], f[jj][3]); o.z = pk2(f[jj][4], f[jj][5]); o.w = pk2(f[jj][6], f[jj][7]);
            *(GAS v4u*)((bf16*)d.dst + (size_t)(d.drow0 + n) * d.K + d.k0 + 8 * c) = o; } }
}
constexpr int PT_WGU = NEXP * 8 * 64, PT_WD = NEXP * 8 * 32, PT_WIN = 8 * 80, PT_WOUT = 8 * 32, P0T_EXPERTS = PT_WGU + PT_WD, P0T_ALL = P0T_EXPERTS + PT_WIN + PT_WOUT;
__device__ __forceinline__ void p0_transposes(Frame& F, int lo, int hi, int rank = -1, int nranks = 0) {
    const int lane = F.lane;
    const float *in_w_in = F.in(I_w_in), *in_w_out = F.in(I_w_out), *in_w_gate_up = F.in(I_w_gate_up), *in_w_down = F.in(I_w_down);
    const int gw = (rank < 0 ? F.vcu : rank) * NWAVES + F.wave, NGW = (rank < 0 ? F.G : nranks) * NWAVES;
    LAS unsigned char* lb = F.lds + RING_OFF + F.wave * 16384;
#define P0_DECODE(IT, D) do { int r = (IT); \
        if (r < PT_WGU) { const int e = r >> 9, rr = r & 511, kb = rr >> 6, nb = rr & 63, n0 = 32 * nb, j = n0 & 1023; \
            (D).src = in_w_gate_up + (size_t)e * DM * DE2; (D).dst = P_WGU8 + (size_t)e * DE2 * DM; (D).N = DE2; (D).K = DM; (D).k0 = 128 * kb; (D).n0 = n0; (D).drow0 = (j >> 7) * 256 + (n0 >= 1024 ? 128 : 0) + (j & 127); (D).fp8 = 1; break; } \
        r -= PT_WGU; \
        if (r < PT_WD) { const int e = r >> 8, rr = r & 255, kb = rr >> 5, nb = rr & 31; \
            (D).src = in_w_down + (size_t)e * DM * DM; (D).dst = P_WD8 + (size_t)e * DM * DM; (D).N = DM; (D).K = DM; (D).k0 = 128 * kb; (D).n0 = 32 * nb; (D).drow0 = 32 * nb; (D).fp8 = 1; break; } \
        r -= PT_WD; \
        if (r < PT_WIN) { const int kb = r / 80, nb = r % 80; (D).src = in_w_in; (D).dst = (unsigned char*)P_WIN_T; (D).N = INCOLS; (D).K = DM; (D).k0 = 128 * kb; (D).n0 = 32 * nb; (D).drow0 = 32 * nb; (D).fp8 = 0; break; } \
        r -= PT_WIN; \
        { const int kb = r / 32, nb = r % 32; (D).src = in_w_out; (D).dst = (unsigned char*)P_WOUT_T; (D).N = DM; (D).K = DM; (D).k0 = 128 * kb; (D).n0 = 32 * nb; (D).drow0 = 32 * nb; (D).fp8 = 0; } \
    } while (0)
    int it = lo + gw;
    if (it < hi) {
        TDesc d, d1; P0_DECODE(it, d); d1 = d;
        p0_dma_issue(d, lb, lane);
        asm volatile("s_waitcnt vmcnt(0)" ::: "memory");
        for (;;) {
            float f[8][8]; p0_read(lb, lane, f);
            LDS_WAIT(); asm volatile("" ::: "memory");
            const bool has = it + NGW < hi;
            if (has) { P0_DECODE(it + NGW, d1); p0_dma_issue(d1, lb, lane); }
            p0_emit(d, lane, f);
            asm volatile("" ::: "memory");
            if (!has) break;
            asm volatile("s_waitcnt vmcnt(8)" ::: "memory");
            it += NGW; d = d1;
        }
    }
#undef P0_DECODE
}
__device__ __forceinline__ void p0_prologue(Frame& F) {
    const int lane = F.lane;
    const float *in_w_ada = F.in(I_w_ada), *in_c = F.in(I_c), *in_b_ada = F.in(I_b_ada), *in_w_in = F.in(I_w_in), *in_w_out = F.in(I_w_out), *in_w_gate_up = F.in(I_w_gate_up), *in_w_down = F.in(I_w_down),
        *in_w_rg_a = F.in(I_w_rg_a), *in_w_rg_x = F.in(I_w_rg_x), *in_w_router = F.in(I_w_router);
    const int gw = F.vcu * NWAVES + F.wave, NGW = F.G * NWAVES;
    for (int cb = F.vcu; cb < NMOD / 24; cb += F.G) {
        LAS f32x4* part = (LAS f32x4*)(F.lds + RING_OFF);
        const int q = lane % 6, kk = lane / 6, col0 = cb * 24;
        if (kk < 8) { const int kb = F.wave * 128 + kk * 16;
            f32x4 a[4] = {(f32x4){0.f, 0.f, 0.f, 0.f}, (f32x4){0.f, 0.f, 0.f, 0.f}, (f32x4){0.f, 0.f, 0.f, 0.f}, (f32x4){0.f, 0.f, 0.f, 0.f}};
#pragma unroll
            for (int hf = 0; hf < 2; ++hf) {
                f32x4 wv[8];
#pragma unroll
                for (int t = 0; t < 8; ++t) wv[t] = *(const f32x4*)(in_w_ada + (size_t)(kb + 8 * hf + t) * NMOD + col0 + 4 * q);
#pragma unroll
                for (int b4 = 0; b4 < 4; ++b4) { const f32x4 c0 = *(const f32x4*)(in_c + b4 * DM + kb + 8 * hf), c1 = *(const f32x4*)(in_c + b4 * DM + kb + 8 * hf + 4);
                    a[b4] += c0.x * wv[0]; a[b4] += c0.y * wv[1]; a[b4] += c0.z * wv[2]; a[b4] += c0.w * wv[3]; a[b4] += c1.x * wv[4]; a[b4] += c1.y * wv[5]; a[b4] += c1.z * wv[6]; a[b4] += c1.w * wv[7]; }
                asm volatile("" ::: "memory"); }
#pragma unroll
            for (int b4 = 0; b4 < 4; ++b4) part[((F.wave * 8 + kk) * 6 + q) * 4 + b4] = a[b4]; }
        LDS_WAIT(); __syncthreads();
        if (F.tid < 96) { const int b4 = F.tid / 24, cc = F.tid % 24, qq = cc >> 2, comp = cc & 3; float s = 0.f;
            for (int p = 0; p < 64; ++p) s += part[(p * 6 + qq) * 4 + b4][comp];
            P_MOD[(size_t)b4 * NMOD + col0 + cc] = s + in_b_ada[col0 + cc]; }
        LDS_WAIT(); __syncthreads();
    }
    for (int r = gw; r < 512; r += NGW) { const int idx = r * 64 + lane, e = idx >> 10, k = idx & 1023; P_WRT[idx] = in_w_router[k * NEXP + e]; }
    asm volatile("s_waitcnt vmcnt(0)" ::: "memory");
    p0_transposes(F, P0T_EXPERTS, P0T_ALL);
    asm volatile("s_waitcnt vmcnt(0)" ::: "memory"); LDS_WAIT();
    for (int r = gw; r < 32; r += NGW) { const int which = r >> 4, rr = r & 15, n = rr >> 1, nb = rr & 1;
        p0_transpose_item((which ? in_w_rg_x : in_w_rg_a) + n * 4096, 64, 64, (which ? P_WX_T : P_WA_T) + n * 4096, 0, 32 * nb, 32 * nb, (LAS float*)(F.lds + RING_OFF + F.wave * 16384), lane); }
}
__device__ __forceinline__ void p1_norm(Frame& F) {
    const float* in_x = F.in(I_x); const float* in_g_mix = F.in(I_g_mix);
    const int gw = F.vcu * NWAVES + F.wave, NGW = F.G * NWAVES, lane = F.lane;
    for (int m = gw; m < TT; m += NGW) {
        const int b = m / SEQ;
        const GAS f32x4* xr = (const GAS f32x4*)(in_x + (size_t)m * DM) + lane;
        f32x4 v[4]; float ss = 0.f;
#pragma unroll
        for (int j = 0; j < 4; ++j) { v[j] = xr[64 * j]; ss += (v[j].x * v[j].x + v[j].y * v[j].y) + (v[j].z * v[j].z + v[j].w * v[j].w); }
        const float rstd = 1.0f / sqrtf(wave_sum(ss) * (1.0f / DM) + NORM_EPS);
        const float* mb = P_MOD + (size_t)b * NMOD;
#pragma unroll
        for (int j = 0; j < 4; ++j) { const int col = 4 * lane + 256 * j;
            const f32x4 g = *(const f32x4*)(in_g_mix + col), sc = *(const f32x4*)(mb + DM + col), sh = *(const f32x4*)(mb + col);
            const f32x4 h = (v[j] * rstd) * g * (sc + 1.0f) + sh;
            v2u o; o.x = pk2(h.x, h.y); o.y = pk2(h.z, h.w); *(GAS v2u*)(P_XN + (size_t)m * DM + col) = o; }
        asm volatile("" ::: "memory");
    }
}
template <bool FINAL> __device__ __forceinline__ void rglru_items(Frame& F) {
    LAS unsigned char* wl = F.lds + RING_OFF + F.wave * 16384;
    LAS float* summ = (LAS float*)(F.lds + SUMM_OFF);
    const float* in_conv_w = F.in(I_conv_w); const float* in_conv_b = F.in(I_conv_b); const float* in_b_rg_a = F.in(I_b_rg_a); const float* in_b_rg_x = F.in(I_b_rg_x); const float* in_lam = F.in(I_lam);
    const int lane = F.lane, w = F.wave;
    for (int it = F.vcu; it < NB * 8 * 16; it += F.G) {
        const int sp = it & 15, n = (it >> 4) & 7, b = it >> 7;
        const int gc = n * 64 + lane, t0 = sp * 256 + w * 32;
        const bf16* xrp = P_XR + ((size_t)b * SEQ) * DH + gc;
        float xin[35];
#pragma unroll
        for (int i = 0; i < 35; ++i) { const int tt = t0 - 3 + i, tc = tt < 0 ? 0 : tt; const float v = bf2f(xrp[(size_t)tc * DH]); xin[i] = tt < 0 ? 0.f : v; }
        const float cw0 = in_conv_w[gc], cw1 = in_conv_w[DH + gc], cw2 = in_conv_w[2 * DH + gc], cw3 = in_conv_w[3 * DH + gc], cb = in_conv_b[gc];
        float xc[32];
#pragma unroll
        for (int t = 0; t < 32; ++t) xc[t] = ((cw0 * xin[t] + cw1 * xin[t + 1]) + (cw2 * xin[t + 2] + cw3 * xin[t + 3])) + cb;
        LAS unsigned short* w16 = (LAS unsigned short*)wl;
#pragma unroll
        for (int t = 0; t < 32; ++t) w16[t * 64 + lane] = (unsigned short)f2bf(xc[t]);
        LDS_WAIT(); asm volatile("" ::: "memory");
        const int tok = lane & 31, hh = lane >> 5;
        bf16x8 af[4];
#pragma unroll
        for (int s = 0; s < 4; ++s) af[s] = *(const LAS bf16x8*)(wl + (tok * 64 + 16 * s + 8 * hh) * 2);
        f32x16 ga[2], gx[2];
#pragma unroll
        for (int nt = 0; nt < 2; ++nt) { ga[nt] = f32x16{}; gx[nt] = f32x16{};
            const size_t wo = ((size_t)(n * 64 + tok + 32 * nt)) * 64 + 8 * hh;
#pragma unroll
            for (int s = 0; s < 4; ++s) { const bf16x8 ba = *(const GAS bf16x8*)(P_WA_T + wo + 16 * s), bx = *(const GAS bf16x8*)(P_WX_T + wo + 16 * s);
                ga[nt] = __builtin_amdgcn_mfma_f32_32x32x16_bf16(af[s], ba, ga[nt], 0, 0, 0); gx[nt] = __builtin_amdgcn_mfma_f32_32x32x16_bf16(af[s], bx, gx[nt], 0, 0, 0); } }
        LDS_WAIT(); asm volatile("" ::: "memory");
        LAS float* wf = (LAS float*)wl;
#pragma unroll
        for (int nt = 0; nt < 2; ++nt)
#pragma unroll
            for (int rr = 0; rr < 16; ++rr) { const int tr = crow(rr, hh); wf[tr * 64 + tok + 32 * nt] = ga[nt][rr]; wf[2048 + tr * 64 + tok + 32 * nt] = gx[nt][rr]; }
        LDS_WAIT(); asm volatile("" ::: "memory");
        const float ba_ = in_b_rg_a[gc], bx_ = in_b_rg_x[gc], spc = log1pf(expf(-in_lam[gc]));
        float av[32], uv[32];
#pragma unroll
        for (int t = 0; t < 32; ++t) { const float pa = wf[t * 64 + lane] + ba_, px = wf[2048 + t * 64 + lane] + bx_;
            const float rg = __builtin_amdgcn_rcpf(1.0f + __builtin_amdgcn_exp2f(-1.4426950408889634f * pa)), ig = __builtin_amdgcn_rcpf(1.0f + __builtin_amdgcn_exp2f(-1.4426950408889634f * px));
            const float a = __builtin_amdgcn_exp2f((-8.0f * 1.4426950408889634f) * rg * spc);
            av[t] = a; uv[t] = __builtin_amdgcn_sqrtf(fmaxf(1.0f - a * a, 0.f)) * (ig * xc[t]); }
        LDS_WAIT(); asm volatile("" ::: "memory");
        float h = 0.f, P = 1.f;
#pragma unroll
        for (int t = 0; t < 32; ++t) { h = av[t] * h + uv[t]; P *= av[t]; }
        summ[(w * 64 + lane) * 2] = P; summ[(w * 64 + lane) * 2 + 1] = h;
        LDS_WAIT(); __syncthreads();
        if (!FINAL) {
            if (w == 0) { float Pt = 1.f, Ht = 0.f;
#pragma unroll
                for (int q = 0; q < 8; ++q) { const float p = summ[(q * 64 + lane) * 2], hq = summ[(q * 64 + lane) * 2 + 1]; Ht = p * Ht + hq; Pt *= p; }
                float* o = P_RSUM + ((size_t)(b * 16 + sp) * DH + gc) * 2; o[0] = Pt; o[1] = Ht; }
        } else {
            float hc = 0.f;
            { float pq[16], hq[16];
#pragma unroll
              for (int q = 0; q < 16; ++q) { const float* r2 = P_RSUM + ((size_t)(b * 16 + (q < sp ? q : 0)) * DH + gc) * 2; pq[q] = r2[0]; hq[q] = r2[1]; }
#pragma unroll
              for (int q = 0; q < 16; ++q) if (q < sp) hc = pq[q] * hc + hq[q]; }
            for (int q = 0; q < w; ++q) hc = summ[(q * 64 + lane) * 2] * hc + summ[(q * 64 + lane) * 2 + 1];
            h = hc;
            const bf16* grp = P_GR + ((size_t)b * SEQ + t0) * DH + gc; bf16* op = P_MIX + ((size_t)b * SEQ + t0) * DM + DH + gc;
            float gv[32];
#pragma unroll
            for (int t = 0; t < 32; ++t) gv[t] = bf2f(grp[(size_t)t * DH]);
            asm volatile("s_waitcnt vmcnt(0)" ::: "memory");
#pragma unroll
            for (int t = 0; t < 32; ++t) { h = av[t] * h + uv[t]; const float g = gv[t]; const float y = 0.7978845608028654f * (g + 0.044715f * g * g * g);
                const float th = 1.0f - 2.0f * __builtin_amdgcn_rcpf(1.0f + __builtin_amdgcn_exp2f((2.0f * 1.4426950408889634f) * y)); op[(size_t)t * DM] = (bf16)f2bf(h * (0.5f * g * (1.0f + th))); }
        }
        asm volatile("s_waitcnt vmcnt(0)" ::: "memory");
        LDS_WAIT(); __syncthreads();
    }
}
__device__ __forceinline__ void rglru_single(Frame& F) {
    LAS unsigned char* wl = F.lds + RING_OFF + F.wave * 16384;
    LAS float* summ = (LAS float*)(F.lds + SUMM_OFF);
    const float* in_conv_w = F.in(I_conv_w); const float* in_conv_b = F.in(I_conv_b); const float* in_b_rg_a = F.in(I_b_rg_a); const float* in_b_rg_x = F.in(I_b_rg_x); const float* in_lam = F.in(I_lam);
    const int lane = F.lane, w = F.wave;
    for (int it = F.vcu; it < NB * 8 * 16; it += F.G) {
        const int sp = it & 15, n = (it >> 4) & 7, b = it >> 7;
        const int gc = n * 64 + lane, t0 = sp * 256 + w * 32;
        const bf16* xrp = P_XR + ((size_t)b * SEQ) * DH + gc;
        float xin[35];
#pragma unroll
        for (int i = 0; i < 35; ++i) { const int tt = t0 - 3 + i, tc = tt < 0 ? 0 : tt; const float v = bf2f(xrp[(size_t)tc * DH]); xin[i] = tt < 0 ? 0.f : v; }
        const float cw0 = in_conv_w[gc], cw1 = in_conv_w[DH + gc], cw2 = in_conv_w[2 * DH + gc], cw3 = in_conv_w[3 * DH + gc], cb = in_conv_b[gc];
        float xc[32];
#pragma unroll
        for (int t = 0; t < 32; ++t) xc[t] = ((cw0 * xin[t] + cw1 * xin[t + 1]) + (cw2 * xin[t + 2] + cw3 * xin[t + 3])) + cb;
        LAS unsigned short* w16 = (LAS unsigned short*)wl;
#pragma unroll
        for (int t = 0; t < 32; ++t) w16[t * 64 + lane] = (unsigned short)f2bf(xc[t]);
        LDS_WAIT(); asm volatile("" ::: "memory");
        const int tok = lane & 31, hh = lane >> 5;
        bf16x8 af[4];
#pragma unroll
        for (int s = 0; s < 4; ++s) af[s] = *(const LAS bf16x8*)(wl + (tok * 64 + 16 * s + 8 * hh) * 2);
        f32x16 ga[2], gx[2];
#pragma unroll
        for (int nt = 0; nt < 2; ++nt) { ga[nt] = f32x16{}; gx[nt] = f32x16{};
            const size_t wo = ((size_t)(n * 64 + tok + 32 * nt)) * 64 + 8 * hh;
#pragma unroll
            for (int s = 0; s < 4; ++s) { const bf16x8 ba = *(const GAS bf16x8*)(P_WA_T + wo + 16 * s), bx = *(const GAS bf16x8*)(P_WX_T + wo + 16 * s);
                ga[nt] = __builtin_amdgcn_mfma_f32_32x32x16_bf16(af[s], ba, ga[nt], 0, 0, 0); gx[nt] = __builtin_amdgcn_mfma_f32_32x32x16_bf16(af[s], bx, gx[nt], 0, 0, 0); } }
        LDS_WAIT(); asm volatile("" ::: "memory");
        LAS float* wf = (LAS float*)wl;
#pragma unroll
        for (int nt = 0; nt < 2; ++nt)
#pragma unroll
            for (int rr = 0; rr < 16; ++rr) { const int tr = crow(rr, hh); wf[tr * 64 + tok + 32 * nt] = ga[nt][rr]; wf[2048 + tr * 64 + tok + 32 * nt] = gx[nt][rr]; }
        LDS_WAIT(); asm volatile("" ::: "memory");
        const float ba_ = in_b_rg_a[gc], bx_ = in_b_rg_x[gc], spc = log1pf(expf(-in_lam[gc]));
        float av[32], uv[32];
#pragma unroll
        for (int t = 0; t < 32; ++t) { const float pa = wf[t * 64 + lane] + ba_, px = wf[2048 + t * 64 + lane] + bx_;
            const float rg = __builtin_amdgcn_rcpf(1.0f + __builtin_amdgcn_exp2f(-1.4426950408889634f * pa)), ig = __builtin_amdgcn_rcpf(1.0f + __builtin_amdgcn_exp2f(-1.4426950408889634f * px));
            const float a = __builtin_amdgcn_exp2f((-8.0f * 1.4426950408889634f) * rg * spc);
            av[t] = a; uv[t] = __builtin_amdgcn_sqrtf(fmaxf(1.0f - a * a, 0.f)) * (ig * xc[t]); }
        LDS_WAIT(); asm volatile("" ::: "memory");
        float h = 0.f, P = 1.f;
#pragma unroll
        for (int t = 0; t < 32; ++t) { h = av[t] * h + uv[t]; P *= av[t]; }
        summ[(w * 64 + lane) * 2] = P; summ[(w * 64 + lane) * 2 + 1] = h;
        LDS_WAIT(); __syncthreads();
        const bf16* grp = P_GR + ((size_t)b * SEQ + t0) * DH + gc; bf16* op = P_MIX + ((size_t)b * SEQ + t0) * DM + DH + gc;
        float gv[32];
#pragma unroll
        for (int t = 0; t < 32; ++t) gv[t] = bf2f(grp[(size_t)t * DH]);
        LAS float* hspan = (LAS float*)(F.lds + TILE_OFF);
        if (w == 0) {
            float Pt = 1.f, Ht = 0.f;
#pragma unroll
            for (int q = 0; q < 8; ++q) { const float p = summ[(q * 64 + lane) * 2], hq = summ[(q * 64 + lane) * 2 + 1]; Ht = p * Ht + hq; Pt *= p; }
            unsigned long long* rx = (unsigned long long*)(F.ws + WS_CTL + (size_t)CW_RX * 4) + ((size_t)((b * 8 + n) * 16) * 64 + lane);
            __hip_atomic_store(rx + sp * 64, ((unsigned long long)__float_as_uint(Ht) << 32) | (unsigned long long)(__float_as_uint(Pt) | 1u), RLX_AGENT);
            unsigned long long v[15]; unsigned spins = 0u;
            for (;;) { bool ok = true;
#pragma unroll
                for (int q = 0; q < 15; ++q) { v[q] = q < sp ? __hip_atomic_load(rx + q * 64, RLX_AGENT) : 1ull; ok = ok && (v[q] != 0ull); }
                if (__all(ok)) break;
                __builtin_amdgcn_s_sleep(1); if (++spins > (1u << 20)) { if (lane == 0) __hip_atomic_store((unsigned*)(F.ws + WS_CTL) + CW_TMO, 0xA11u, RLX_AGENT); break; } }
            float hc = 0.f;
#pragma unroll
            for (int q = 0; q < 15; ++q) if (q < sp) hc = __uint_as_float((unsigned)v[q]) * hc + __uint_as_float((unsigned)(v[q] >> 32));
            hspan[lane] = hc;
        }
        LDS_WAIT(); __syncthreads();
        {   float hc = hspan[lane];
            for (int q = 0; q < w; ++q) hc = summ[(q * 64 + lane) * 2] * hc + summ[(q * 64 + lane) * 2 + 1];
            h = hc;
            asm volatile("s_waitcnt vmcnt(0)" ::: "memory");
#pragma unroll
            for (int t = 0; t < 32; ++t) { h = av[t] * h + uv[t]; const float g = gv[t]; const float y = 0.7978845608028654f * (g + 0.044715f * g * g * g);
                const float th = 1.0f - 2.0f * __builtin_amdgcn_rcpf(1.0f + __builtin_amdgcn_exp2f((2.0f * 1.4426950408889634f) * y)); op[(size_t)t * DM] = (bf16)f2bf(h * (0.5f * g * (1.0f + th))); }
        }
        asm volatile("s_waitcnt vmcnt(0)" ::: "memory");
        LDS_WAIT(); __syncthreads();
    }
}
typedef float cvt_f32x2 __attribute__((ext_vector_type(2))); typedef __bf16 cvt_bf16x2 __attribute__((ext_vector_type(2)));
__device__ __forceinline__ unsigned cvt2bf(float lo, float hi) { const cvt_f32x2 v = {lo, hi}; return __builtin_bit_cast(unsigned, __builtin_convertvector(v, cvt_bf16x2)); }
struct AttnUnit { int p, dsh, r, L0; size_t hb; };
__device__ __forceinline__ void attn_decode(int u, AttnUnit& a) {
    const int uu = u & 15, bh = (u >> 4) & 31; a.p = u >> 9; a.dsh = 2 * a.p;
    const int spr = 16 >> a.dsh;
    a.r = uu / spr; a.L0 = (uu % spr) * 256; a.hb = ((size_t)(bh >> 3) * SEQ) * DH + (bh & 7) * HD;
}
constexpr int ATT_KS = 144, ATT_VS = 192, ATT_VOFF = 384 * ATT_KS;
static_assert(ATT_VOFF + 384 * ATT_VS <= RING_BYTES, "attention LDS");
__device__ __forceinline__ void attn_items(Frame& F) {
    LAS unsigned char* kl = F.lds + RING_OFF; LAS unsigned char* vl = F.lds + RING_OFF + ATT_VOFF;
    const int lane = F.lane, c = lane & 31, hh = lane >> 5, w = F.wave, tid = F.tid;
    const float NEG = -1e30f;
    const int gi = lane >> 4, li = lane & 15;
    const int tr_base = (4 * hh + (li >> 2)) * ATT_VS + (16 * (gi & 1) + 4 * (li & 3)) * 2;
    const bf16 *QB = P_QB, *KB = P_KB, *VB = P_VB;
    constexpr int NUNIT = 3 * NB * NHEAD * 16;
    int u = F.vcu; if (u >= NUNIT) return;
    AttnUnit cu; attn_decode(u, cu);
    v4u kr[6], vr[6]; bf16x8 qn[4];
#define ATT_LOAD(A) do { _Pragma("unroll") for (int i = 0; i < 6; ++i) { const int cid = tid + 512 * i, rho = cid >> 3, ch = cid & 7; const int sub = (A).L0 - 128 + rho; \
        const int subc = sub < 0 ? 0 : sub; const size_t go = (A).hb + (size_t)((subc << (A).dsh) + (A).r) * DH + ch * 8; kr[i] = *(const GAS v4u*)(KB + go); vr[i] = *(const GAS v4u*)(VB + go); } \
        { const int tq = (((A).L0 + 32 * w + c) << (A).dsh) + (A).r; _Pragma("unroll") for (int s = 0; s < 4; ++s) qn[s] = *(const GAS bf16x8*)(QB + (A).hb + (size_t)tq * DH + 16 * s + 8 * hh); } } while (0)
    ATT_LOAD(cu);
    for (;;) {
#pragma unroll
        for (int i = 0; i < 6; ++i) { const int cid = tid + 512 * i, rho = cid >> 3, ch = cid & 7;
            *(LAS v4u*)(kl + rho * ATT_KS + ch * 16) = kr[i]; *(LAS v4u*)(vl + rho * ATT_VS + ch * 16) = vr[i]; }
        bf16x8 qf[4];
#pragma unroll
        for (int s = 0; s < 4; ++s) qf[s] = qn[s];
        const int un = u + F.G; const bool more = un < NUNIT; AttnUnit nx = cu;
        if (more) { attn_decode(un, nx); ATT_LOAD(nx); }
        LDS_WAIT(); __syncthreads();
        float m = NEG, l = 0.f; f32x16 o0 = f32x16{}, o1 = f32x16{};
        for (int j = 0; j < 5; ++j) {
            const int rho0 = 32 * w + 32 * j; if (cu.L0 - 128 + rho0 < 0) continue;
            bf16x8 kf[4];
#pragma unroll
            for (int s = 0; s < 4; ++s) kf[s] = *(const LAS bf16x8*)(kl + (rho0 + c) * ATT_KS + (16 * s + 8 * hh) * 2);
            f32x16 sc = f32x16{};
#pragma unroll
            for (int s = 0; s < 4; ++s) sc = __builtin_amdgcn_mfma_f32_32x32x16_bf16(kf[s], qf[s], sc, 0, 0, 0);
            if (j == 0) {
#pragma unroll
                for (int rr = 0; rr < 16; ++rr) if (crow(rr, hh) < c) sc[rr] = NEG;
            }
            if (j == 4) {
#pragma unroll
                for (int rr = 0; rr < 16; ++rr) if (crow(rr, hh) > c) sc[rr] = NEG;
            }
            float mx = fmaxf(fmaxf(sc[0], sc[1]), fmaxf(sc[2], sc[3]));
#pragma unroll
            for (int rr = 4; rr < 16; rr += 4) mx = fmaxf(mx, fmaxf(fmaxf(sc[rr], sc[rr + 1]), fmaxf(sc[rr + 2], sc[rr + 3])));
            mx = fmaxf(mx, __shfl_xor(mx, 32));
            if (__any(mx > m)) { const float mn = fmaxf(m, mx), alpha = __builtin_amdgcn_exp2f(m - mn); m = mn; l *= alpha;
#pragma unroll
                for (int rr = 0; rr < 16; ++rr) { o0[rr] *= alpha; o1[rr] *= alpha; } }
            float ps = 0.f;
#pragma unroll
            for (int rr = 0; rr < 16; ++rr) { sc[rr] = __builtin_amdgcn_exp2f(sc[rr] - m); ps += sc[rr]; }
            l += ps;
            v4u pb0, pb1;
            pb0.x = cvt2bf(sc[0], sc[1]); pb0.y = cvt2bf(sc[2], sc[3]); pb0.z = cvt2bf(sc[4], sc[5]); pb0.w = cvt2bf(sc[6], sc[7]);
            pb1.x = cvt2bf(sc[8], sc[9]); pb1.y = cvt2bf(sc[10], sc[11]); pb1.z = cvt2bf(sc[12], sc[13]); pb1.w = cvt2bf(sc[14], sc[15]);
            LAS unsigned char* vt = vl + rho0 * ATT_VS + tr_base;
#pragma unroll
            for (int dt = 0; dt < 2; ++dt)
#pragma unroll
                for (int s = 0; s < 2; ++s) {
                    const v4i16_t lo = __builtin_amdgcn_ds_read_tr16_b64_v4i16((LAS v4i16_t*)(vt + (16 * s) * ATT_VS + 64 * dt));
                    const v4i16_t hi = __builtin_amdgcn_ds_read_tr16_b64_v4i16((LAS v4i16_t*)(vt + (16 * s + 8) * ATT_VS + 64 * dt));
                    const bf16x8 af = (bf16x8){lo[0], lo[1], lo[2], lo[3], hi[0], hi[1], hi[2], hi[3]};
                    const bf16x8 pf = __builtin_bit_cast(bf16x8, s ? pb1 : pb0);
                    if (dt == 0) o0 = __builtin_amdgcn_mfma_f32_32x32x16_bf16(af, pf, o0, 0, 0, 0); else o1 = __builtin_amdgcn_mfma_f32_32x32x16_bf16(af, pf, o1, 0, 0, 0);
                }
        }
        asm volatile("s_waitcnt vmcnt(0)" ::: "memory");
        {   l += __shfl_xor(l, 32);
            const float inv = 1.0f / l;
            const int tq = ((cu.L0 + 32 * w + c) << cu.dsh) + cu.r;
            bf16* op = P_OP + (size_t)cu.p * TT * DH + cu.hb + (size_t)tq * DH;
#pragma unroll
            for (int g4 = 0; g4 < 4; ++g4) {
                v2u w0, w1; w0.x = cvt2bf(o0[4 * g4] * inv, o0[4 * g4 + 1] * inv); w0.y = cvt2bf(o0[4 * g4 + 2] * inv, o0[4 * g4 + 3] * inv);
                w1.x = cvt2bf(o1[4 * g4] * inv, o1[4 * g4 + 1] * inv); w1.y = cvt2bf(o1[4 * g4 + 2] * inv, o1[4 * g4 + 3] * inv);
                *(GAS v2u*)(op + 8 * g4 + 4 * hh) = w0; *(GAS v2u*)(op + 32 + 8 * g4 + 4 * hh) = w1; }
            if (hh == 0) P_LSE[(((size_t)cu.p * TT * DH + cu.hb + (size_t)tq * DH) >> 6)] = m + __builtin_amdgcn_logf(l); }
        LDS_WAIT(); __syncthreads();
        if (!more) break;
        u = un; cu = nx;
    }
#undef ATT_LOAD
}
__device__ __forceinline__ void attn_merge(Frame& F) {
    const int gt = F.vcu * (NWAVES * 64) + F.tid, NGT = F.G * NWAVES * 64;
    for (int idx = gt; idx < TT * 64; idx += NGT) {
        const int t = idx >> 6, ch = idx & 63, h = ch >> 3;
        const float l0 = P_LSE[(size_t)t * NHEAD + h], l1 = P_LSE[((size_t)TT + t) * NHEAD + h], l2 = P_LSE[((size_t)2 * TT + t) * NHEAD + h];
        const float mx = fmaxf(l0, fmaxf(l1, l2));
        float w0 = __builtin_amdgcn_exp2f(l0 - mx), w1 = __builtin_amdgcn_exp2f(l1 - mx), w2 = __builtin_amdgcn_exp2f(l2 - mx);
        const float inv = 1.0f / (w0 + w1 + w2); w0 *= inv; w1 *= inv; w2 *= inv;
        const v4u a = *(const GAS v4u*)(P_OP + (size_t)t * DH + ch * 8), bq = *(const GAS v4u*)(P_OP + ((size_t)TT + t) * DH + ch * 8), cq = *(const GAS v4u*)(P_OP + ((size_t)2 * TT + t) * DH + ch * 8);
        v4u o;
#pragma unroll
        for (int k = 0; k < 4; ++k) {
            const float lo = w0 * bf2f((unsigned short)(a[k] & 0xffffu)) + w1 * bf2f((unsigned short)(bq[k] & 0xffffu)) + w2 * bf2f((unsigned short)(cq[k] & 0xffffu));
            const float hi = w0 * bf2f((unsigned short)(a[k] >> 16)) + w1 * bf2f((unsigned short)(bq[k] >> 16)) + w2 * bf2f((unsigned short)(cq[k] >> 16));
            o[k] = pk2(lo, hi); }
        *(GAS v4u*)(P_MIX + (size_t)t * DM + ch * 8) = o;
        asm volatile("" ::: "memory");
    }
}

#ifndef ROUTER_SPLIT
#define ROUTER_SPLIT 2
#endif
__device__ __forceinline__ void p6_rows(Frame& F, int only = 0) {
    typedef float f32x2 __attribute__((ext_vector_type(2)));
    const float* in_g_ffn = F.in(I_g_ffn); const float* in_b_router = F.in(I_b_router);
    constexpr int RS = ROUTER_SPLIT;
    const bool split = (F.G % RS) == 0;
    if (split && (F.vcu % RS) != 0) { if (only != 1) p0_transposes(F, 0, PT_WGU, (F.vcu / RS) * (RS - 1) + (F.vcu % RS) - 1, (F.G / RS) * (RS - 1)); return; }
    const int rrank = split ? F.vcu / RS : F.vcu, rn = split ? F.G / RS : F.G;
    if (only >= 2) return;
    LAS float* wl = (LAS float*)(F.lds + RING_OFF);
    LAS int* wc = (LAS int*)(F.lds + SUMM_OFF);
    for (int i = F.tid; i < NEXP * DM / 4; i += NWAVES * 64) ((LAS f32x4*)wl)[i] = ((const GAS f32x4*)P_WRT)[i];
    LDS_WAIT(); __syncthreads();
    const int lane = F.lane, w = F.wave, el = lane & 15, qsh = lane & 48;
    const float biasA = in_b_router[el], biasB = in_b_router[16 + el];
    const __amdgpu_buffer_rsrc_t rs_x1 = __builtin_amdgcn_make_buffer_rsrc((void*)P_X1, 0, 0x7ffffff0, 0x00020000), rs_h8 = __builtin_amdgcn_make_buffer_rsrc((void*)P_XN8, 0, 0x7ffffff0, 0x00020000);
    typedef unsigned u32x4_t __attribute__((ext_vector_type(4)));
#define P6_LOADROW(dst, m) do { _Pragma("unroll") for (int j_ = 0; j_ < 4; ++j_) { const v2u t_ = __builtin_bit_cast(v2u, __builtin_amdgcn_raw_buffer_load_b64(rs_x1, lane * 8 + j_ * 512, (m) * (DM * 2), 0)); \
        (dst)[j_] = (f32x4){bf2f((unsigned short)(t_.x & 0xffffu)), bf2f((unsigned short)(t_.x >> 16)), bf2f((unsigned short)(t_.y & 0xffffu)), bf2f((unsigned short)(t_.y >> 16))}; } } while (0)
    f32x4 xa[4][4];
    if (rrank < TT / 64) {
#pragma unroll
      for (int q = 0; q < 4; ++q) P6_LOADROW(xa[q], rrank * 64 + w * 8 + q); }
    for (int chunk = rrank; chunk < TT / 64; chunk += rn) {
      int wcount = 0;
      const int b = (chunk * 64) / SEQ;
      const float* mb = P_MOD + (size_t)b * NMOD;
      const int m0 = chunk * 64 + w * 8;
#pragma nounroll
      for (int st = 0; st < 2; ++st) {
        const int m4 = m0 + 4 * st;
        f32x4 v[4][4];
        { float ra[4];
#pragma unroll
          for (int q = 0; q < 4; ++q) { float sa = 0.f;
#pragma unroll
              for (int j = 0; j < 4; ++j) sa += (xa[q][j].x * xa[q][j].x + xa[q][j].y * xa[q][j].y) + (xa[q][j].z * xa[q][j].z + xa[q][j].w * xa[q][j].w);
              ra[q] = 1.0f / sqrtf(wave_sum(sa) * (1.0f / DM) + NORM_EPS); }
#pragma unroll
          for (int j = 0; j < 4; ++j) { const int col = 4 * lane + 256 * j;
              const f32x4 Gm = *(const f32x4*)(in_g_ffn + col) * (*(const f32x4*)(mb + 4 * DM + col) + 1.0f), Sm = *(const f32x4*)(mb + 3 * DM + col);
#pragma unroll
              for (int q = 0; q < 4; ++q) { v[q][j] = (xa[q][j] * ra[q]) * Gm + Sm;
                  __builtin_amdgcn_raw_buffer_store_b32(pg8::pk4_fp8(v[q][j].x * SC_H, v[q][j].y * SC_H, v[q][j].z * SC_H, v[q][j].w * SC_H), rs_h8, lane * 4 + j * 256, (m4 + q) * DM, 0); } } }
        float val[2];
#pragma unroll
        for (int hf = 0; hf < 2; ++hf) {
          float k16[16], k8[8], k4[4], k2[2], k1;
          const bool up32 = (lane & 32) != 0, up16 = (lane & 16) != 0;
#pragma unroll
          for (int e16 = 0; e16 < 16; ++e16) { const int e = hf * 16 + e16; f32x4 w4[4]; float p[4];
#pragma unroll
              for (int j = 0; j < 4; ++j) w4[j] = *(const LAS f32x4*)(wl + e * DM + 4 * lane + 256 * j);
#pragma unroll
              for (int q = 0; q < 4; ++q) { f32x2 a0 = (f32x2){0.f, 0.f};
#pragma unroll
                  for (int j = 0; j < 4; ++j) { a0 += (f32x2){v[q][j].x, v[q][j].y} * (f32x2){w4[j].x, w4[j].y}; a0 += (f32x2){v[q][j].z, v[q][j].w} * (f32x2){w4[j].z, w4[j].w}; }
                  p[q] = a0.x + a0.y; }
              const float sA = (up32 ? p[2] : p[0]) + __shfl_xor(up32 ? p[0] : p[2], 32), sB = (up32 ? p[3] : p[1]) + __shfl_xor(up32 ? p[1] : p[3], 32);
              k16[e16] = (up16 ? sB : sA) + __shfl_xor(up16 ? sA : sB, 16);
              if (e16 > 1) asm volatile("" : "+v"(k16[e16 - 2]));
              if ((e16 & 3) == 3) asm volatile("" ::: "memory"); }
          { const bool up = (lane & 8) != 0;
#pragma unroll
            for (int i = 0; i < 8; ++i) { const float keep = up ? k16[8 + i] : k16[i], send = up ? k16[i] : k16[8 + i]; k8[i] = keep + __shfl_xor(send, 8); } }
          { const bool up = (lane & 4) != 0;
#pragma unroll
            for (int i = 0; i < 4; ++i) { const float keep = up ? k8[4 + i] : k8[i], send = up ? k8[i] : k8[4 + i]; k4[i] = keep + __shfl_xor(send, 4); } }
          { const bool up = (lane & 2) != 0;
#pragma unroll
            for (int i = 0; i < 2; ++i) { const float keep = up ? k4[2 + i] : k4[i], send = up ? k4[i] : k4[2 + i]; k2[i] = keep + __shfl_xor(send, 2); } }
          { const bool up = (lane & 1) != 0; const float keep = up ? k2[1] : k2[0], send = up ? k2[0] : k2[1]; k1 = keep + __shfl_xor(send, 1); }
          val[hf] = k1 + (hf ? biasB : biasA);
        }
        {
            const int mn = st == 0 ? m4 + 4 : (chunk + rn < TT / 64 ? (chunk + rn) * 64 + w * 8 : m0);
#pragma unroll
            for (int q = 0; q < 4; ++q) P6_LOADROW(xa[q], mn + q); }
        float tv[4]; int te[4];
#pragma unroll
        for (int r = 0; r < 4; ++r) { float mx = fmaxf(val[0], val[1]);
            mx = fmaxf(mx, __shfl_xor(mx, 1)); mx = fmaxf(mx, __shfl_xor(mx, 2)); mx = fmaxf(mx, __shfl_xor(mx, 4)); mx = fmaxf(mx, __shfl_xor(mx, 8));
            const unsigned long long bA = __ballot(val[0] == mx), bB = __ballot(val[1] == mx);
            const unsigned mA = (unsigned)(bA >> qsh) & 0xffffu, mB = (unsigned)(bB >> qsh) & 0xffffu;
            const int e = mA ? __builtin_ctz(mA) : 16 + __builtin_ctz(mB | 0x10000u);
            te[r] = e; tv[r] = mx;
            if (el == (e & 15)) { if (e < 16) val[0] = -INFINITY; else val[1] = -INFINITY; } }
        const float e1 = expf(tv[1] - tv[0]), e2 = expf(tv[2] - tv[0]), e3 = expf(tv[3] - tv[0]); const float inv = 1.0f / (1.0f + e1 + e2 + e3);
        int lpv = 0;
#pragma unroll
        for (int q = 0; q < 4; ++q)
#pragma unroll
          for (int r = 0; r < 4; ++r) { const int es = __builtin_amdgcn_readlane(te[r], 16 * q); const int lp = __builtin_amdgcn_readlane(wcount, es);
              if (lane == es) ++wcount; if (lane == 16 * q + r) lpv = lp; }
        if (el < 4) { const int q = lane >> 4, m = m4 + q, ti = 4 * st + q;
            const int e = el == 0 ? te[0] : el == 1 ? te[1] : el == 2 ? te[2] : te[3];
            const float g = (el == 0 ? 1.0f : el == 1 ? e1 : el == 2 ? e2 : e3) * inv;
            P_TOK_E[m * 4 + el] = e; P_TOK_GATE[m * 4 + el] = g;
            wc[512 + ((w * 8 + ti) * 4 + el) * 2] = e; wc[512 + ((w * 8 + ti) * 4 + el) * 2 + 1] = lpv; }
      }
      if (lane < 32) wc[w * 32 + lane] = wcount;
      LDS_WAIT(); __syncthreads();
      if (lane < 32) { int pre = 0; for (int q = 0; q < w; ++q) pre += wc[q * 32 + lane]; wc[256 + w * 32 + lane] = pre;
          if (w == 7) P_BCNT[chunk * 32 + lane] = pre + wcount; }
      LDS_WAIT(); asm volatile("" ::: "memory");
      if (lane < 32) { const int ti = lane >> 2, r = lane & 3; const int e = wc[512 + ((w * 8 + ti) * 4 + r) * 2], l = wc[512 + ((w * 8 + ti) * 4 + r) * 2 + 1];
          P_TOK_POS[(chunk * 64 + w * 8 + ti) * 4 + r] = wc[256 + w * 32 + e] + l; }
      asm volatile("s_waitcnt vmcnt(0)" ::: "memory");
      LDS_WAIT(); __syncthreads();
    }
#undef P6_LOADROW
}
__device__ __forceinline__ void p7_gather(Frame& F) {
    LAS int* pt = (LAS int*)(F.lds + RING_OFF);
    volatile LAS int* lb = (volatile LAS int*)(F.lds + TILE_OFF);
    { const int e = F.tid & 31, seg = F.tid >> 5; int s = 0;
      for (int j = 0; j < 16; ++j) s += P_BCNT[(seg * 16 + j) * 32 + e];
      pt[8192 + seg * 32 + e] = s; LDS_WAIT(); __syncthreads();
      int base = 0, tot = 0; for (int q = 0; q < 16; ++q) { const int x = pt[8192 + q * 32 + e]; if (q < seg) base += x; tot += x; }
      for (int j = 0; j < 16; ++j) { pt[(seg * 16 + j) * 32 + e] = base; base += P_BCNT[(seg * 16 + j) * 32 + e]; }
      if (seg == 0) lb[64 + e] = tot; }
    LDS_WAIT(); __syncthreads();
    if (F.tid == 0) { int acc = 0, nt = 0;
        for (int e = 0; e < NEXP; ++e) { const int c = lb[64 + e]; lb[e] = acc; const int tiles = (c + 255) >> 8;
            if (blockIdx.x == 0) for (int k = 0; k < tiles; ++k) P_TILE_E[nt + k] = e;
            nt += tiles; acc += tiles * 256; }
        lb[32] = acc; if (blockIdx.x == 0) P_TILE_N[0] = nt; }
    LDS_WAIT(); __syncthreads();
    const int gt = F.vcu * (NWAVES * 64) + F.tid, NGT = F.G * NWAVES * 64;
    for (int idx = gt; idx < TT * TOPK + NEXP * 256; idx += NGT) {
        if (idx < TT * TOPK) { const int e = P_TOK_E[idx], pos = P_TOK_POS[idx]; const int slot = lb[e] + pt[(idx >> 8) * 32 + e] + pos; P_TOK_SLOT[idx] = slot; P_SLOT_TOK[slot] = idx >> 2; }
        else { const int q = idx - TT * TOPK, e = q >> 8, i = q & 255; const int c = lb[64 + e]; const int padded = ((c + 255) >> 8) << 8; if (c + i < padded) P_SLOT_TOK[lb[e] + c + i] = TT; }
    }
    if (blockIdx.x == 0 && F.tid < 64) ((GAS v4u*)(P_XN8 + (size_t)TT * DM))[F.tid] = (v4u){0u, 0u, 0u, 0u};
    asm volatile("s_waitcnt vmcnt(0)" ::: "memory");
    LDS_WAIT(); __syncthreads();
    if (F.G % ROUTER_SPLIT) p0_transposes(F, 0, PT_WGU);
}
__device__ __forceinline__ void p10_final(Frame& F) {
    const float* in_g_final = F.in(I_g_final); float* out_p = (float*)F.in(22);
    const int gw = F.vcu * NWAVES + F.wave, NGW = F.G * NWAVES, lane = F.lane;
    const bf16* Y2 = P_Y2;
    for (int m = gw; m < TT; m += NGW) {
        const int b = m / SEQ;
        const GAS v2u* xr = (const GAS v2u*)(P_X1 + (size_t)m * DM) + lane;
        f32x4 v[4], a[4];
#pragma unroll
        for (int j = 0; j < 4; ++j) { const v2u t = xr[64 * j]; v[j] = (f32x4){bf2f((unsigned short)(t.x & 0xffffu)), bf2f((unsigned short)(t.x >> 16)), bf2f((unsigned short)(t.y & 0xffffu)), bf2f((unsigned short)(t.y >> 16))}; a[j] = (f32x4){0.f, 0.f, 0.f, 0.f}; }
#pragma unroll
        for (int k = 0; k < 4; ++k) { const int slot = P_TOK_SLOT[m * 4 + k]; const float g = P_TOK_GATE[m * 4 + k];
            const GAS v2u* yr = (const GAS v2u*)(Y2 + (size_t)slot * DM) + lane;
#pragma unroll
            for (int j = 0; j < 4; ++j) { const v2u y = yr[64 * j];
                a[j].x += g * bf2f((unsigned short)(y.x & 0xffffu)); a[j].y += g * bf2f((unsigned short)(y.x >> 16)); a[j].z += g * bf2f((unsigned short)(y.y & 0xffffu)); a[j].w += g * bf2f((unsigned short)(y.y >> 16)); } }
        const float* gf = P_MOD + (size_t)b * NMOD + 5 * DM; float ss = 0.f;
#pragma unroll
        for (int j = 0; j < 4; ++j) { const f32x4 gt = *(const f32x4*)(gf + 4 * lane + 256 * j); v[j] = v[j] + gt * a[j]; ss += (v[j].x * v[j].x + v[j].y * v[j].y) + (v[j].z * v[j].z + v[j].w * v[j].w); }
        const float rstd = 1.0f / sqrtf(wave_sum(ss) * (1.0f / DM) + NORM_EPS);
        GAS f32x4* orow = (GAS f32x4*)(out_p + (size_t)m * DM) + lane;
#pragma unroll
        for (int j = 0; j < 4; ++j) { const f32x4 g = *(const f32x4*)(in_g_final + 4 * lane + 256 * j); orow[64 * j] = (v[j] * rstd) * g; }        asm volatile("" ::: "memory");
    }
}

#ifndef DUP_MASK
#define DUP_MASK 0
#endif
struct Args { const float* in[22]; float* out; unsigned char* ws; int ph_lo, ph_hi, li, pad; };
__global__ void __launch_bounds__(NWAVES * 64, 2) hymba_fwd(Args args) {
    extern __shared__ __attribute__((aligned(16))) unsigned char lds[];
    Frame F;
    F.lds = (LAS unsigned char*)lds;
    F.tid = threadIdx.x; F.lane = F.tid & 63; F.wave = __builtin_amdgcn_readfirstlane(F.tid >> 6);
    F.G = gridDim.x; { const int bx = blockIdx.x; F.vcu = (F.G % 8 == 0) ? (bx % 8) * (F.G / 8) + bx / 8 : bx; }
    unsigned char* ws = args.ws;
    F.ws = ws; F.ka = (const __attribute__((address_space(4))) void*)__builtin_amdgcn_kernarg_segment_ptr();
    for (int u = F.tid; u < (LDS_BYTES - LDSCTL_OFF) / 4; u += NWAVES * 64) ((LAS unsigned*)(F.lds + LDSCTL_OFF))[u] = 0u;
    __syncthreads();
#define CTLP ((gu32*)(F.ws + WS_CTL))
#define MISCP ((volatile LAS unsigned*)(F.lds + MISC_OFF))
    if (N_LAUNCHES != PER_PHASE) (void)xcd_barrier_post((unsigned*)(CTLP + CW_BAR), MISCP + 8);
#define GRID_BAR(seam) do { if (N_LAUNCHES == PER_PHASE) { if (F.tid == 0) __hip_atomic_store(CTLP + CW_TMO, 0xBADBA0u | (unsigned)(seam), RLX_AGENT); } \
    else { XcdBarrier bar_; bar_.bar = (unsigned*)(CTLP + CW_BAR); bar_.x = xb_xcc_id(); bar_.st = MISCP + 8; xcd_barrier(bar_); if (DUPK(13)) xcd_barrier(bar_); } asm volatile("" : "+v"(F.tid), "+v"(F.lane)); } while (0)
    const int lo = (N_LAUNCHES == 1) ? 0 : args.ph_lo, hi = (N_LAUNCHES == 1) ? PER_PHASE : args.ph_hi;
#ifndef PHASE_MASK
#define PHASE_MASK 0x7ff
#endif
#define IN(k) (((PHASE_MASK >> (k)) & 1) && lo <= (k) && (k) < hi)
#define BOTH(k) (IN(k) && IN((k) + 1))
#define DUPK(k) ((DUP_MASK >> (k)) & 1)
#define RUN_P2() do { pg8::Gemm g{P_XN, P_WIN_T, TT, INCOLS, DM}; pg8::StaticOrder S; S.init(TT, INCOLS, F.G, (int)blockIdx.x); \
        pg8::EpiBf16<0> E{P_QB, DH, nullptr, DH, (size_t)TT * DH, C2}; \
        pg8::gemm_phase<pg8::EpiBf16<0>, pg8::StaticOrder, true, true>(F.lds + RING_OFF, g, S, E); } while (0)
#define RUN_P5() do { pg8::Gemm g{P_MIX, P_WOUT_T, TT, DM, DM}; pg8::StaticOrder S; S.init(TT, DM, F.G, (int)blockIdx.x); \
        pg8::EpiResGate E{F.in(I_x), P_X1, DM, P_MOD + 2 * DM, NMOD, SEQ}; \
        pg8::gemm_phase<pg8::EpiResGate, pg8::StaticOrder, true, true>(F.lds + RING_OFF, g, S, E); } while (0)
#define RUN_P8() do { const int ntm = P_TILE_N[0]; \
        pg8::Gemm g{(const pg8::bf16_t*)P_XN8, (const pg8::bf16_t*)P_WGU8, ntm * 256, DE2, DM / 2}; pg8::GroupedOrder S; S.init(P_TILE_E, ntm, 8, F.G, (int)blockIdx.x); \
        LAS int* rt = (LAS int*)(F.lds + ROWTAB_OFF); { pg8::Unit u_; for (int i_ = 0; i_ < ROWTAB_UNITS && S.next(i_, u_); ++i_) if (F.tid < 256) rt[i_ * 256 + F.tid] = P_SLOT_TOK[u_.pm * 256 + F.tid] * DM; } \
        LDS_WAIT(); __syncthreads(); \
        pg8::EpiSwiglu E{P_ACT8, F.in(I_b_gate_up), 1.0f / (SC_H * SC_W), SC_ACT}; \
        pg8::gemm_phase<pg8::EpiSwiglu, pg8::GroupedOrder, true, true, true, true>(F.lds + RING_OFF, g, S, E, rt); \
        asm volatile("s_waitcnt vmcnt(0)" ::: "memory"); __syncthreads(); p0_transposes(F, PT_WGU, P0T_EXPERTS); } while (0)
#define RUN_P9() do { const int ntm = P_TILE_N[0]; \
        pg8::Gemm g{(const pg8::bf16_t*)P_ACT8, (const pg8::bf16_t*)P_WD8, ntm * 256, DM, DM / 2}; pg8::GroupedOrder S; S.init(P_TILE_E, ntm, 4, F.G, (int)blockIdx.x); \
        pg8::EpiDown E{P_Y2, F.in(I_b_down), 1.0f / (SC_ACT * SC_W)}; \
        pg8::gemm_phase<pg8::EpiDown, pg8::GroupedOrder, true, true, true>(F.lds + RING_OFF, g, S, E); } while (0)
    if (IN(0)) { p0_prologue(F); if (BOTH(0)) GRID_BAR(0); if (DUPK(0)) { p0_prologue(F); GRID_BAR(0); } }
    if (IN(1)) { p1_norm(F); if (BOTH(1)) GRID_BAR(1); if (DUPK(1)) { p1_norm(F); GRID_BAR(1); } }
    if (IN(2)) { RUN_P2(); if (BOTH(2)) GRID_BAR(2); if (DUPK(2)) { RUN_P2(); GRID_BAR(2); } }
    if (IN(3)) { rglru_single(F); attn_items(F); if (BOTH(3)) GRID_BAR(3);  if (DUPK(11)) { attn_items(F); GRID_BAR(3); }  }
    if (IN(4)) { attn_merge(F); if (BOTH(4)) GRID_BAR(4); if (DUPK(4)) { attn_merge(F); GRID_BAR(4); } }
    if (IN(5)) { RUN_P5(); if (BOTH(5)) GRID_BAR(5); if (DUPK(5)) { RUN_P5(); GRID_BAR(5); } }
    if (IN(6)) { p6_rows(F); if (BOTH(6)) GRID_BAR(6); if (DUPK(6)) { p6_rows(F); GRID_BAR(6); } if (DUPK(14)) { p6_rows(F, 1); GRID_BAR(6); } if (DUPK(15)) { p6_rows(F, 2); GRID_BAR(6); } }
    if (IN(7)) { p7_gather(F); if (BOTH(7)) GRID_BAR(7); if (DUPK(7)) { p7_gather(F); GRID_BAR(7); } }
    if (IN(8)) { RUN_P8(); if (BOTH(8)) GRID_BAR(8); if (DUPK(8)) { RUN_P8(); GRID_BAR(8); } }
    if (IN(9)) { RUN_P9(); if (BOTH(9)) GRID_BAR(9); if (DUPK(9)) { RUN_P9(); GRID_BAR(9); } }
    if (IN(10)) { p10_final(F); if (DUPK(10)) { GRID_BAR(10); p10_final(F); } }
#undef IN
#undef BOTH
}

extern "C" void kernel_launch(void* const* d_in, const int* in_sizes, int n_in, void* d_out, int out_size, void* d_ws, size_t ws_size, hipStream_t stream) {
    static int grid = 0;
    if (grid == 0) {
        if (n_in != 22 || in_sizes[0] != TT * DM || out_size != TT * DM || ws_size < WS_END) { fprintf(stderr, "kernel_launch: unexpected shapes (n_in %d, in0 %d, out %d, ws %zu); nothing launched\n", n_in, n_in > 0 ? in_sizes[0] : -1, out_size, ws_size); grid = -1; return; }
        int dev = 0, cus = 0, per_cu = 0;
        if (hipGetDevice(&dev) != hipSuccess || hipDeviceGetAttribute(&cus, hipDeviceAttributeMultiprocessorCount, dev) != hipSuccess) { fprintf(stderr, "kernel_launch: device query failed\n"); grid = -1; return; }
        if (hipFuncSetAttribute((const void*)hymba_fwd, hipFuncAttributeMaxDynamicSharedMemorySize, LDS_BYTES) != hipSuccess) { fprintf(stderr, "kernel_launch: hipFuncSetAttribute failed\n"); grid = -1; return; }
        if (hipOccupancyMaxActiveBlocksPerMultiprocessor(&per_cu, (const void*)hymba_fwd, NWAVES * 64, LDS_BYTES) != hipSuccess || per_cu < 1) { fprintf(stderr, "kernel_launch: occupancy query reports %d workgroups per CU\n", per_cu); per_cu = 1; }
        (void)hipGetLastError();
        if (cus < 256) { fprintf(stderr, "kernel_launch: built for a 256-CU device (one workgroup per CU), found %d CUs; nothing launched\n", cus); grid = -1; return; }
        grid = 256;
    }
    if (grid < 0) return;
    if (hipMemsetAsync((char*)d_ws + WS_CTL, 0, CTL_ZERO_BYTES, stream) != hipSuccess) { fprintf(stderr, "kernel_launch: memset failed\n"); return; }
    Args a{};
    for (int i = 0; i < 22; ++i) a.in[i] = (const float*)d_in[i];
    a.out = (float*)d_out; a.ws = (unsigned char*)d_ws; a.pad = DUP_MASK;
    for (int li = 0; li < N_LAUNCHES; ++li) {
        a.ph_lo = (N_LAUNCHES == PER_PHASE) ? li : 0; a.ph_hi = (N_LAUNCHES == PER_PHASE) ? li + 1 : PER_PHASE; a.li = li;
        hipLaunchKernelGGL(hymba_fwd, dim3(grid), dim3(NWAVES * 64), LDS_BYTES, stream, a);
        const hipError_t le = hipPeekAtLastError();
        if (le != hipSuccess) { fprintf(stderr, "kernel_launch: launch %d failed: %s\n", li, hipGetErrorName(le)); break; }
    }
}
```

```cpp
#include <hip/hip_runtime.h>
#include <cstdio>
#include <cstdint>
#define MK_N_LAUNCHES 1
#define DUP_MASK 0
namespace pg8 {
#define PG8_LAS __attribute__((address_space(3)))
typedef unsigned short bf16_t;
typedef short bf16x8 __attribute__((ext_vector_type(8)));
typedef float f32x4 __attribute__((ext_vector_type(4)));
typedef unsigned u32x4 __attribute__((ext_vector_type(4)));
constexpr int BM = 256, BK = 64, HALF = 128, HTB = HALF * BK * 2  , STAGE_BYTES = 8 * HTB, NXCD = 8, WGM = 8;

__host__ __device__ __forceinline__ int lds_byte(int r, int c) { const int st = (r >> 4) * 2 + (c >> 5), rr = r & 15, cc = c & 31, ob = rr * 64 + cc * 2; return st * 1024 + (ob ^ (((ob >> 9) & 1) << 5)); }
__host__ __device__ __forceinline__ void stage_rc(int b, int& R, int& C) { const int st = b / 1024, sb = b % 1024, swz = sb ^ (((sb >> 9) & 1) << 5); R = (st >> 1) * 16 + swz / 64; C = (st & 1) * 32 + (swz % 64) / 2; }
__host__ __device__ __forceinline__ int perm32(int rho) { const int n = rho >> 4, i = rho & 15; return 8 * (i >> 2) + 4 * n + (i & 3); }

struct Unit { int pm, pn; };
struct Gemm { const bf16_t* A; const bf16_t* Bt; int M, N, K; };

struct StaticOrder {
    int nM, nN, nwg, G, c;
    __host__ __device__ void init(int M, int N, int G_, int c_) { nM = M / BM; nN = N / BM; nwg = nM * nN; G = G_; c = c_; }
    __host__ __device__ bool next(int i, Unit& u) const {
        const long L = (long)i * G + c; if (L >= nwg) return false;
        int wgid = (int)L; { const int q = nwg / NXCD, r = nwg % NXCD, xcd = wgid % NXCD, off = wgid / NXCD; wgid = (xcd < r ? xcd * (q + 1) : r * (q + 1) + (xcd - r) * q) + off; }
        const int nig = WGM * nN, gid = wgid / nig, fm = gid * WGM, gsz = (nM - fm) < WGM ? (nM - fm) : WGM;
        u.pm = fm + ((wgid % nig) % gsz); u.pn = (wgid % nig) / gsz; return true;
    }
    __device__ __forceinline__ void a_ready(const Unit&) const {}
    __device__ __forceinline__ void done(const Unit&) const {}
};

typedef float cvtf32x2_t __attribute__((ext_vector_type(2))); typedef __bf16 cvtbf16x2_t __attribute__((ext_vector_type(2)));
__device__ __forceinline__ unsigned cvt_pk_bf16(float lo, float hi) { const cvtf32x2_t v = {lo, hi}; return __builtin_bit_cast(unsigned, __builtin_convertvector(v, cvtbf16x2_t)); }
typedef float f32x2 __attribute__((ext_vector_type(2)));
__device__ __forceinline__ f32x2 gelu_pk(f32x2 v) {
    const f32x2 av = __builtin_elementwise_abs(v), d = av * 0.2316418882f + 1.0f;
    f32x2 t; t.x = __builtin_amdgcn_rcpf(d.x); t.y = __builtin_amdgcn_rcpf(d.y);
    f32x2 q = t * 0.5307027145f + (-0.7265760135f); q = q * t + 0.7107068705f; q = q * t + (-0.142248368f); q = q * t + 0.127414796f; q = q * t;
    const f32x2 s = (v * v) * (-0.72134752044f);
    f32x2 e; e.x = __builtin_amdgcn_exp2f(s.x); e.y = __builtin_amdgcn_exp2f(s.y);
    const f32x2 m = v * (q * e), r = v - m;
    f32x2 o; o.x = v.x < 0.f ? m.x : r.x; o.y = v.y < 0.f ? m.y : r.y; return o;
}

template <int ACT  > struct EpiBf16 {
    static constexpr bool PERM = true, AFTER_DRAIN = false; static_assert(ACT == 0 || ACT == 1, "EpiBf16: ACT is 0 (none) or 1 (gelu_pk)");
    bf16_t* O; int ldc; const float* bias; int split_cols; size_t split_stride; float scale0;
    __device__ __forceinline__ void operator()(const f32x4 (&acc)[2][2][4][2], const Unit& u, int wr, int wc, int fr, int fq) const {
        const int row0 = u.pm * BM + wr * 64 + fr; int colt = u.pn * BM; bf16_t* base = O;
        float sc = 1.f; if (split_cols) { const int t = colt / split_cols; base += (size_t)t * split_stride; colt -= t * split_cols; if (t == 0) sc = scale0; }
        const int col0 = colt + wc * 32 + 8 * fq, bcol0 = u.pn * BM + wc * 32 + 8 * fq;
        f32x4 bv[2][2];
#pragma unroll
        for (int bj = 0; bj < 2; ++bj)
#pragma unroll
            for (int n = 0; n < 2; ++n) bv[bj][n] = bias ? *(const f32x4*)(bias + bcol0 + bj * HALF + 4 * n) : (f32x4){0.f, 0.f, 0.f, 0.f};
#pragma unroll
        for (int ai = 0; ai < 2; ++ai)
#pragma unroll
            for (int m = 0; m < 4; ++m) { bf16_t* rowp = base + (size_t)(row0 + ai * HALF + m * 16) * ldc + col0;
#pragma unroll
                for (int bj = 0; bj < 2; ++bj) { f32x4 v0 = acc[ai][bj][m][0] + bv[bj][0], v1 = acc[ai][bj][m][1] + bv[bj][1];
                    if (ACT == 1) { f32x2 a = gelu_pk((f32x2){v0[0], v0[1]}), b = gelu_pk((f32x2){v0[2], v0[3]}), c = gelu_pk((f32x2){v1[0], v1[1]}), d = gelu_pk((f32x2){v1[2], v1[3]});
                        v0 = (f32x4){a.x, a.y, b.x, b.y}; v1 = (f32x4){c.x, c.y, d.x, d.y}; }
                    v0 = v0 * sc; v1 = v1 * sc; u32x4 w; w.x = cvt_pk_bf16(v0[0], v0[1]); w.y = cvt_pk_bf16(v0[2], v0[3]); w.z = cvt_pk_bf16(v1[0], v1[1]); w.w = cvt_pk_bf16(v1[2], v1[3]);
                    *(u32x4*)(rowp + bj * HALF) = w; } }
    }
};
template <class Epi, class Sched, bool ALIGN_EPI = false, bool SP2 = false, bool FP8 = false, bool GATHER = false>
__device__ __forceinline__ void gemm_phase(PG8_LAS unsigned char* lds, const Gemm g, const Sched& S, const Epi& E, const PG8_LAS int* rowtab = nullptr) {
    int tid_ = threadIdx.x; asm volatile("" : "+v"(tid_));
    const int tid = tid_, wid = __builtin_amdgcn_readfirstlane(tid >> 6), lane = tid & 63, wr = wid >> 2, wc = wid & 3, fr = lane & 15, fq = lane >> 4;
    const int K = g.K, nt = K / BK;
    unsigned voffA, voffB;
    { int R, C; stage_rc(tid * 16, R, C); const int Rb = Epi::PERM ? ((R & ~31) + perm32(R & 31)) : R; voffA = (unsigned)(R * K + C) * 2u; voffB = (unsigned)(Rb * K + C) * 2u; }
    const unsigned qstep = 64u * K * 2;
    const unsigned kstep = (unsigned)(BK * 2);
    const unsigned hstep = (unsigned)HALF * K * 2;
    const unsigned tstep = 2 * hstep;
    const unsigned ldsw = (unsigned)wid * 1024u;
    const int aoff = lds_byte(wr * 64 + fr, fq * 8), boff = lds_byte(wc * 32 + fr, fq * 8);
#define PG8_SA(b, h) (((b) * 2 + (h)) * HTB)
#define PG8_SB(b, h) ((4 + (b) * 2 + (h)) * HTB)
#define PG8_STAGE(bufoff, goff, voff) do { _Pragma("unroll") for (int _i = 0; _i < 2; ++_i) \
        __builtin_amdgcn_raw_ptr_buffer_load_lds(srd_##voff, (PG8_LAS unsigned*)(lds + (bufoff) + ldsw + _i * 8192), 16, (int)(voff), (int)((goff) + _i * qstep), 0, 0); } while (0)
#define PG8_STAGE_A(bufoff, goff, VS) do { _Pragma("unroll") for (int _i = 0; _i < 2; ++_i) \
        __builtin_amdgcn_raw_ptr_buffer_load_lds(srd_voffA, (PG8_LAS unsigned*)(lds + (bufoff) + ldsw + _i * 8192), 16, GATHER ? (int)VS[((bufoff) / HTB) & 1][_i] : (int)voffA, GATHER ? (int)(goff) : (int)((goff) + _i * qstep), 0, 0); } while (0)
#define PG8_LDA(dst, b, h) do { if constexpr (FP8) { _Pragma("unroll") for (int m = 0; m < 4; ++m) { const v4i_t l_ = *(const PG8_LAS v4i_t*)(lds + PG8_SA(b, h) + aoff + m * 2048), h_ = *(const PG8_LAS v4i_t*)(lds + PG8_SA(b, h) + aoff + m * 2048 + 1024); dst##8[m] = __builtin_shufflevector(l_, h_, 0, 1, 2, 3, 4, 5, 6, 7); } } else { _Pragma("unroll") for (int m = 0; m < 4; ++m) _Pragma("unroll") for (int k = 0; k < 2; ++k) dst[m][k] = *(const PG8_LAS bf16x8*)(lds + PG8_SA(b, h) + aoff + m * 2048 + k * 1024); } } while (0)
#define PG8_LDB(dst, b, h) do { if constexpr (FP8) { _Pragma("unroll") for (int n = 0; n < 2; ++n) { const v4i_t l_ = *(const PG8_LAS v4i_t*)(lds + PG8_SB(b, h) + boff + n * 2048), h_ = *(const PG8_LAS v4i_t*)(lds + PG8_SB(b, h) + boff + n * 2048 + 1024); dst##8[n] = __builtin_shufflevector(l_, h_, 0, 1, 2, 3, 4, 5, 6, 7); } } else { _Pragma("unroll") for (int n = 0; n < 2; ++n) _Pragma("unroll") for (int k = 0; k < 2; ++k) dst[n][k] = *(const PG8_LAS bf16x8*)(lds + PG8_SB(b, h) + boff + n * 2048 + k * 1024); } } while (0)
#define PG8_MMA(ai, bj, At, Bt) do { __builtin_amdgcn_s_setprio(1); if constexpr (FP8) { _Pragma("unroll") for (int m = 0; m < 4; ++m) _Pragma("unroll") for (int n = 0; n < 2; ++n) \
        asm volatile("v_mfma_f32_16x16x128_f8f6f4 %0, %1, %2, %0" : "+v"(acc[ai][bj][m][n]) : "v"(Bt##8[n]), "v"(At##8[m])); } else { \
        _Pragma("unroll") for (int m = 0; m < 4; ++m) _Pragma("unroll") for (int n = 0; n < 2; ++n) _Pragma("unroll") for (int k = 0; k < 2; ++k) \
        acc[ai][bj][m][n] = __builtin_amdgcn_mfma_f32_16x16x32_bf16(Bt[n][k], At[m][k], acc[ai][bj][m][n], 0, 0, 0); } __builtin_amdgcn_s_setprio(0); } while (0)
#define PG8_WAIT_V(n) asm volatile("s_waitcnt vmcnt(" #n ")" ::: "memory")
#define PG8_WAIT_L(n) asm volatile("s_waitcnt lgkmcnt(" #n ")" ::: "memory")
#define PG8_BAR __builtin_amdgcn_s_barrier()
#define PG8_SCHED __builtin_amdgcn_sched_barrier(0)
    Unit cur, nxt; int ui = 0;
    if (!S.next(0, cur)) return;
    f32x4 acc[2][2][4][2];
#pragma unroll
    for (int a = 0; a < 2; ++a)
#pragma unroll
        for (int b = 0; b < 2; ++b)
#pragma unroll
            for (int m = 0; m < 4; ++m)
#pragma unroll
                for (int n = 0; n < 2; ++n) acc[a][b][m][n] = (f32x4){0.f, 0.f, 0.f, 0.f};
    typedef int v8i_t __attribute__((ext_vector_type(8))); typedef int v4i_t __attribute__((ext_vector_type(4)));
    bf16x8 At[4][2], B0[2][2], B1[2][2]; v8i_t At8[4], B08[2], B18[2];
    const __amdgpu_buffer_rsrc_t srd_voffA = __builtin_amdgcn_make_buffer_rsrc((void*)g.A, 0, 0x7ffffff0, 0x00020000), srd_voffB = __builtin_amdgcn_make_buffer_rsrc((void*)g.Bt, 0, 0x7ffffff0, 0x00020000);
    unsigned cA = GATHER ? 0u : (unsigned)cur.pm * tstep, cB = (unsigned)cur.pn * tstep;
    const unsigned hstepA = GATHER ? 0u : hstep;
    unsigned ca_[2][2] = {{0u, 0u}, {0u, 0u}}, na_[2][2] = {{0u, 0u}, {0u, 0u}}, va2_[2][2] = {{0u, 0u}, {0u, 0u}};
    int gR_ = 0, gC2_ = 0;
    if constexpr (GATHER) { int R, C; stage_rc(tid * 16, R, C); gR_ = R; gC2_ = C * 2;
#pragma unroll
        for (int h = 0; h < 2; ++h)
#pragma unroll
            for (int i = 0; i < 2; ++i) ca_[h][i] = (unsigned)rowtab[128 * h + 64 * i + R] + (unsigned)gC2_; }
    S.a_ready(cur);
    if constexpr (SP2) {
        PG8_STAGE(PG8_SB(0, 0), cB, voffB); PG8_STAGE(PG8_SB(0, 1), cB + hstep, voffB); PG8_STAGE_A(PG8_SA(0, 0), cA, ca_); PG8_STAGE_A(PG8_SA(0, 1), cA + hstepA, ca_);
        if (wr == 1) PG8_BAR;
        PG8_WAIT_V(2); PG8_BAR;
        PG8_STAGE(PG8_SB(1, 0), cB + kstep, voffB); PG8_STAGE_A(PG8_SA(1, 0), cA + kstep, ca_); PG8_STAGE(PG8_SB(1, 1), cB + hstep + kstep, voffB);
        PG8_WAIT_V(6); PG8_BAR;
    } else {
        PG8_STAGE(PG8_SB(0, 0), cB, voffB); PG8_STAGE_A(PG8_SA(0, 0), cA, ca_); PG8_STAGE(PG8_SB(0, 1), cB + hstep, voffB); PG8_STAGE_A(PG8_SA(0, 1), cA + hstepA, ca_);
        if (wr == 1) PG8_BAR;
        PG8_WAIT_V(4); PG8_BAR;
        PG8_STAGE(PG8_SB(1, 0), cB + kstep, voffB); PG8_STAGE_A(PG8_SA(1, 0), cA + kstep, ca_); PG8_STAGE(PG8_SB(1, 1), cB + hstep + kstep, voffB);
        PG8_WAIT_V(6); PG8_BAR;
    }
    for (;;) {
        const bool has_next = S.next(ui + 1, nxt);
        const unsigned nA = GATHER ? 0u : (has_next ? (unsigned)nxt.pm * tstep : cA); const unsigned nB = has_next ? (unsigned)nxt.pn * tstep : cB;
        if constexpr (GATHER) {
#pragma unroll
            for (int h = 0; h < 2; ++h)
#pragma unroll
                for (int i = 0; i < 2; ++i) na_[h][i] = has_next ? (unsigned)rowtab[(ui + 1) * 256 + 128 * h + 64 * i + gR_] + (unsigned)gC2_ : ca_[h][i]; }
#pragma nounroll
        for (int t = 0; t < nt; t += 2) {
            const bool last = (t == nt - 2);
            const unsigned a1 = cA + (unsigned)(t + 1) * kstep;
            const unsigned a2 = last ? nA : cA + (unsigned)(t + 2) * kstep; const unsigned b2 = last ? nB : cB + (unsigned)(t + 2) * kstep;
            const unsigned a3 = a2 + kstep; const unsigned b3 = b2 + kstep;
            if constexpr (GATHER) {
#pragma unroll
                for (int h = 0; h < 2; ++h)
#pragma unroll
                    for (int i = 0; i < 2; ++i) va2_[h][i] = last ? na_[h][i] : ca_[h][i]; }
            if (last && has_next) S.a_ready(nxt);
            if constexpr (SP2) {
            PG8_LDB(B0, 0, 0); PG8_LDB(B1, 0, 1); PG8_SCHED; PG8_LDA(At, 0, 0); PG8_STAGE_A(PG8_SA(1, 1), a1 + hstepA, ca_);
            PG8_WAIT_V(8); PG8_WAIT_L(0); PG8_BAR; PG8_MMA(0, 0, At, B0); PG8_MMA(0, 1, At, B1); PG8_BAR; PG8_SCHED;
            PG8_LDA(At, 0, 1); PG8_STAGE(PG8_SB(0, 0), b2, voffB); PG8_STAGE(PG8_SB(0, 1), b2 + hstep, voffB); PG8_STAGE_A(PG8_SA(0, 0), a2, va2_);
            PG8_WAIT_V(8); PG8_WAIT_L(0); PG8_BAR; PG8_MMA(1, 0, At, B0); PG8_MMA(1, 1, At, B1); PG8_BAR; PG8_SCHED;
            PG8_LDB(B0, 1, 0); PG8_LDB(B1, 1, 1); PG8_SCHED; PG8_LDA(At, 1, 0); PG8_STAGE_A(PG8_SA(0, 1), a2 + hstepA, va2_);
            PG8_WAIT_V(8); PG8_WAIT_L(0); PG8_BAR; PG8_MMA(0, 0, At, B0); PG8_MMA(0, 1, At, B1); PG8_BAR; PG8_SCHED;
            PG8_LDA(At, 1, 1); PG8_STAGE(PG8_SB(1, 0), b3, voffB); PG8_STAGE(PG8_SB(1, 1), b3 + hstep, voffB); PG8_STAGE_A(PG8_SA(1, 0), a3, va2_);
            PG8_WAIT_V(8); PG8_WAIT_L(0); PG8_BAR; PG8_MMA(1, 0, At, B0); PG8_MMA(1, 1, At, B1); PG8_BAR; PG8_SCHED;
            } else {
            PG8_LDB(B0, 0, 0); PG8_SCHED; PG8_LDA(At, 0, 0); PG8_STAGE_A(PG8_SA(1, 1), a1 + hstepA, ca_);
            PG8_WAIT_L(8); PG8_BAR; PG8_WAIT_L(0); PG8_MMA(0, 0, At, B0); PG8_BAR; PG8_SCHED;
            PG8_LDB(B1, 0, 1); PG8_STAGE(PG8_SB(0, 0), b2, voffB);
            PG8_BAR; PG8_WAIT_L(0); PG8_MMA(0, 1, At, B1); PG8_BAR;
            PG8_LDA(At, 0, 1); PG8_STAGE_A(PG8_SA(0, 0), a2, va2_);
            PG8_BAR; PG8_WAIT_L(0); PG8_MMA(1, 0, At, B0); PG8_BAR; PG8_SCHED;
            PG8_STAGE(PG8_SB(0, 1), b2 + hstep, voffB);
            PG8_WAIT_V(6); PG8_BAR; PG8_MMA(1, 1, At, B1); PG8_BAR;
            PG8_LDB(B0, 1, 0); PG8_SCHED; PG8_LDA(At, 1, 0); PG8_STAGE_A(PG8_SA(0, 1), a2 + hstepA, va2_);
            PG8_WAIT_L(8); PG8_BAR; PG8_WAIT_L(0); PG8_MMA(0, 0, At, B0); PG8_BAR; PG8_SCHED;
            PG8_LDB(B1, 1, 1); PG8_STAGE(PG8_SB(1, 0), b3, voffB);
            PG8_BAR; PG8_WAIT_L(0); PG8_MMA(0, 1, At, B1); PG8_BAR;
            PG8_LDA(At, 1, 1); PG8_STAGE_A(PG8_SA(1, 0), a3, va2_);
            PG8_BAR; PG8_WAIT_L(0); PG8_MMA(1, 0, At, B0); PG8_BAR; PG8_SCHED;
            PG8_STAGE(PG8_SB(1, 1), b3 + hstep, voffB);
            PG8_WAIT_V(6); PG8_BAR; PG8_MMA(1, 1, At, B1); PG8_BAR;
            }
        }
        if constexpr (ALIGN_EPI) { if (wr == 0) PG8_BAR; }
        if constexpr (FP8) asm volatile("s_nop 15\n\ts_nop 15" ::: "memory");
        if constexpr (!Epi::AFTER_DRAIN) { E(acc, cur, wr, wc, fr, fq); S.done(cur); }
        if (!has_next) break;
#pragma unroll
        for (int a = 0; a < 2; ++a)
#pragma unroll
            for (int b = 0; b < 2; ++b)
#pragma unroll
                for (int m = 0; m < 4; ++m)
#pragma unroll
                    for (int n = 0; n < 2; ++n) acc[a][b][m][n] = (f32x4){0.f, 0.f, 0.f, 0.f};
        cur = nxt; cA = nA; cB = nB; ++ui;
        if constexpr (GATHER) {
#pragma unroll
            for (int h = 0; h < 2; ++h)
#pragma unroll
                for (int i = 0; i < 2; ++i) ca_[h][i] = na_[h][i]; }
        if constexpr (ALIGN_EPI) { if (wr == 1) PG8_BAR; }
    }
    PG8_WAIT_V(0);
    if constexpr (!ALIGN_EPI) { if (wr == 0) PG8_BAR; }
    PG8_BAR;
    if constexpr (Epi::AFTER_DRAIN) { E.fused(acc, cur, wr, wc, fr, fq, lds, wid, lane); S.done(cur); }
#undef PG8_SA
#undef PG8_SB
#undef PG8_STAGE
#undef PG8_LDA
#undef PG8_LDB
#undef PG8_MMA
#undef PG8_WAIT_V
#undef PG8_WAIT_L
#undef PG8_BAR
#undef PG8_SCHED
}
}

namespace pg8 {
struct EpiResGate {
    static constexpr bool PERM = false, AFTER_DRAIN = false;
    const float* base; unsigned short* out; int ldc; const float* gate; int gate_bstride; int rows_per_batch;
    __device__ __forceinline__ void operator()(const f32x4 (&acc)[2][2][4][2], const Unit& u, int wr, int wc, int fr, int fq) const {
        const int b = (u.pm * BM) / rows_per_batch;
        const int col0 = u.pn * BM + wc * 32 + 4 * fq;
        f32x4 gv[2][2];
#pragma unroll
        for (int bj = 0; bj < 2; ++bj)
#pragma unroll
            for (int n = 0; n < 2; ++n) gv[bj][n] = *(const f32x4*)(gate + (size_t)b * gate_bstride + col0 + bj * HALF + n * 16);
#pragma unroll
        for (int ai = 0; ai < 2; ++ai)
#pragma unroll
            for (int mp = 0; mp < 2; ++mp) {
                f32x4 bs[2][2][2];
#pragma unroll
                for (int mm = 0; mm < 2; ++mm) { const int m = 2 * mp + mm; const size_t off = (size_t)(u.pm * BM + ai * HALF + wr * 64 + m * 16 + fr) * ldc + col0;
#pragma unroll
                    for (int bj = 0; bj < 2; ++bj)
#pragma unroll
                        for (int n = 0; n < 2; ++n) bs[mm][bj][n] = *(const f32x4*)(base + off + bj * HALF + n * 16); }
                asm volatile("s_waitcnt vmcnt(0)" ::: "memory");
#pragma unroll
                for (int mm = 0; mm < 2; ++mm) { const int m = 2 * mp + mm; const size_t off = (size_t)(u.pm * BM + ai * HALF + wr * 64 + m * 16 + fr) * ldc + col0;
#pragma unroll
                    for (int bj = 0; bj < 2; ++bj)
#pragma unroll
                        for (int n = 0; n < 2; ++n) { const f32x4 r = bs[mm][bj][n] + gv[bj][n] * acc[ai][bj][m][n]; typedef unsigned u32x2_ __attribute__((ext_vector_type(2)));
                            u32x2_ w; w.x = cvt_pk_bf16(r[0], r[1]); w.y = cvt_pk_bf16(r[2], r[3]); *(u32x2_*)(out + off + bj * HALF + n * 16) = w; } }
                asm volatile("" ::: "memory");
            }
    }
};
__device__ __forceinline__ unsigned pk4_fp8(float a, float b, float c, float d) {
    a = __builtin_fminf(__builtin_fmaxf(a, -448.f), 448.f); b = __builtin_fminf(__builtin_fmaxf(b, -448.f), 448.f); c = __builtin_fminf(__builtin_fmaxf(c, -448.f), 448.f); d = __builtin_fminf(__builtin_fmaxf(d, -448.f), 448.f);
    int w = 0; w = __builtin_amdgcn_cvt_pk_fp8_f32(a, b, w, false); w = __builtin_amdgcn_cvt_pk_fp8_f32(c, d, w, true); return (unsigned)w; }
__device__ __forceinline__ unsigned pk4_fp8_nc(float a, float b, float c, float d) {
    int w = 0; w = __builtin_amdgcn_cvt_pk_fp8_f32(a, b, w, false); w = __builtin_amdgcn_cvt_pk_fp8_f32(c, d, w, true); return (unsigned)w; }
struct EpiSwiglu {
    static constexpr bool PERM = true, AFTER_DRAIN = false;
    unsigned char* O; const float* bgu; float asc, osc;
    __device__ __forceinline__ float act1(float g, float u) const {
        g = __builtin_fminf(g, 7.0f); u = __builtin_fminf(__builtin_fmaxf(u, -7.0f), 7.0f);
        const float s = __builtin_amdgcn_rcpf(1.0f + __builtin_amdgcn_exp2f(g * (-1.702f * 1.4426950408889634f)));
        return (u + 1.0f) * (g * s) * osc;
    }
    __device__ __forceinline__ void operator()(const f32x4 (&acc)[2][2][4][2], const Unit& u, int wr, int wc, int fr, int fq) const {
        const int e = u.pn >> 3, pnl = u.pn & 7;
        const int row0 = u.pm * BM + wr * 64 + fr;
        const int ocol0 = pnl * 128 + wc * 32 + 8 * fq;
        f32x4 bg[2], bu[2];
#pragma unroll
        for (int n = 0; n < 2; ++n) { bg[n] = *(const f32x4*)(bgu + (size_t)e * 2048 + ocol0 + 4 * n); bu[n] = *(const f32x4*)(bgu + (size_t)e * 2048 + 1024 + ocol0 + 4 * n); }
#pragma unroll
        for (int ai = 0; ai < 2; ++ai)
#pragma unroll
            for (int m = 0; m < 4; ++m) { unsigned char* rowp = O + (size_t)(row0 + ai * HALF + m * 16) * 1024 + ocol0;
                const f32x4 g0 = acc[ai][0][m][0] * asc + bg[0], g1 = acc[ai][0][m][1] * asc + bg[1], u0 = acc[ai][1][m][0] * asc + bu[0], u1 = acc[ai][1][m][1] * asc + bu[1];
                typedef unsigned u32x2 __attribute__((ext_vector_type(2)));
                u32x2 w; w.x = pk4_fp8_nc(act1(g0[0], u0[0]), act1(g0[1], u0[1]), act1(g0[2], u0[2]), act1(g0[3], u0[3]));
                w.y = pk4_fp8_nc(act1(g1[0], u1[0]), act1(g1[1], u1[1]), act1(g1[2], u1[2]), act1(g1[3], u1[3]));
                *(u32x2*)rowp = w; asm volatile("" ::: "memory"); }
    }
};
struct EpiDown {
    static constexpr bool PERM = true, AFTER_DRAIN = false;
    bf16_t* O; const float* bias; float asc;
    __device__ __forceinline__ void operator()(const f32x4 (&acc)[2][2][4][2], const Unit& u, int wr, int wc, int fr, int fq) const {
        const int row0 = u.pm * BM + wr * 64 + fr; const int pnl = u.pn & 3;
        const int col0 = pnl * BM + wc * 32 + 8 * fq, bcol0 = u.pn * BM + wc * 32 + 8 * fq;
        f32x4 bv[2][2];
#pragma unroll
        for (int bj = 0; bj < 2; ++bj)
#pragma unroll
            for (int n = 0; n < 2; ++n) bv[bj][n] = *(const f32x4*)(bias + bcol0 + bj * HALF + 4 * n);
#pragma unroll
        for (int ai = 0; ai < 2; ++ai)
#pragma unroll
            for (int m = 0; m < 4; ++m) { bf16_t* rowp = O + (size_t)(row0 + ai * HALF + m * 16) * 1024 + col0;
#pragma unroll
                for (int bj = 0; bj < 2; ++bj) { const f32x4 v0 = acc[ai][bj][m][0] * asc + bv[bj][0], v1 = acc[ai][bj][m][1] * asc + bv[bj][1];
                    u32x4 w; w.x = cvt_pk_bf16(v0[0], v0[1]); w.y = cvt_pk_bf16(v0[2], v0[3]); w.z = cvt_pk_bf16(v1[0], v1[1]); w.w = cvt_pk_bf16(v1[2], v1[3]);
                    *(u32x4*)(rowp + bj * HALF) = w; } }
    }
};
#ifndef GROUPED_WGM
#define GROUPED_WGM 16
#endif
struct GroupedOrder {
    const int* tile_e; int nM, nNl, nwg, G, c;
    __device__ void init(const int* te, int ntm, int nNl_, int G_, int c_) { tile_e = te; nM = ntm; nNl = nNl_; nwg = ntm * nNl_; G = G_; c = c_; }
    __device__ bool next(int i, Unit& u) const {
        const long L = (long)i * G + c; if (L >= nwg) return false;
        int wgid = (int)L; { const int q = nwg / NXCD, r = nwg % NXCD, xcd = wgid % NXCD, off = wgid / NXCD; wgid = (xcd < r ? xcd * (q + 1) : r * (q + 1) + (xcd - r) * q) + off; }
        constexpr int WG = GROUPED_WGM; const int nig = WG * nNl, gid = wgid / nig, fm = gid * WG, gsz = (nM - fm) < WG ? (nM - fm) : WG;
        u.pm = fm + ((wgid % nig) % gsz); const int pl = (wgid % nig) / gsz;
        u.pn = __builtin_amdgcn_readfirstlane(tile_e[u.pm]) * nNl + pl; return true;
    }
    __device__ __forceinline__ void a_ready(const Unit&) const {}
    __device__ __forceinline__ void done(const Unit&) const {}
};
}

constexpr int NWAVES = 8;
constexpr int NB = 4, SEQ = 4096, DM = 1024, TT = NB * SEQ, DH = 512, NHEAD = 8, HD = 64, NEXP = 32, TOPK = 4, INCOLS = 2560, NMOD = 6 * DM, DE2 = 2048;
constexpr float NORM_EPS = 1e-6f;
constexpr float C2 = 0.125f * 1.4426950408889634f;
constexpr float SC_H = 16.0f, SC_W = 512.0f, SC_ACT = 4.0f;
constexpr int MAXSLOT = TT * TOPK + NEXP * 256, MAXTILE = MAXSLOT / 256;
#ifndef MK_N_LAUNCHES
#define MK_N_LAUNCHES 1
#endif
constexpr int PER_PHASE = 11;
constexpr int N_LAUNCHES = MK_N_LAUNCHES;

constexpr size_t MiB = 1u << 20;
constexpr size_t WS_CTL = 0, CTL_ZERO_BYTES = 1 * MiB;
constexpr size_t WS_MISC = 1 * MiB;
constexpr size_t WS_WRT = 2 * MiB;
constexpr size_t WS_WIN = 3 * MiB, WS_WOUT = 8 * MiB, WS_WGU = 16 * MiB, WS_WD = 144 * MiB;
constexpr size_t WS_XN = 208 * MiB, WS_QKV = 240 * MiB, WS_OP = 320 * MiB, WS_LSE = 368 * MiB, WS_MIX = 370 * MiB, WS_X1 = 402 * MiB;
constexpr size_t WS_ROUTE = 466 * MiB;
constexpr size_t WS_XG = 468 * MiB, WS_ACT = 612 * MiB, WS_MODP = 756 * MiB, WS_END = 758 * MiB;
constexpr int CW_TMO = 0, CW_CODE = 1, CW_BAR = 4096, CW_CNT = 8192, CW_RFLAG = 12288, CW_MOD = 16384, CW_RX = 65536;
static_assert((size_t)CW_RX * 4 + (size_t)NB * 8 * 16 * 64 * 8 <= CTL_ZERO_BYTES, "ctl rx");
static_assert((CW_MOD + NB * NMOD) * 4 <= (int)CTL_ZERO_BYTES, "ctl");
constexpr int RING_OFF = 0, RING_BYTES = 131072, LDSCTL_OFF = RING_BYTES, MISC_OFF = LDSCTL_OFF + 320, SUMM_OFF = RING_BYTES + 1024, TILE_OFF = SUMM_OFF + 4096, ROWTAB_OFF = TILE_OFF + 1024, ROWTAB_UNITS = 9, LDS_BYTES = 147456;
static_assert(ROWTAB_OFF + ROWTAB_UNITS * 1024 <= LDS_BYTES && (MAXTILE * 8 + 255) / 256 <= ROWTAB_UNITS, "lds");
#define GAS __attribute__((address_space(1)))
#define LAS __attribute__((address_space(3)))
typedef unsigned short bf16;
typedef unsigned v4u __attribute__((ext_vector_type(4)));
typedef float f32x4 __attribute__((ext_vector_type(4)));
typedef short bf16x8 __attribute__((ext_vector_type(8)));
typedef GAS unsigned gu32;
typedef GAS unsigned long long gu64;
#define RLX_AGENT __ATOMIC_RELAXED, __HIP_MEMORY_SCOPE_AGENT
#define LDS_WAIT() asm volatile("s_waitcnt lgkmcnt(0)" ::: "memory")
#define VM_WAIT() asm volatile("s_waitcnt vmcnt(0)" ::: "memory")
__device__ __forceinline__ unsigned long long rt() { return __builtin_amdgcn_s_memrealtime(); }
__device__ __forceinline__ unsigned f2bf(float f) { unsigned u = __builtin_bit_cast(unsigned, f); return (u + 0x7fffu + ((u >> 16) & 1u)) >> 16; }
__device__ __forceinline__ unsigned pk2(float lo, float hi) { return f2bf(lo) | (f2bf(hi) << 16); }

#define XB_TMO      128
#define XB_XCNT(j)  (256  + 64 * (j))
#define XB_XSUB(j)  (1280 + 64 * (j))
#define XB_XGEN(j)  (2304 + 64 * (j))
#define XB_TOP      3328
#define XB_TOPGEN   3392
#define XCD_BAR_WORDS 3456
#define XB_SPIN_CAP (1u << 18)

__device__ __forceinline__ unsigned xb_ld(unsigned* p)              { return __hip_atomic_load(p, __ATOMIC_RELAXED, __HIP_MEMORY_SCOPE_AGENT); }
__device__ __forceinline__ unsigned xb_add(unsigned* p, unsigned v) { return __hip_atomic_fetch_add(p, v, __ATOMIC_RELAXED, __HIP_MEMORY_SCOPE_AGENT); }
__device__ __forceinline__ unsigned xb_xcc_id() { return (unsigned)__builtin_amdgcn_s_getreg((3 << 11) | 20) & 0xFu; }
#define XB_SPIN(cond, bar) do { unsigned _sp = 0; while (cond) { __builtin_amdgcn_s_sleep(1); \
    if ((++_sp & 255u) == 0u) { if (xb_ld(&(bar)[XB_TMO])) break; if (_sp > XB_SPIN_CAP) { atomicAdd(&(bar)[XB_TMO], 1u); break; } } } } while (0)

struct XcdBarrier {
    unsigned* bar; unsigned x;
    volatile LAS unsigned* st;
};

__device__ __forceinline__ XcdBarrier xcd_barrier_post(unsigned* bar, volatile LAS unsigned* st) {
    XcdBarrier b; b.bar = bar; b.x = xb_xcc_id(); b.st = st;
    if (threadIdx.x == 0) (void)xb_add(&bar[XB_XCNT(b.x)], 1u);
    return b;
}
__device__ __forceinline__ void xcd_barrier_complete(unsigned* bar, unsigned x, unsigned& nloc, unsigned& nx) {
    const unsigned G = gridDim.x * gridDim.y * gridDim.z;
    unsigned sum, cnt, mine, sp = 0u;
    for (;;) {
        sum = 0u; cnt = 0u; mine = 0u;
#pragma unroll
        for (unsigned j = 0; j < 16; ++j) { const unsigned c = xb_ld(&bar[XB_XCNT(j)]); sum += c; cnt += (c > 0u) ? 1u : 0u; mine = (j == x) ? c : mine; }
        if (sum == G) break;
        __builtin_amdgcn_s_sleep(1);
        if ((++sp & 255u) == 0u) { if (xb_ld(&bar[XB_TMO])) break; if (sp > XB_SPIN_CAP) { atomicAdd(&bar[XB_TMO], 1u); break; } }
    }
    nloc = mine > 0u ? mine : 1u; nx = cnt > 0u ? cnt : 1u;
}

__device__ __forceinline__ void xcd_barrier(const XcdBarrier& b) {
    asm volatile("s_waitcnt vmcnt(0)" ::: "memory");
    __syncthreads();
    if (threadIdx.x == 0) {
        unsigned* bar = b.bar;
        __builtin_amdgcn_s_waitcnt(0);
        unsigned nloc = b.st[0], nx = b.st[1];
        if (nloc == 0u) { xcd_barrier_complete(bar, b.x, nloc, nx); b.st[0] = nloc; b.st[1] = nx; }
        const unsigned old = xb_add(&bar[XB_XSUB(b.x)], 1u);
        const unsigned gen = old / nloc;
        if (old + 1u == (gen + 1u) * nloc) {
            __builtin_amdgcn_fence(__ATOMIC_RELEASE, "agent");
            asm volatile("s_waitcnt vmcnt(0)" ::: "memory");
            const unsigned og = xb_add(&bar[XB_TOP], 1u);
            const unsigned tg = og / nx;
            if (og + 1u == (tg + 1u) * nx) xb_add(&bar[XB_TOPGEN], 1u);
            else XB_SPIN(xb_ld(&bar[XB_TOPGEN]) == tg, bar);
            __builtin_amdgcn_fence(__ATOMIC_ACQUIRE, "agent");
            xb_add(&bar[XB_XGEN(b.x)], 1u);
            asm volatile("s_waitcnt vmcnt(0)" ::: "memory");
        } else {
            XB_SPIN(xb_ld(&bar[XB_XGEN(b.x)]) == gen, bar);
            __builtin_amdgcn_fence(__ATOMIC_ACQUIRE, "agent");
            asm volatile("s_waitcnt vmcnt(0)" ::: "memory");
        }
    }
    __syncthreads();
}

typedef float f32x16 __attribute__((ext_vector_type(16)));
typedef short v4i16_t __attribute__((ext_vector_type(4)));
typedef unsigned v2u __attribute__((ext_vector_type(2)));
struct Frame {
    LAS unsigned char* lds;
    int tid, lane, wave, vcu, G;
    unsigned char* ws;
    const __attribute__((address_space(4))) void* ka;
    __device__ __forceinline__ const float* in(int k) const {
        const unsigned long long v = *(const volatile __attribute__((address_space(4))) unsigned long long*)((const __attribute__((address_space(4))) char*)ka + 8 * k);
        const unsigned lo = (unsigned)__builtin_amdgcn_readfirstlane((int)(unsigned)v), hi = (unsigned)__builtin_amdgcn_readfirstlane((int)(unsigned)(v >> 32));
        return (const float*)(const GAS float*)(((unsigned long long)hi << 32) | lo);
    }
};
enum InIdx { I_x = 0, I_c, I_w_ada, I_b_ada, I_g_mix, I_w_in, I_conv_w, I_conv_b, I_w_rg_a, I_b_rg_a, I_w_rg_x, I_b_rg_x, I_lam, I_w_out, I_g_ffn, I_w_router, I_b_router, I_w_gate_up, I_b_gate_up, I_w_down, I_b_down, I_g_final };
#define WSP(T, off) ((T*)(F.ws + (off)))
#define P_MOD   (WSP(float, WS_CTL) + CW_MOD)
#define P_BCNT  WSP(int, WS_MISC + 8192)
#define P_TILE_E WSP(int, WS_MISC)
#define P_TILE_N WSP(int, WS_MISC + 4096)
#define P_RSUM  WSP(float, WS_MISC + 65536)
#define P_WRT   WSP(float, WS_WRT)
#define P_WA_T  WSP(bf16, WS_WRT + 262144)
#define P_WX_T  WSP(bf16, WS_WRT + 393216)
#define P_WIN_T WSP(bf16, WS_WIN)
#define P_WOUT_T WSP(bf16, WS_WOUT)
#define P_WGU8 WSP(unsigned char, WS_WGU)
#define P_WD8  WSP(unsigned char, WS_WD)
#define P_XN    WSP(bf16, WS_XN)
#define P_QB    WSP(bf16, WS_QKV)
#define P_KB    (WSP(bf16, WS_QKV) + (size_t)TT * DH)
#define P_VB    (WSP(bf16, WS_QKV) + (size_t)2 * TT * DH)
#define P_XR    (WSP(bf16, WS_QKV) + (size_t)3 * TT * DH)
#define P_GR    (WSP(bf16, WS_QKV) + (size_t)4 * TT * DH)
#define P_OP    WSP(bf16, WS_OP)
#define P_LSE   WSP(float, WS_LSE)
#define P_MIX   WSP(bf16, WS_MIX)
#define P_X1    WSP(bf16, WS_X1)
#define P_TOK_E WSP(int, WS_ROUTE)
#define P_TOK_POS (WSP(int, WS_ROUTE) + TT * TOPK)
#define P_TOK_GATE (WSP(float, WS_ROUTE) + 2 * TT * TOPK)
#define P_TOK_SLOT (WSP(int, WS_ROUTE) + 3 * TT * TOPK)
#define P_SLOT_TOK (WSP(int, WS_ROUTE + 1048576))
#define P_Y2    WSP(bf16, WS_XG)
#define P_XN8   WSP(unsigned char, WS_XN)
#define P_ACT8  WSP(unsigned char, WS_ACT)
__device__ __forceinline__ float bf2f(unsigned short v) { return __uint_as_float(((unsigned)v) << 16); }
template <int N> __device__ __forceinline__ float dpp_ror(float v) { return __builtin_bit_cast(float, __builtin_amdgcn_update_dpp(0, __builtin_bit_cast(int, v), 0x120 + N, 0xf, 0xf, false)); }
__device__ __forceinline__ float row_sum16(float v) { v += dpp_ror<8>(v); v += dpp_ror<4>(v); v += dpp_ror<2>(v); v += dpp_ror<1>(v); return v; }
__device__ __forceinline__ float row_max16(float v) { v = fmaxf(v, dpp_ror<8>(v)); v = fmaxf(v, dpp_ror<4>(v)); v = fmaxf(v, dpp_ror<2>(v)); v = fmaxf(v, dpp_ror<1>(v)); return v; }
__device__ __forceinline__ float wave_sum(float v) {
    v = row_sum16(v);
    const float s0 = __builtin_bit_cast(float, __builtin_amdgcn_readlane(__builtin_bit_cast(int, v), 0)), s1 = __builtin_bit_cast(float, __builtin_amdgcn_readlane(__builtin_bit_cast(int, v), 16)),
                s2 = __builtin_bit_cast(float, __builtin_amdgcn_readlane(__builtin_bit_cast(int, v), 32)), s3 = __builtin_bit_cast(float, __builtin_amdgcn_readlane(__builtin_bit_cast(int, v), 48));
    return ((s0 + s1) + s2) + s3;
}
__device__ __forceinline__ float wave_max(float v) {
#pragma unroll
    for (int o = 1; o < 64; o <<= 1) v = fmaxf(v, __shfl_xor(v, o));
    return v;
}
__device__ __forceinline__ int crow(int r, int hi) { return (r & 3) + 8 * (r >> 2) + 4 * hi; }

__device__ __forceinline__ void p0_transpose_item(const float* W, int K, int N, bf16* WT, int k0, int n0, int drow0, LAS float* scr, int lane) {
#pragma unroll 8
    for (int i = 0; i < 32; ++i) { const int kk = 2 * i + (lane >> 5); scr[kk * 33 + (lane & 31)] = W[(size_t)(k0 + kk) * N + n0 + (lane & 31)]; }
    LDS_WAIT(); asm volatile("" ::: "memory");
    const int c = lane & 7;
#pragma unroll
    for (int j = 0; j < 4; ++j) { const int n = (lane >> 3) + 8 * j; const LAS float* s = scr + (8 * c) * 33 + n;
        v4u o; o.x = pk2(s[0 * 33], s[1 * 33]); o.y = pk2(s[2 * 33], s[3 * 33]); o.z = pk2(s[4 * 33], s[5 * 33]); o.w = pk2(s[6 * 33], s[7 * 33]);
        *(GAS v4u*)(WT + (size_t)(drow0 + n) * K + k0 + 8 * c) = o; }
    LDS_WAIT(); asm volatile("" ::: "memory");
}
__device__ __forceinline__ void p0_transpose_item8(const float* W, int K, int N, unsigned char* WT, int k0, int n0, int drow0, float sc, LAS float* scr, int lane) {
#pragma unroll 8
    for (int i = 0; i < 32; ++i) { const int kk = 2 * i + (lane >> 5); scr[kk * 33 + (lane & 31)] = W[(size_t)(k0 + kk) * N + n0 + (lane & 31)]; }
    LDS_WAIT(); asm volatile("" ::: "memory");
    const int c = lane & 7;
#pragma unroll
    for (int j = 0; j < 4; ++j) { const int n = (lane >> 3) + 8 * j; const LAS float* s = scr + (8 * c) * 33 + n;
        v2u o; o.x = pg8::pk4_fp8(s[0 * 33] * sc, s[1 * 33] * sc, s[2 * 33] * sc, s[3 * 33] * sc); o.y = pg8::pk4_fp8(s[4 * 33] * sc, s[5 * 33] * sc, s[6 * 33] * sc, s[7 * 33] * sc);
        *(GAS v2u*)(WT + (size_t)(drow0 + n) * K + k0 + 8 * c) = o; }
    LDS_WAIT(); asm volatile("" ::: "memory");
}
struct TDesc { const float* src; unsigned char* dst; int N, K, k0, n0, drow0, fp8; };
__device__ __forceinline__ void p0_dma_issue(const TDesc& d, LAS unsigned char* buf, int lane) {
    const __amdgpu_buffer_rsrc_t rs = __builtin_amdgcn_make_buffer_rsrc((void*)d.src, 0, 0x7ffffff0, 0x00020000);
#pragma unroll
    for (int j = 0; j < 16; ++j) { const int voff = ((lane >> 3) * d.N + 4 * ((lane & 7) ^ (j & 7))) * 4, soff = ((d.k0 + 8 * j) * d.N + d.n0) * 4;
        __builtin_amdgcn_raw_ptr_buffer_load_lds(rs, (LAS unsigned*)(buf + j * 1024), 16, voff, soff, 0, 0); }
}
__device__ __forceinline__ void p0_read(LAS unsigned char* buf, int lane, float (&f)[8][8]) {
    const int c = lane & 15;
#pragma unroll
    for (int jj = 0; jj < 8; ++jj) { const int n = (lane >> 4) + 4 * jj; const LAS unsigned char* s = buf + (8 * c) * 128 + ((((n >> 2) ^ (c & 7)) * 4 + (n & 3)) * 4);
#pragma unroll
        for (int i = 0; i < 8; ++i) f[jj][i] = *(const LAS float*)(s + i * 128); }
}
__device__ __forceinline__ void p0_emit(const TDesc& d, int lane, const float (&f)[8][8]) {
    const int c = lane & 15;
#pragma unroll
    for (int jj = 0; jj < 8; ++jj) { const int n = (lane >> 4) + 4 * jj;
        if (d.fp8) { v2u o; o.x = pg8::pk4_fp8(f[jj][0] * SC_W, f[jj][1] * SC_W, f[jj][2] * SC_W, f[jj][3] * SC_W); o.y = pg8::pk4_fp8(f[jj][4] * SC_W, f[jj][5] * SC_W, f[jj][6] * SC_W, f[jj][7] * SC_W);
            *(GAS v2u*)(d.dst + (size_t)(d.drow0 + n) * d.K + d.k0 + 8 * c) = o; }
        else { v4u o; o.x = pk2(f[jj][0], f[jj][1]); o.y = pk2(f[jj][2], f[jj][3]); o.z = pk2(f[jj][4], f[jj][5]); o.w = pk2(f[jj][6], f[jj][7]);
            *(GAS v4u*)((bf16*)d.dst + (size_t)(d.drow0 + n) * d.K + d.k0 + 8 * c) = o; } }
}
constexpr int PT_WGU = NEXP * 8 * 64, PT_WD = NEXP * 8 * 32, PT_WIN = 8 * 80, PT_WOUT = 8 * 32, P0T_EXPERTS = PT_WGU + PT_WD, P0T_ALL = P0T_EXPERTS + PT_WIN + PT_WOUT;
__device__ __forceinline__ void p0_transposes(Frame& F, int lo, int hi, int rank = -1, int nranks = 0) {
    const int lane = F.lane;
    const float *in_w_in = F.in(I_w_in), *in_w_out = F.in(I_w_out), *in_w_gate_up = F.in(I_w_gate_up), *in_w_down = F.in(I_w_down);
    const int gw = (rank < 0 ? F.vcu : rank) * NWAVES + F.wave, NGW = (rank < 0 ? F.G : nranks) * NWAVES;
    LAS unsigned char* lb = F.lds + RING_OFF + F.wave * 16384;
#define P0_DECODE(IT, D) do { int r = (IT); \
        if (r < PT_WGU) { const int e = r >> 9, rr = r & 511, kb = rr >> 6, nb = rr & 63, n0 = 32 * nb, j = n0 & 1023; \
            (D).src = in_w_gate_up + (size_t)e * DM * DE2; (D).dst = P_WGU8 + (size_t)e * DE2 * DM; (D).N = DE2; (D).K = DM; (D).k0 = 128 * kb; (D).n0 = n0; (D).drow0 = (j >> 7) * 256 + (n0 >= 1024 ? 128 : 0) + (j & 127); (D).fp8 = 1; break; } \
        r -= PT_WGU; \
        if (r < PT_WD) { const int e = r >> 8, rr = r & 255, kb = rr >> 5, nb = rr & 31; \
            (D).src = in_w_down + (size_t)e * DM * DM; (D).dst = P_WD8 + (size_t)e * DM * DM; (D).N = DM; (D).K = DM; (D).k0 = 128 * kb; (D).n0 = 32 * nb; (D).drow0 = 32 * nb; (D).fp8 = 1; break; } \
        r -= PT_WD; \
        if (r < PT_WIN) { const int kb = r / 80, nb = r % 80; (D).src = in_w_in; (D).dst = (unsigned char*)P_WIN_T; (D).N = INCOLS; (D).K = DM; (D).k0 = 128 * kb; (D).n0 = 32 * nb; (D).drow0 = 32 * nb; (D).fp8 = 0; break; } \
        r -= PT_WIN; \
        { const int kb = r / 32, nb = r % 32; (D).src = in_w_out; (D).dst = (unsigned char*)P_WOUT_T; (D).N = DM; (D).K = DM; (D).k0 = 128 * kb; (D).n0 = 32 * nb; (D).drow0 = 32 * nb; (D).fp8 = 0; } \
    } while (0)
    int it = lo + gw;
    if (it < hi) {
        TDesc d, d1; P0_DECODE(it, d); d1 = d;
        p0_dma_issue(d, lb, lane);
        asm volatile("s_waitcnt vmcnt(0)" ::: "memory");
        for (;;) {
            float f[8][8]; p0_read(lb, lane, f);
            LDS_WAIT(); asm volatile("" ::: "memory");
            const bool has = it + NGW < hi;
            if (has) { P0_DECODE(it + NGW, d1); p0_dma_issue(d1, lb, lane); }
            p0_emit(d, lane, f);
            asm volatile("" ::: "memory");
            if (!has) break;
            asm volatile("s_waitcnt vmcnt(8)" ::: "memory");
            it += NGW; d = d1;
        }
    }
#undef P0_DECODE
}
__device__ __forceinline__ void p0_prologue(Frame& F) {
    const int lane = F.lane;
    const float *in_w_ada = F.in(I_w_ada), *in_c = F.in(I_c), *in_b_ada = F.in(I_b_ada), *in_w_in = F.in(I_w_in), *in_w_out = F.in(I_w_out), *in_w_gate_up = F.in(I_w_gate_up), *in_w_down = F.in(I_w_down),
        *in_w_rg_a = F.in(I_w_rg_a), *in_w_rg_x = F.in(I_w_rg_x), *in_w_router = F.in(I_w_router);
    const int gw = F.vcu * NWAVES + F.wave, NGW = F.G * NWAVES;
    for (int cb = F.vcu; cb < NMOD / 24; cb += F.G) {
        LAS f32x4* part = (LAS f32x4*)(F.lds + RING_OFF);
        const int q = lane % 6, kk = lane / 6, col0 = cb * 24;
        if (kk < 8) { const int kb = F.wave * 128 + kk * 16;
            f32x4 a[4] = {(f32x4){0.f, 0.f, 0.f, 0.f}, (f32x4){0.f, 0.f, 0.f, 0.f}, (f32x4){0.f, 0.f, 0.f, 0.f}, (f32x4){0.f, 0.f, 0.f, 0.f}};
#pragma unroll
            for (int hf = 0; hf < 2; ++hf) {
                f32x4 wv[8];
#pragma unroll
                for (int t = 0; t < 8; ++t) wv[t] = *(const f32x4*)(in_w_ada + (size_t)(kb + 8 * hf + t) * NMOD + col0 + 4 * q);
#pragma unroll
                for (int b4 = 0; b4 < 4; ++b4) { const f32x4 c0 = *(const f32x4*)(in_c + b4 * DM + kb + 8 * hf), c1 = *(const f32x4*)(in_c + b4 * DM + kb + 8 * hf + 4);
                    a[b4] += c0.x * wv[0]; a[b4] += c0.y * wv[1]; a[b4] += c0.z * wv[2]; a[b4] += c0.w * wv[3]; a[b4] += c1.x * wv[4]; a[b4] += c1.y * wv[5]; a[b4] += c1.z * wv[6]; a[b4] += c1.w * wv[7]; }
                asm volatile("" ::: "memory"); }
#pragma unroll
            for (int b4 = 0; b4 < 4; ++b4) part[((F.wave * 8 + kk) * 6 + q) * 4 + b4] = a[b4]; }
        LDS_WAIT(); __syncthreads();
        if (F.tid < 96) { const int b4 = F.tid / 24, cc = F.tid % 24, qq = cc >> 2, comp = cc & 3; float s = 0.f;
            for (int p = 0; p < 64; ++p) s += part[(p * 6 + qq) * 4 + b4][comp];
            P_MOD[(size_t)b4 * NMOD + col0 + cc] = s + in_b_ada[col0 + cc]; }
        LDS_WAIT(); __syncthreads();
    }
    for (int r = gw; r < 512; r += NGW) { const int idx = r * 64 + lane, e = idx >> 10, k = idx & 1023; P_WRT[idx] = in_w_router[k * NEXP + e]; }
    asm volatile("s_waitcnt vmcnt(0)" ::: "memory");
    p0_transposes(F, P0T_EXPERTS, P0T_ALL);
    asm volatile("s_waitcnt vmcnt(0)" ::: "memory"); LDS_WAIT();
    for (int r = gw; r < 32; r += NGW) { const int which = r >> 4, rr = r & 15, n = rr >> 1, nb = rr & 1;
        p0_transpose_item((which ? in_w_rg_x : in_w_rg_a) + n * 4096, 64, 64, (which ? P_WX_T : P_WA_T) + n * 4096, 0, 32 * nb, 32 * nb, (LAS float*)(F.lds + RING_OFF + F.wave * 16384), lane); }
}
__device__ __forceinline__ void p1_norm(Frame& F) {
    const float* in_x = F.in(I_x); const float* in_g_mix = F.in(I_g_mix);
    const int gw = F.vcu * NWAVES + F.wave, NGW = F.G * NWAVES, lane = F.lane;
    for (int m = gw; m < TT; m += NGW) {
        const int b = m / SEQ;
        const GAS f32x4* xr = (const GAS f32x4*)(in_x + (size_t)m * DM) + lane;
        f32x4 v[4]; float ss = 0.f;
#pragma unroll
        for (int j = 0; j < 4; ++j) { v[j] = xr[64 * j]; ss += (v[j].x * v[j].x + v[j].y * v[j].y) + (v[j].z * v[j].z + v[j].w * v[j].w); }
        const float rstd = 1.0f / sqrtf(wave_sum(ss) * (1.0f / DM) + NORM_EPS);
        const float* mb = P_MOD + (size_t)b * NMOD;
#pragma unroll
        for (int j = 0; j < 4; ++j) { const int col = 4 * lane + 256 * j;
            const f32x4 g = *(const f32x4*)(in_g_mix + col), sc = *(const f32x4*)(mb + DM + col), sh = *(const f32x4*)(mb + col);
            const f32x4 h = (v[j] * rstd) * g * (sc + 1.0f) + sh;
            v2u o; o.x = pk2(h.x, h.y); o.y = pk2(h.z, h.w); *(GAS v2u*)(P_XN + (size_t)m * DM + col) = o; }
        asm volatile("" ::: "memory");
    }
}
template <bool FINAL> __device__ __forceinline__ void rglru_items(Frame& F) {
    LAS unsigned char* wl = F.lds + RING_OFF + F.wave * 16384;
    LAS float* summ = (LAS float*)(F.lds + SUMM_OFF);
    const float* in_conv_w = F.in(I_conv_w); const float* in_conv_b = F.in(I_conv_b); const float* in_b_rg_a = F.in(I_b_rg_a); const float* in_b_rg_x = F.in(I_b_rg_x); const float* in_lam = F.in(I_lam);
    const int lane = F.lane, w = F.wave;
    for (int it = F.vcu; it < NB * 8 * 16; it += F.G) {
        const int sp = it & 15, n = (it >> 4) & 7, b = it >> 7;
        const int gc = n * 64 + lane, t0 = sp * 256 + w * 32;
        const bf16* xrp = P_XR + ((size_t)b * SEQ) * DH + gc;
        float xin[35];
#pragma unroll
        for (int i = 0; i < 35; ++i) { const int tt = t0 - 3 + i, tc = tt < 0 ? 0 : tt; const float v = bf2f(xrp[(size_t)tc * DH]); xin[i] = tt < 0 ? 0.f : v; }
        const float cw0 = in_conv_w[gc], cw1 = in_conv_w[DH + gc], cw2 = in_conv_w[2 * DH + gc], cw3 = in_conv_w[3 * DH + gc], cb = in_conv_b[gc];
        float xc[32];
#pragma unroll
        for (int t = 0; t < 32; ++t) xc[t] = ((cw0 * xin[t] + cw1 * xin[t + 1]) + (cw2 * xin[t + 2] + cw3 * xin[t + 3])) + cb;
        LAS unsigned short* w16 = (LAS unsigned short*)wl;
#pragma unroll
        for (int t = 0; t < 32; ++t) w16[t * 64 + lane] = (unsigned short)f2bf(xc[t]);
        LDS_WAIT(); asm volatile("" ::: "memory");
        const int tok = lane & 31, hh = lane >> 5;
        bf16x8 af[4];
#pragma unroll
        for (int s = 0; s < 4; ++s) af[s] = *(const LAS bf16x8*)(wl + (tok * 64 + 16 * s + 8 * hh) * 2);
        f32x16 ga[2], gx[2];
#pragma unroll
        for (int nt = 0; nt < 2; ++nt) { ga[nt] = f32x16{}; gx[nt] = f32x16{};
            const size_t wo = ((size_t)(n * 64 + tok + 32 * nt)) * 64 + 8 * hh;
#pragma unroll
            for (int s = 0; s < 4; ++s) { const bf16x8 ba = *(const GAS bf16x8*)(P_WA_T + wo + 16 * s), bx = *(const GAS bf16x8*)(P_WX_T + wo + 16 * s);
                ga[nt] = __builtin_amdgcn_mfma_f32_32x32x16_bf16(af[s], ba, ga[nt], 0, 0, 0); gx[nt] = __builtin_amdgcn_mfma_f32_32x32x16_bf16(af[s], bx, gx[nt], 0, 0, 0); } }
        LDS_WAIT(); asm volatile("" ::: "memory");
        LAS float* wf = (LAS float*)wl;
#pragma unroll
        for (int nt = 0; nt < 2; ++nt)
#pragma unroll
            for (int rr = 0; rr < 16; ++rr) { const int tr = crow(rr, hh); wf[tr * 64 + tok + 32 * nt] = ga[nt][rr]; wf[2048 + tr * 64 + tok + 32 * nt] = gx[nt][rr]; }
        LDS_WAIT(); asm volatile("" ::: "memory");
        const float ba_ = in_b_rg_a[gc], bx_ = in_b_rg_x[gc], spc = log1pf(expf(-in_lam[gc]));
        float av[32], uv[32];
#pragma unroll
        for (int t = 0; t < 32; ++t) { const float pa = wf[t * 64 + lane] + ba_, px = wf[2048 + t * 64 + lane] + bx_;
            const float rg = __builtin_amdgcn_rcpf(1.0f + __builtin_amdgcn_exp2f(-1.4426950408889634f * pa)), ig = __builtin_amdgcn_rcpf(1.0f + __builtin_amdgcn_exp2f(-1.4426950408889634f * px));
            const float a = __builtin_amdgcn_exp2f((-8.0f * 1.4426950408889634f) * rg * spc);
            av[t] = a; uv[t] = __builtin_amdgcn_sqrtf(fmaxf(1.0f - a * a, 0.f)) * (ig * xc[t]); }
        LDS_WAIT(); asm volatile("" ::: "memory");
        float h = 0.f, P = 1.f;
#pragma unroll
        for (int t = 0; t < 32; ++t) { h = av[t] * h + uv[t]; P *= av[t]; }
        summ[(w * 64 + lane) * 2] = P; summ[(w * 64 + lane) * 2 + 1] = h;
        LDS_WAIT(); __syncthreads();
        if (!FINAL) {
            if (w == 0) { float Pt = 1.f, Ht = 0.f;
#pragma unroll
                for (int q = 0; q < 8; ++q) { const float p = summ[(q * 64 + lane) * 2], hq = summ[(q * 64 + lane) * 2 + 1]; Ht = p * Ht + hq; Pt *= p; }
                float* o = P_RSUM + ((size_t)(b * 16 + sp) * DH + gc) * 2; o[0] = Pt; o[1] = Ht; }
        } else {
            float hc = 0.f;
            { float pq[16], hq[16];
#pragma unroll
              for (int q = 0; q < 16; ++q) { const float* r2 = P_RSUM + ((size_t)(b * 16 + (q < sp ? q : 0)) * DH + gc) * 2; pq[q] = r2[0]; hq[q] = r2[1]; }
#pragma unroll
              for (int q = 0; q < 16; ++q) if (q < sp) hc = pq[q] * hc + hq[q]; }
            for (int q = 0; q < w; ++q) hc = summ[(q * 64 + lane) * 2] * hc + summ[(q * 64 + lane) * 2 + 1];
            h = hc;
            const bf16* grp = P_GR + ((size_t)b * SEQ + t0) * DH + gc; bf16* op = P_MIX + ((size_t)b * SEQ + t0) * DM + DH + gc;
            float gv[32];
#pragma unroll
            for (int t = 0; t < 32; ++t) gv[t] = bf2f(grp[(size_t)t * DH]);
            asm volatile("s_waitcnt vmcnt(0)" ::: "memory");
#pragma unroll
            for (int t = 0; t < 32; ++t) { h = av[t] * h + uv[t]; const float g = gv[t]; const float y = 0.7978845608028654f * (g + 0.044715f * g * g * g);
                const float th = 1.0f - 2.0f * __builtin_amdgcn_rcpf(1.0f + __builtin_amdgcn_exp2f((2.0f * 1.4426950408889634f) * y)); op[(size_t)t * DM] = (bf16)f2bf(h * (0.5f * g * (1.0f + th))); }
        }
        asm volatile("s_waitcnt vmcnt(0)" ::: "memory");
        LDS_WAIT(); __syncthreads();
    }
}
__device__ __forceinline__ void rglru_single(Frame& F) {
    LAS unsigned char* wl = F.lds + RING_OFF + F.wave * 16384;
    LAS float* summ = (LAS float*)(F.lds + SUMM_OFF);
    const float* in_conv_w = F.in(I_conv_w); const float* in_conv_b = F.in(I_conv_b); const float* in_b_rg_a = F.in(I_b_rg_a); const float* in_b_rg_x = F.in(I_b_rg_x); const float* in_lam = F.in(I_lam);
    const int lane = F.lane, w = F.wave;
    for (int it = F.vcu; it < NB * 8 * 16; it += F.G) {
        const int sp = it & 15, n = (it >> 4) & 7, b = it >> 7;
        const int gc = n * 64 + lane, t0 = sp * 256 + w * 32;
        const bf16* xrp = P_XR + ((size_t)b * SEQ) * DH + gc;
        float xin[35];
#pragma unroll
        for (int i = 0; i < 35; ++i) { const int tt = t0 - 3 + i, tc = tt < 0 ? 0 : tt; const float v = bf2f(xrp[(size_t)tc * DH]); xin[i] = tt < 0 ? 0.f : v; }
        const float cw0 = in_conv_w[gc], cw1 = in_conv_w[DH + gc], cw2 = in_conv_w[2 * DH + gc], cw3 = in_conv_w[3 * DH + gc], cb = in_conv_b[gc];
        float xc[32];
#pragma unroll
        for (int t = 0; t < 32; ++t) xc[t] = ((cw0 * xin[t] + cw1 * xin[t + 1]) + (cw2 * xin[t + 2] + cw3 * xin[t + 3])) + cb;
        LAS unsigned short* w16 = (LAS unsigned short*)wl;
#pragma unroll
        for (int t = 0; t < 32; ++t) w16[t * 64 + lane] = (unsigned short)f2bf(xc[t]);
        LDS_WAIT(); asm volatile("" ::: "memory");
        const int tok = lane & 31, hh = lane >> 5;
        bf16x8 af[4];
#pragma unroll
        for (int s = 0; s < 4; ++s) af[s] = *(const LAS bf16x8*)(wl + (tok * 64 + 16 * s + 8 * hh) * 2);
        f32x16 ga[2], gx[2];
#pragma unroll
        for (int nt = 0; nt < 2; ++nt) { ga[nt] = f32x16{}; gx[nt] = f32x16{};
            const size_t wo = ((size_t)(n * 64 + tok + 32 * nt)) * 64 + 8 * hh;
#pragma unroll
            for (int s = 0; s < 4; ++s) { const bf16x8 ba = *(const GAS bf16x8*)(P_WA_T + wo + 16 * s), bx = *(const GAS bf16x8*)(P_WX_T + wo + 16 * s);
                ga[nt] = __builtin_amdgcn_mfma_f32_32x32x16_bf16(af[s], ba, ga[nt], 0, 0, 0); gx[nt] = __builtin_amdgcn_mfma_f32_32x32x16_bf16(af[s], bx, gx[nt], 0, 0, 0); } }
        LDS_WAIT(); asm volatile("" ::: "memory");
        LAS float* wf = (LAS float*)wl;
#pragma unroll
        for (int nt = 0; nt < 2; ++nt)
#pragma unroll
            for (int rr = 0; rr < 16; ++rr) { const int tr = crow(rr, hh); wf[tr * 64 + tok + 32 * nt] = ga[nt][rr]; wf[2048 + tr * 64 + tok + 32 * nt] = gx[nt][rr]; }
        LDS_WAIT(); asm volatile("" ::: "memory");
        const float ba_ = in_b_rg_a[gc], bx_ = in_b_rg_x[gc], spc = log1pf(expf(-in_lam[gc]));
        float av[32], uv[32];
#pragma unroll
        for (int t = 0; t < 32; ++t) { const float pa = wf[t * 64 + lane] + ba_, px = wf[2048 + t * 64 + lane] + bx_;
            const float rg = __builtin_amdgcn_rcpf(1.0f + __builtin_amdgcn_exp2f(-1.4426950408889634f * pa)), ig = __builtin_amdgcn_rcpf(1.0f + __builtin_amdgcn_exp2f(-1.4426950408889634f * px));
            const float a = __builtin_amdgcn_exp2f((-8.0f * 1.4426950408889634f) * rg * spc);
            av[t] = a; uv[t] = __builtin_amdgcn_sqrtf(fmaxf(1.0f - a * a, 0.f)) * (ig * xc[t]); }
        LDS_WAIT(); asm volatile("" ::: "memory");
        float h = 0.f, P = 1.f;
#pragma unroll
        for (int t = 0; t < 32; ++t) { h = av[t] * h + uv[t]; P *= av[t]; }
        summ[(w * 64 + lane) * 2] = P; summ[(w * 64 + lane) * 2 + 1] = h;
        LDS_WAIT(); __syncthreads();
        const bf16* grp = P_GR + ((size_t)b * SEQ + t0) * DH + gc; bf16* op = P_MIX + ((size_t)b * SEQ + t0) * DM + DH + gc;
        float gv[32];
#pragma unroll
        for (int t = 0; t < 32; ++t) gv[t] = bf2f(grp[(size_t)t * DH]);
        LAS float* hspan = (LAS float*)(F.lds + TILE_OFF);
        if (w == 0) {
            float Pt = 1.f, Ht = 0.f;
#pragma unroll
            for (int q = 0; q < 8; ++q) { const float p = summ[(q * 64 + lane) * 2], hq = summ[(q * 64 + lane) * 2 + 1]; Ht = p * Ht + hq; Pt *= p; }
            unsigned long long* rx = (unsigned long long*)(F.ws + WS_CTL + (size_t)CW_RX * 4) + ((size_t)((b * 8 + n) * 16) * 64 + lane);
            __hip_atomic_store(rx + sp * 64, ((unsigned long long)__float_as_uint(Ht) << 32) | (unsigned long long)(__float_as_uint(Pt) | 1u), RLX_AGENT);
            unsigned long long v[15]; unsigned spins = 0u;
            for (;;) { bool ok = true;
#pragma unroll
                for (int q = 0; q < 15; ++q) { v[q] = q < sp ? __hip_atomic_load(rx + q * 64, RLX_AGENT) : 1ull; ok = ok && (v[q] != 0ull); }
                if (__all(ok)) break;
                __builtin_amdgcn_s_sleep(1); if (++spins > (1u << 20)) { if (lane == 0) __hip_atomic_store((unsigned*)(F.ws + WS_CTL) + CW_TMO, 0xA11u, RLX_AGENT); break; } }
            float hc = 0.f;
#pragma unroll
            for (int q = 0; q < 15; ++q) if (q < sp) hc = __uint_as_float((unsigned)v[q]) * hc + __uint_as_float((unsigned)(v[q] >> 32));
            hspan[lane] = hc;
        }
        LDS_WAIT(); __syncthreads();
        {   float hc = hspan[lane];
            for (int q = 0; q < w; ++q) hc = summ[(q * 64 + lane) * 2] * hc + summ[(q * 64 + lane) * 2 + 1];
            h = hc;
            asm volatile("s_waitcnt vmcnt(0)" ::: "memory");
#pragma unroll
            for (int t = 0; t < 32; ++t) { h = av[t] * h + uv[t]; const float g = gv[t]; const float y = 0.7978845608028654f * (g + 0.044715f * g * g * g);
                const float th = 1.0f - 2.0f * __builtin_amdgcn_rcpf(1.0f + __builtin_amdgcn_exp2f((2.0f * 1.4426950408889634f) * y)); op[(size_t)t * DM] = (bf16)f2bf(h * (0.5f * g * (1.0f + th))); }
        }
        asm volatile("s_waitcnt vmcnt(0)" ::: "memory");
        LDS_WAIT(); __syncthreads();
    }
}
typedef float cvt_f32x2 __attribute__((ext_vector_type(2))); typedef __bf16 cvt_bf16x2 __attribute__((ext_vector_type(2)));
__device__ __forceinline__ unsigned cvt2bf(float lo, float hi) { const cvt_f32x2 v = {lo, hi}; return __builtin_bit_cast(unsigned, __builtin_convertvector(v, cvt_bf16x2)); }
struct AttnUnit { int p, dsh, r, L0; size_t hb; };
__device__ __forceinline__ void attn_decode(int u, AttnUnit& a) {
    const int uu = u & 15, bh = (u >> 4) & 31; a.p = u >> 9; a.dsh = 2 * a.p;
    const int spr = 16 >> a.dsh;
    a.r = uu / spr; a.L0 = (uu % spr) * 256; a.hb = ((size_t)(bh >> 3) * SEQ) * DH + (bh & 7) * HD;
}
constexpr int ATT_KS = 144, ATT_VS = 192, ATT_VOFF = 384 * ATT_KS;
static_assert(ATT_VOFF + 384 * ATT_VS <= RING_BYTES, "attention LDS");
__device__ __forceinline__ void attn_items(Frame& F) {
    LAS unsigned char* kl = F.lds + RING_OFF; LAS unsigned char* vl = F.lds + RING_OFF + ATT_VOFF;
    const int lane = F.lane, c = lane & 31, hh = lane >> 5, w = F.wave, tid = F.tid;
    const float NEG = -1e30f;
    const int gi = lane >> 4, li = lane & 15;
    const int tr_base = (4 * hh + (li >> 2)) * ATT_VS + (16 * (gi & 1) + 4 * (li & 3)) * 2;
    const bf16 *QB = P_QB, *KB = P_KB, *VB = P_VB;
    constexpr int NUNIT = 3 * NB * NHEAD * 16;
    int u = F.vcu; if (u >= NUNIT) return;
    AttnUnit cu; attn_decode(u, cu);
    v4u kr[6], vr[6]; bf16x8 qn[4];
#define ATT_LOAD(A) do { _Pragma("unroll") for (int i = 0; i < 6; ++i) { const int cid = tid + 512 * i, rho = cid >> 3, ch = cid & 7; const int sub = (A).L0 - 128 + rho; \
        const int subc = sub < 0 ? 0 : sub; const size_t go = (A).hb + (size_t)((subc << (A).dsh) + (A).r) * DH + ch * 8; kr[i] = *(const GAS v4u*)(KB + go); vr[i] = *(const GAS v4u*)(VB + go); } \
        { const int tq = (((A).L0 + 32 * w + c) << (A).dsh) + (A).r; _Pragma("unroll") for (int s = 0; s < 4; ++s) qn[s] = *(const GAS bf16x8*)(QB + (A).hb + (size_t)tq * DH + 16 * s + 8 * hh); } } while (0)
    ATT_LOAD(cu);
    for (;;) {
#pragma unroll
        for (int i = 0; i < 6; ++i) { const int cid = tid + 512 * i, rho = cid >> 3, ch = cid & 7;
            *(LAS v4u*)(kl + rho * ATT_KS + ch * 16) = kr[i]; *(LAS v4u*)(vl + rho * ATT_VS + ch * 16) = vr[i]; }
        bf16x8 qf[4];
#pragma unroll
        for (int s = 0; s < 4; ++s) qf[s] = qn[s];
        const int un = u + F.G; const bool more = un < NUNIT; AttnUnit nx = cu;
        if (more) { attn_decode(un, nx); ATT_LOAD(nx); }
        LDS_WAIT(); __syncthreads();
        float m = NEG, l = 0.f; f32x16 o0 = f32x16{}, o1 = f32x16{};
        for (int j = 0; j < 5; ++j) {
            const int rho0 = 32 * w + 32 * j; if (cu.L0 - 128 + rho0 < 0) continue;
            bf16x8 kf[4];
#pragma unroll
            for (int s = 0; s < 4; ++s) kf[s] = *(const LAS bf16x8*)(kl + (rho0 + c) * ATT_KS + (16 * s + 8 * hh) * 2);
            f32x16 sc = f32x16{};
#pragma unroll
            for (int s = 0; s < 4; ++s) sc = __builtin_amdgcn_mfma_f32_32x32x16_bf16(kf[s], qf[s], sc, 0, 0, 0);
            if (j == 0) {
#pragma unroll
                for (int rr = 0; rr < 16; ++rr) if (crow(rr, hh) < c) sc[rr] = NEG;
            }
            if (j == 4) {
#pragma unroll
                for (int rr = 0; rr < 16; ++rr) if (crow(rr, hh) > c) sc[rr] = NEG;
            }
            float mx = fmaxf(fmaxf(sc[0], sc[1]), fmaxf(sc[2], sc[3]));
#pragma unroll
            for (int rr = 4; rr < 16; rr += 4) mx = fmaxf(mx, fmaxf(fmaxf(sc[rr], sc[rr + 1]), fmaxf(sc[rr + 2], sc[rr + 3])));
            mx = fmaxf(mx, __shfl_xor(mx, 32));
            if (__any(mx > m)) { const float mn = fmaxf(m, mx), alpha = __builtin_amdgcn_exp2f(m - mn); m = mn; l *= alpha;
#pragma unroll
                for (int rr = 0; rr < 16; ++rr) { o0[rr] *= alpha; o1[rr] *= alpha; } }
            float ps = 0.f;
#pragma unroll
            for (int rr = 0; rr < 16; ++rr) { sc[rr] = __builtin_amdgcn_exp2f(sc[rr] - m); ps += sc[rr]; }
            l += ps;
            v4u pb0, pb1;
            pb0.x = cvt2bf(sc[0], sc[1]); pb0.y = cvt2bf(sc[2], sc[3]); pb0.z = cvt2bf(sc[4], sc[5]); pb0.w = cvt2bf(sc[6], sc[7]);
            pb1.x = cvt2bf(sc[8], sc[9]); pb1.y = cvt2bf(sc[10], sc[11]); pb1.z = cvt2bf(sc[12], sc[13]); pb1.w = cvt2bf(sc[14], sc[15]);
            LAS unsigned char* vt = vl + rho0 * ATT_VS + tr_base;
#pragma unroll
            for (int dt = 0; dt < 2; ++dt)
#pragma unroll
                for (int s = 0; s < 2; ++s) {
                    const v4i16_t lo = __builtin_amdgcn_ds_read_tr16_b64_v4i16((LAS v4i16_t*)(vt + (16 * s) * ATT_VS + 64 * dt));
                    const v4i16_t hi = __builtin_amdgcn_ds_read_tr16_b64_v4i16((LAS v4i16_t*)(vt + (16 * s + 8) * ATT_VS + 64 * dt));
                    const bf16x8 af = (bf16x8){lo[0], lo[1], lo[2], lo[3], hi[0], hi[1], hi[2], hi[3]};
                    const bf16x8 pf = __builtin_bit_cast(bf16x8, s ? pb1 : pb0);
                    if (dt == 0) o0 = __builtin_amdgcn_mfma_f32_32x32x16_bf16(af, pf, o0, 0, 0, 0); else o1 = __builtin_amdgcn_mfma_f32_32x32x16_bf16(af, pf, o1, 0, 0, 0);
                }
        }
        asm volatile("s_waitcnt vmcnt(0)" ::: "memory");
        {   l += __shfl_xor(l, 32);
            const float inv = 1.0f / l;
            const int tq = ((cu.L0 + 32 * w + c) << cu.dsh) + cu.r;
            bf16* op = P_OP + (size_t)cu.p * TT * DH + cu.hb + (size_t)tq * DH;
#pragma unroll
            for (int g4 = 0; g4 < 4; ++g4) {
                v2u w0, w1; w0.x = cvt2bf(o0[4 * g4] * inv, o0[4 * g4 + 1] * inv); w0.y = cvt2bf(o0[4 * g4 + 2] * inv, o0[4 * g4 + 3] * inv);
                w1.x = cvt2bf(o1[4 * g4] * inv, o1[4 * g4 + 1] * inv); w1.y = cvt2bf(o1[4 * g4 + 2] * inv, o1[4 * g4 + 3] * inv);
                *(GAS v2u*)(op + 8 * g4 + 4 * hh) = w0; *(GAS v2u*)(op + 32 + 8 * g4 + 4 * hh) = w1; }
            if (hh == 0) P_LSE[(((size_t)cu.p * TT * DH + cu.hb + (size_t)tq * DH) >> 6)] = m + __builtin_amdgcn_logf(l); }
        LDS_WAIT(); __syncthreads();
        if (!more) break;
        u = un; cu = nx;
    }
#undef ATT_LOAD
}
__device__ __forceinline__ void attn_merge(Frame& F) {
    const int gt = F.vcu * (NWAVES * 64) + F.tid, NGT = F.G * NWAVES * 64;
    for (int idx = gt; idx < TT * 64; idx += NGT) {
        const int t = idx >> 6, ch = idx & 63, h = ch >> 3;
        const float l0 = P_LSE[(size_t)t * NHEAD + h], l1 = P_LSE[((size_t)TT + t) * NHEAD + h], l2 = P_LSE[((size_t)2 * TT + t) * NHEAD + h];
        const float mx = fmaxf(l0, fmaxf(l1, l2));
        float w0 = __builtin_amdgcn_exp2f(l0 - mx), w1 = __builtin_amdgcn_exp2f(l1 - mx), w2 = __builtin_amdgcn_exp2f(l2 - mx);
        const float inv = 1.0f / (w0 + w1 + w2); w0 *= inv; w1 *= inv; w2 *= inv;
        const v4u a = *(const GAS v4u*)(P_OP + (size_t)t * DH + ch * 8), bq = *(const GAS v4u*)(P_OP + ((size_t)TT + t) * DH + ch * 8), cq = *(const GAS v4u*)(P_OP + ((size_t)2 * TT + t) * DH + ch * 8);
        v4u o;
#pragma unroll
        for (int k = 0; k < 4; ++k) {
            const float lo = w0 * bf2f((unsigned short)(a[k] & 0xffffu)) + w1 * bf2f((unsigned short)(bq[k] & 0xffffu)) + w2 * bf2f((unsigned short)(cq[k] & 0xffffu));
            const float hi = w0 * bf2f((unsigned short)(a[k] >> 16)) + w1 * bf2f((unsigned short)(bq[k] >> 16)) + w2 * bf2f((unsigned short)(cq[k] >> 16));
            o[k] = pk2(lo, hi); }
        *(GAS v4u*)(P_MIX + (size_t)t * DM + ch * 8) = o;
        asm volatile("" ::: "memory");
    }
}

#ifndef ROUTER_SPLIT
#define ROUTER_SPLIT 2
#endif
__device__ __forceinline__ void p6_rows(Frame& F, int only = 0) {
    const float* in_g_ffn = F.in(I_g_ffn); const float* in_b_router = F.in(I_b_router);
    constexpr int RS = ROUTER_SPLIT;
    const bool split = (F.G % RS) == 0;
    if (split && (F.vcu % RS) != 0) { if (only != 1) p0_transposes(F, 0, PT_WGU, (F.vcu / RS) * (RS - 1) + (F.vcu % RS) - 1, (F.G / RS) * (RS - 1)); return; }
    const int rrank = split ? F.vcu / RS : F.vcu, rn = split ? F.G / RS : F.G;
    if (only >= 2) return;
    LAS unsigned char* hl = F.lds + RING_OFF;
    LAS int* wc = (LAS int*)(F.lds + SUMM_OFF);
    const int lane = F.lane, w = F.wave, e = lane & 31, hh = lane >> 5;
    float wreg[64];
#pragma unroll
    for (int i4 = 0; i4 < 16; ++i4) { const f32x4 t = *(const GAS f32x4*)(P_WRT + (size_t)e * DM + 128 * w + 64 * hh + 4 * i4); wreg[4 * i4] = t.x; wreg[4 * i4 + 1] = t.y; wreg[4 * i4 + 2] = t.z; wreg[4 * i4 + 3] = t.w; }
    const float bias = in_b_router[e];
    const __amdgpu_buffer_rsrc_t rs_x1 = __builtin_amdgcn_make_buffer_rsrc((void*)P_X1, 0, 0x7ffffff0, 0x00020000), rs_h8 = __builtin_amdgcn_make_buffer_rsrc((void*)P_XN8, 0, 0x7ffffff0, 0x00020000);
#define P6_LOADROW(dst, m) do { _Pragma("unroll") for (int j_ = 0; j_ < 4; ++j_) (dst)[j_] = __builtin_bit_cast(v2u, __builtin_amdgcn_raw_buffer_load_b64(rs_x1, lane * 8 + j_ * 512, (m) * (DM * 2), 0)); } while (0)
    v2u xa[4][4];
    if (rrank < TT / 64) {
#pragma unroll
      for (int q = 0; q < 4; ++q) P6_LOADROW(xa[q], rrank * 64 + 4 * w + q); }
    for (int chunk = rrank; chunk < TT / 64; chunk += rn) {
      int wcount = 0;
      const int b = (chunk * 64) / SEQ;
      const float* mb = P_MOD + (size_t)b * NMOD;
#pragma nounroll
      for (int bl = 0; bl < 2; ++bl) {
        const int mblk = chunk * 64 + bl * 32;
#pragma unroll
        for (int q = 0; q < 4; ++q) { f32x4 v[4]; float sa = 0.f; const int tok = 4 * w + q;
#pragma unroll
            for (int j = 0; j < 4; ++j) { const v2u t = xa[q][j]; v[j] = (f32x4){bf2f((unsigned short)(t.x & 0xffffu)), bf2f((unsigned short)(t.x >> 16)), bf2f((unsigned short)(t.y & 0xffffu)), bf2f((unsigned short)(t.y >> 16))};
                sa += (v[j].x * v[j].x + v[j].y * v[j].y) + (v[j].z * v[j].z + v[j].w * v[j].w); }
            const float ra = 1.0f / sqrtf(wave_sum(sa) * (1.0f / DM) + NORM_EPS);
#pragma unroll
            for (int j = 0; j < 4; ++j) { const int col = 4 * lane + 256 * j;
                const f32x4 Gm = *(const f32x4*)(in_g_ffn + col) * (*(const f32x4*)(mb + 4 * DM + col) + 1.0f), Sm = *(const f32x4*)(mb + 3 * DM + col);
                const f32x4 h = (v[j] * ra) * Gm + Sm;
                __builtin_amdgcn_raw_buffer_store_b32(pg8::pk4_fp8(h.x * SC_H, h.y * SC_H, h.z * SC_H, h.w * SC_H), rs_h8, lane * 4 + j * 256, (mblk + tok) * DM, 0);
                *(LAS f32x4*)(hl + tok * 4096 + (((lane + 64 * j) ^ (tok & 15)) * 16)) = h; } }
        {
            const int mn = bl == 0 ? mblk + 32 : (chunk + rn < TT / 64 ? (chunk + rn) * 64 : mblk);
#pragma unroll
            for (int q = 0; q < 4; ++q) P6_LOADROW(xa[q], mn + 4 * w + q); }
        LDS_WAIT(); __syncthreads();
        f32x16 acc = f32x16{};
        { const LAS unsigned char* hrow = hl + e * 4096;
#pragma unroll
          for (int i4 = 0; i4 < 16; ++i4) { const f32x4 a4 = *(const LAS f32x4*)(hrow + (((32 * w + 16 * hh + i4) ^ (e & 15)) * 16));
              acc = __builtin_amdgcn_mfma_f32_32x32x2f32(wreg[4 * i4], a4.x, acc, 0, 0, 0); acc = __builtin_amdgcn_mfma_f32_32x32x2f32(wreg[4 * i4 + 1], a4.y, acc, 0, 0, 0);
              acc = __builtin_amdgcn_mfma_f32_32x32x2f32(wreg[4 * i4 + 2], a4.z, acc, 0, 0, 0); acc = __builtin_amdgcn_mfma_f32_32x32x2f32(wreg[4 * i4 + 3], a4.w, acc, 0, 0, 0); } }
        LDS_WAIT(); __syncthreads();
#pragma unroll
        for (int g = 0; g < 4; ++g) *(LAS f32x4*)(hl + (w * 32 + e) * 128 + (((2 * g + hh) ^ (e & 7)) * 16)) = (f32x4){acc[4 * g], acc[4 * g + 1], acc[4 * g + 2], acc[4 * g + 3]};
        LDS_WAIT(); __syncthreads();
#pragma unroll
        for (int pr = 0; pr < 2; ++pr) {
          const int tl = 4 * w + 2 * pr + hh;
          float val = bias;
#pragma unroll
          for (int q = 0; q < 8; ++q) val += *(const LAS float*)(hl + (q * 32 + tl) * 128 + (((e >> 2) ^ (tl & 7)) * 16) + (e & 3) * 4);
          float tv[4]; int te[4];
#pragma unroll
          for (int r = 0; r < 4; ++r) { float mx = val;
              mx = row_max16(mx); mx = fmaxf(mx, __shfl_xor(mx, 16));
              const unsigned long long bal = __ballot(val == mx); const unsigned hb = hh ? (unsigned)(bal >> 32) : (unsigned)bal;
              const int es = __builtin_ctz(hb | 0x80000000u);
              te[r] = es; tv[r] = mx; if (e == es) val = -INFINITY; }
          const float e1 = expf(tv[1] - tv[0]), e2 = expf(tv[2] - tv[0]), e3 = expf(tv[3] - tv[0]); const float inv = 1.0f / (1.0f + e1 + e2 + e3);
          int lpv = 0;
#pragma unroll
          for (int h2 = 0; h2 < 2; ++h2)
#pragma unroll
            for (int r = 0; r < 4; ++r) { const int es = __builtin_amdgcn_readlane(te[r], 32 * h2); const int lp = __builtin_amdgcn_readlane(wcount, es);
                if (lane == es) ++wcount; if (lane == 32 * h2 + r) lpv = lp; }
          if (e < 4) { const int m = mblk + tl, ti = 4 * bl + 2 * pr + hh;
              const int ee = e == 0 ? te[0] : e == 1 ? te[1] : e == 2 ? te[2] : te[3];
              const float g = (e == 0 ? 1.0f : e == 1 ? e1 : e == 2 ? e2 : e3) * inv;
              P_TOK_E[m * 4 + e] = ee; P_TOK_GATE[m * 4 + e] = g;
              wc[512 + ((w * 8 + ti) * 4 + e) * 2] = ee; wc[512 + ((w * 8 + ti) * 4 + e) * 2 + 1] = lpv; }
        }
        LDS_WAIT(); __syncthreads();
      }
      if (lane < 32) wc[w * 32 + lane] = wcount;
      LDS_WAIT(); __syncthreads();
      if (lane < 32) { int pre = 0; for (int q = 0; q < w; ++q) pre += wc[q * 32 + lane]; wc[256 + w * 32 + lane] = pre;
          if (w == 7) P_BCNT[chunk * 32 + lane] = pre + wcount; }
      LDS_WAIT(); asm volatile("" ::: "memory");
      if (lane < 32) { const int ti = lane >> 2, r = lane & 3; const int ee = wc[512 + ((w * 8 + ti) * 4 + r) * 2], l = wc[512 + ((w * 8 + ti) * 4 + r) * 2 + 1];
          P_TOK_POS[(chunk * 64 + (ti >> 2) * 32 + 4 * w + (ti & 3)) * 4 + r] = wc[256 + w * 32 + ee] + l; }
      LDS_WAIT(); __syncthreads();
    }
#undef P6_LOADROW
}
__device__ __forceinline__ void p7_gather(Frame& F) {
    LAS int* pt = (LAS int*)(F.lds + RING_OFF);
    volatile LAS int* lb = (volatile LAS int*)(F.lds + TILE_OFF);
    { const int e = F.tid & 31, seg = F.tid >> 5; int s = 0;
      for (int j = 0; j < 16; ++j) s += P_BCNT[(seg * 16 + j) * 32 + e];
      pt[8192 + seg * 32 + e] = s; LDS_WAIT(); __syncthreads();
      int base = 0, tot = 0; for (int q = 0; q < 16; ++q) { const int x = pt[8192 + q * 32 + e]; if (q < seg) base += x; tot += x; }
      for (int j = 0; j < 16; ++j) { pt[(seg * 16 + j) * 32 + e] = base; base += P_BCNT[(seg * 16 + j) * 32 + e]; }
      if (seg == 0) lb[64 + e] = tot; }
    LDS_WAIT(); __syncthreads();
    if (F.tid == 0) { int acc = 0, nt = 0;
        for (int e = 0; e < NEXP; ++e) { const int c = lb[64 + e]; lb[e] = acc; const int tiles = (c + 255) >> 8;
            if (blockIdx.x == 0) for (int k = 0; k < tiles; ++k) P_TILE_E[nt + k] = e;
            nt += tiles; acc += tiles * 256; }
        lb[32] = acc; if (blockIdx.x == 0) P_TILE_N[0] = nt; }
    LDS_WAIT(); __syncthreads();
    const int gt = F.vcu * (NWAVES * 64) + F.tid, NGT = F.G * NWAVES * 64;
    for (int idx = gt; idx < TT * TOPK + NEXP * 256; idx += NGT) {
        if (idx < TT * TOPK) { const int e = P_TOK_E[idx], pos = P_TOK_POS[idx]; const int slot = lb[e] + pt[(idx >> 8) * 32 + e] + pos; P_TOK_SLOT[idx] = slot; P_SLOT_TOK[slot] = idx >> 2; }
        else { const int q = idx - TT * TOPK, e = q >> 8, i = q & 255; const int c = lb[64 + e]; const int padded = ((c + 255) >> 8) << 8; if (c + i < padded) P_SLOT_TOK[lb[e] + c + i] = TT; }
    }
    if (blockIdx.x == 0 && F.tid < 64) ((GAS v4u*)(P_XN8 + (size_t)TT * DM))[F.tid] = (v4u){0u, 0u, 0u, 0u};
    asm volatile("s_waitcnt vmcnt(0)" ::: "memory");
    LDS_WAIT(); __syncthreads();
    if (F.G % ROUTER_SPLIT) p0_transposes(F, 0, PT_WGU);
}
__device__ __forceinline__ void p10_final(Frame& F) {
    const float* in_g_final = F.in(I_g_final); float* out_p = (float*)F.in(22);
    const int gw = F.vcu * NWAVES + F.wave, NGW = F.G * NWAVES, lane = F.lane;
    const bf16* Y2 = P_Y2;
    for (int m = gw; m < TT; m += NGW) {
        const int b = m / SEQ;
        const GAS v2u* xr = (const GAS v2u*)(P_X1 + (size_t)m * DM) + lane;
        f32x4 v[4], a[4];
#pragma unroll
        for (int j = 0; j < 4; ++j) { const v2u t = xr[64 * j]; v[j] = (f32x4){bf2f((unsigned short)(t.x & 0xffffu)), bf2f((unsigned short)(t.x >> 16)), bf2f((unsigned short)(t.y & 0xffffu)), bf2f((unsigned short)(t.y >> 16))}; a[j] = (f32x4){0.f, 0.f, 0.f, 0.f}; }
#pragma unroll
        for (int k = 0; k < 4; ++k) { const int slot = P_TOK_SLOT[m * 4 + k]; const float g = P_TOK_GATE[m * 4 + k];
            const GAS v2u* yr = (const GAS v2u*)(Y2 + (size_t)slot * DM) + lane;
#pragma unroll
            for (int j = 0; j < 4; ++j) { const v2u y = yr[64 * j];
                a[j].x += g * bf2f((unsigned short)(y.x & 0xffffu)); a[j].y += g * bf2f((unsigned short)(y.x >> 16)); a[j].z += g * bf2f((unsigned short)(y.y & 0xffffu)); a[j].w += g * bf2f((unsigned short)(y.y >> 16)); } }
        const float* gf = P_MOD + (size_t)b * NMOD + 5 * DM; float ss = 0.f;
#pragma unroll
        for (int j = 0; j < 4; ++j) { const f32x4 gt = *(const f32x4*)(gf + 4 * lane + 256 * j); v[j] = v[j] + gt * a[j]; ss += (v[j].x * v[j].x + v[j].y * v[j].y) + (v[j].z * v[j].z + v[j].w * v[j].w); }
        const float rstd = 1.0f / sqrtf(wave_sum(ss) * (1.0f / DM) + NORM_EPS);
        GAS f32x4* orow = (GAS f32x4*)(out_p + (size_t)m * DM) + lane;
#pragma unroll
        for (int j = 0; j < 4; ++j) { const f32x4 g = *(const f32x4*)(in_g_final + 4 * lane + 256 * j); orow[64 * j] = (v[j] * rstd) * g; }        asm volatile("" ::: "memory");
    }
}

#ifndef DUP_MASK
#define DUP_MASK 0
#endif
struct Args { const float* in[22]; float* out; unsigned char* ws; int ph_lo, ph_hi, li, pad; };
__global__ void __launch_bounds__(NWAVES * 64, 2) hymba_fwd(Args args) {
    extern __shared__ __attribute__((aligned(16))) unsigned char lds[];
    Frame F;
    F.lds = (LAS unsigned char*)lds;
    F.tid = threadIdx.x; F.lane = F.tid & 63; F.wave = __builtin_amdgcn_readfirstlane(F.tid >> 6);
    F.G = gridDim.x; { const int bx = blockIdx.x; F.vcu = (F.G % 8 == 0) ? (bx % 8) * (F.G / 8) + bx / 8 : bx; }
    unsigned char* ws = args.ws;
    F.ws = ws; F.ka = (const __attribute__((address_space(4))) void*)__builtin_amdgcn_kernarg_segment_ptr();
    for (int u = F.tid; u < (LDS_BYTES - LDSCTL_OFF) / 4; u += NWAVES * 64) ((LAS unsigned*)(F.lds + LDSCTL_OFF))[u] = 0u;
    __syncthreads();
#define CTLP ((gu32*)(F.ws + WS_CTL))
#define MISCP ((volatile LAS unsigned*)(F.lds + MISC_OFF))
    if (N_LAUNCHES != PER_PHASE) (void)xcd_barrier_post((unsigned*)(CTLP + CW_BAR), MISCP + 8);
#define GRID_BAR(seam) do { if (N_LAUNCHES == PER_PHASE) { if (F.tid == 0) __hip_atomic_store(CTLP + CW_TMO, 0xBADBA0u | (unsigned)(seam), RLX_AGENT); } \
    else { XcdBarrier bar_; bar_.bar = (unsigned*)(CTLP + CW_BAR); bar_.x = xb_xcc_id(); bar_.st = MISCP + 8; xcd_barrier(bar_); if (DUPK(13)) xcd_barrier(bar_); } asm volatile("" : "+v"(F.tid), "+v"(F.lane)); } while (0)
    const int lo = (N_LAUNCHES == 1) ? 0 : args.ph_lo, hi = (N_LAUNCHES == 1) ? PER_PHASE : args.ph_hi;
#ifndef PHASE_MASK
#define PHASE_MASK 0x7ff
#endif
#define IN(k) (((PHASE_MASK >> (k)) & 1) && lo <= (k) && (k) < hi)
#define BOTH(k) (IN(k) && IN((k) + 1))
#define DUPK(k) ((DUP_MASK >> (k)) & 1)
#define RUN_P2() do { pg8::Gemm g{P_XN, P_WIN_T, TT, INCOLS, DM}; pg8::StaticOrder S; S.init(TT, INCOLS, F.G, (int)blockIdx.x); \
        pg8::EpiBf16<0> E{P_QB, DH, nullptr, DH, (size_t)TT * DH, C2}; \
        pg8::gemm_phase<pg8::EpiBf16<0>, pg8::StaticOrder, true, true>(F.lds + RING_OFF, g, S, E); } while (0)
#define RUN_P5() do { pg8::Gemm g{P_MIX, P_WOUT_T, TT, DM, DM}; pg8::StaticOrder S; S.init(TT, DM, F.G, (int)blockIdx.x); \
        pg8::EpiResGate E{F.in(I_x), P_X1, DM, P_MOD + 2 * DM, NMOD, SEQ}; \
        pg8::gemm_phase<pg8::EpiResGate, pg8::StaticOrder, true, true>(F.lds + RING_OFF, g, S, E); } while (0)
#define RUN_P8() do { const int ntm = P_TILE_N[0]; \
        pg8::Gemm g{(const pg8::bf16_t*)P_XN8, (const pg8::bf16_t*)P_WGU8, ntm * 256, DE2, DM / 2}; pg8::GroupedOrder S; S.init(P_TILE_E, ntm, 8, F.G, (int)blockIdx.x); \
        LAS int* rt = (LAS int*)(F.lds + ROWTAB_OFF); { pg8::Unit u_; for (int i_ = 0; i_ < ROWTAB_UNITS && S.next(i_, u_); ++i_) if (F.tid < 256) rt[i_ * 256 + F.tid] = P_SLOT_TOK[u_.pm * 256 + F.tid] * DM; } \
        LDS_WAIT(); __syncthreads(); \
        pg8::EpiSwiglu E{P_ACT8, F.in(I_b_gate_up), 1.0f / (SC_H * SC_W), SC_ACT}; \
        pg8::gemm_phase<pg8::EpiSwiglu, pg8::GroupedOrder, true, true, true, true>(F.lds + RING_OFF, g, S, E, rt); \
        asm volatile("s_waitcnt vmcnt(0)" ::: "memory"); __syncthreads(); p0_transposes(F, PT_WGU, P0T_EXPERTS); } while (0)
#define RUN_P9() do { const int ntm = P_TILE_N[0]; \
        pg8::Gemm g{(const pg8::bf16_t*)P_ACT8, (const pg8::bf16_t*)P_WD8, ntm * 256, DM, DM / 2}; pg8::GroupedOrder S; S.init(P_TILE_E, ntm, 4, F.G, (int)blockIdx.x); \
        pg8::EpiDown E{P_Y2, F.in(I_b_down), 1.0f / (SC_ACT * SC_W)}; \
        pg8::gemm_phase<pg8::EpiDown, pg8::GroupedOrder, true, true, true>(F.lds + RING_OFF, g, S, E); } while (0)
    if (IN(0)) { p0_prologue(F); if (BOTH(0)) GRID_BAR(0); if (DUPK(0)) { p0_prologue(F); GRID_BAR(0); } }
    if (IN(1)) { p1_norm(F); if (BOTH(1)) GRID_BAR(1); if (DUPK(1)) { p1_norm(F); GRID_BAR(1); } }
    if (IN(2)) { RUN_P2(); if (BOTH(2)) GRID_BAR(2); if (DUPK(2)) { RUN_P2(); GRID_BAR(2); } }
    if (IN(3)) { rglru_single(F); attn_items(F); if (BOTH(3)) GRID_BAR(3);  if (DUPK(11)) { attn_items(F); GRID_BAR(3); }  }
    if (IN(4)) { attn_merge(F); if (BOTH(4)) GRID_BAR(4); if (DUPK(4)) { attn_merge(F); GRID_BAR(4); } }
    if (IN(5)) { RUN_P5(); if (BOTH(5)) GRID_BAR(5); if (DUPK(5)) { RUN_P5(); GRID_BAR(5); } }
    if (IN(6)) { p6_rows(F); if (BOTH(6)) GRID_BAR(6); if (DUPK(6)) { p6_rows(F); GRID_BAR(6); } if (DUPK(14)) { p6_rows(F, 1); GRID_BAR(6); } if (DUPK(15)) { p6_rows(F, 2); GRID_BAR(6); } }
    if (IN(7)) { p7_gather(F); if (BOTH(7)) GRID_BAR(7); if (DUPK(7)) { p7_gather(F); GRID_BAR(7); } }
    if (IN(8)) { RUN_P8(); if (BOTH(8)) GRID_BAR(8); if (DUPK(8)) { RUN_P8(); GRID_BAR(8); } }
    if (IN(9)) { RUN_P9(); if (BOTH(9)) GRID_BAR(9); if (DUPK(9)) { RUN_P9(); GRID_BAR(9); } }
    if (IN(10)) { p10_final(F); if (DUPK(10)) { GRID_BAR(10); p10_final(F); } }
#undef IN
#undef BOTH
}

extern "C" void kernel_launch(void* const* d_in, const int* in_sizes, int n_in, void* d_out, int out_size, void* d_ws, size_t ws_size, hipStream_t stream) {
    static int grid = 0;
    if (grid == 0) {
        if (n_in != 22 || in_sizes[0] != TT * DM || out_size != TT * DM || ws_size < WS_END) { fprintf(stderr, "kernel_launch: unexpected shapes (n_in %d, in0 %d, out %d, ws %zu); nothing launched\n", n_in, n_in > 0 ? in_sizes[0] : -1, out_size, ws_size); grid = -1; return; }
        int dev = 0, cus = 0, per_cu = 0;
        if (hipGetDevice(&dev) != hipSuccess || hipDeviceGetAttribute(&cus, hipDeviceAttributeMultiprocessorCount, dev) != hipSuccess) { fprintf(stderr, "kernel_launch: device query failed\n"); grid = -1; return; }
        if (hipFuncSetAttribute((const void*)hymba_fwd, hipFuncAttributeMaxDynamicSharedMemorySize, LDS_BYTES) != hipSuccess) { fprintf(stderr, "kernel_launch: hipFuncSetAttribute failed\n"); grid = -1; return; }
        if (hipOccupancyMaxActiveBlocksPerMultiprocessor(&per_cu, (const void*)hymba_fwd, NWAVES * 64, LDS_BYTES) != hipSuccess || per_cu < 1) { fprintf(stderr, "kernel_launch: occupancy query reports %d workgroups per CU\n", per_cu); per_cu = 1; }
        (void)hipGetLastError();
        if (cus < 256) { fprintf(stderr, "kernel_launch: built for a 256-CU device (one workgroup per CU), found %d CUs; nothing launched\n", cus); grid = -1; return; }
        grid = 256;
    }
    if (grid < 0) return;
    if (hipMemsetAsync((char*)d_ws + WS_CTL, 0, CTL_ZERO_BYTES, stream) != hipSuccess) { fprintf(stderr, "kernel_launch: memset failed\n"); return; }
    Args a{};
    for (int i = 0; i < 22; ++i) a.in[i] = (const float*)d_in[i];
    a.out = (float*)d_out; a.ws = (unsigned char*)d_ws; a.pad = DUP_MASK;
    for (int li = 0; li < N_LAUNCHES; ++li) {
        a.ph_lo = (N_LAUNCHES == PER_PHASE) ? li : 0; a.ph_hi = (N_LAUNCHES == PER_PHASE) ? li + 1 : PER_PHASE; a.li = li;
        hipLaunchKernelGGL(hymba_fwd, dim3(grid), dim3(NWAVES * 64), LDS_BYTES, stream, a);
        const hipError_t le = hipPeekAtLastError();
        if (le != hipSuccess) { fprintf(stderr, "kernel_launch: launch %d failed: %s\n", li, hipGetErrorName(le)); break; }
    }
}
```

```cpp
#include <hip/hip_runtime.h>
#include <cstdio>
#include <cstdint>
#define MK_N_LAUNCHES 1
#define DUP_MASK 0
namespace pg8 {
#define PG8_LAS __attribute__((address_space(3)))
typedef unsigned short bf16_t;
typedef short bf16x8 __attribute__((ext_vector_type(8)));
typedef float f32x4 __attribute__((ext_vector_type(4)));
typedef unsigned u32x4 __attribute__((ext_vector_type(4)));
constexpr int BM = 256, BK = 64, HALF = 128, HTB = HALF * BK * 2  , STAGE_BYTES = 8 * HTB, NXCD = 8, WGM = 8;

__host__ __device__ __forceinline__ int lds_byte(int r, int c) { const int st = (r >> 4) * 2 + (c >> 5), rr = r & 15, cc = c & 31, ob = rr * 64 + cc * 2; return st * 1024 + (ob ^ (((ob >> 9) & 1) << 5)); }
__host__ __device__ __forceinline__ void stage_rc(int b, int& R, int& C) { const int st = b / 1024, sb = b % 1024, swz = sb ^ (((sb >> 9) & 1) << 5); R = (st >> 1) * 16 + swz / 64; C = (st & 1) * 32 + (swz % 64) / 2; }
__host__ __device__ __forceinline__ int perm32(int rho) { const int n = rho >> 4, i = rho & 15; return 8 * (i >> 2) + 4 * n + (i & 3); }

struct Unit { int pm, pn; };
struct Gemm { const bf16_t* A; const bf16_t* Bt; int M, N, K; };

struct StaticOrder {
    int nM, nN, nwg, G, c;
    __host__ __device__ void init(int M, int N, int G_, int c_) { nM = M / BM; nN = N / BM; nwg = nM * nN; G = G_; c = c_; }
    __host__ __device__ bool next(int i, Unit& u) const {
        const long L = (long)i * G + c; if (L >= nwg) return false;
        int wgid = (int)L; { const int q = nwg / NXCD, r = nwg % NXCD, xcd = wgid % NXCD, off = wgid / NXCD; wgid = (xcd < r ? xcd * (q + 1) : r * (q + 1) + (xcd - r) * q) + off; }
        const int nig = WGM * nN, gid = wgid / nig, fm = gid * WGM, gsz = (nM - fm) < WGM ? (nM - fm) : WGM;
        u.pm = fm + ((wgid % nig) % gsz); u.pn = (wgid % nig) / gsz; return true;
    }
    __device__ __forceinline__ void a_ready(const Unit&) const {}
    __device__ __forceinline__ void done(const Unit&) const {}
};

typedef float cvtf32x2_t __attribute__((ext_vector_type(2))); typedef __bf16 cvtbf16x2_t __attribute__((ext_vector_type(2)));
__device__ __forceinline__ unsigned cvt_pk_bf16(float lo, float hi) { const cvtf32x2_t v = {lo, hi}; return __builtin_bit_cast(unsigned, __builtin_convertvector(v, cvtbf16x2_t)); }
typedef float f32x2 __attribute__((ext_vector_type(2)));
__device__ __forceinline__ f32x2 gelu_pk(f32x2 v) {
    const f32x2 av = __builtin_elementwise_abs(v), d = av * 0.2316418882f + 1.0f;
    f32x2 t; t.x = __builtin_amdgcn_rcpf(d.x); t.y = __builtin_amdgcn_rcpf(d.y);
    f32x2 q = t * 0.5307027145f + (-0.7265760135f); q = q * t + 0.7107068705f; q = q * t + (-0.142248368f); q = q * t + 0.127414796f; q = q * t;
    const f32x2 s = (v * v) * (-0.72134752044f);
    f32x2 e; e.x = __builtin_amdgcn_exp2f(s.x); e.y = __builtin_amdgcn_exp2f(s.y);
    const f32x2 m = v * (q * e), r = v - m;
    f32x2 o; o.x = v.x < 0.f ? m.x : r.x; o.y = v.y < 0.f ? m.y : r.y; return o;
}

template <int ACT  > struct EpiBf16 {
    static constexpr bool PERM = true, AFTER_DRAIN = false; static_assert(ACT == 0 || ACT == 1, "EpiBf16: ACT is 0 (none) or 1 (gelu_pk)");
    bf16_t* O; int ldc; const float* bias; int split_cols; size_t split_stride; float scale0;
    __device__ __forceinline__ void operator()(const f32x4 (&acc)[2][2][4][2], const Unit& u, int wr, int wc, int fr, int fq) const {
        const int row0 = u.pm * BM + wr * 64 + fr; int colt = u.pn * BM; bf16_t* base = O;
        float sc = 1.f; if (split_cols) { const int t = colt / split_cols; base += (size_t)t * split_stride; colt -= t * split_cols; if (t == 0) sc = scale0; }
        const int col0 = colt + wc * 32 + 8 * fq, bcol0 = u.pn * BM + wc * 32 + 8 * fq;
        f32x4 bv[2][2];
#pragma unroll
        for (int bj = 0; bj < 2; ++bj)
#pragma unroll
            for (int n = 0; n < 2; ++n) bv[bj][n] = bias ? *(const f32x4*)(bias + bcol0 + bj * HALF + 4 * n) : (f32x4){0.f, 0.f, 0.f, 0.f};
#pragma unroll
        for (int ai = 0; ai < 2; ++ai)
#pragma unroll
            for (int m = 0; m < 4; ++m) { bf16_t* rowp = base + (size_t)(row0 + ai * HALF + m * 16) * ldc + col0;
#pragma unroll
                for (int bj = 0; bj < 2; ++bj) { f32x4 v0 = acc[ai][bj][m][0] + bv[bj][0], v1 = acc[ai][bj][m][1] + bv[bj][1];
                    if (ACT == 1) { f32x2 a = gelu_pk((f32x2){v0[0], v0[1]}), b = gelu_pk((f32x2){v0[2], v0[3]}), c = gelu_pk((f32x2){v1[0], v1[1]}), d = gelu_pk((f32x2){v1[2], v1[3]});
                        v0 = (f32x4){a.x, a.y, b.x, b.y}; v1 = (f32x4){c.x, c.y, d.x, d.y}; }
                    v0 = v0 * sc; v1 = v1 * sc; u32x4 w; w.x = cvt_pk_bf16(v0[0], v0[1]); w.y = cvt_pk_bf16(v0[2], v0[3]); w.z = cvt_pk_bf16(v1[0], v1[1]); w.w = cvt_pk_bf16(v1[2], v1[3]);
                    *(u32x4*)(rowp + bj * HALF) = w; } }
    }
};
template <class Epi, class Sched, bool ALIGN_EPI = false, bool SP2 = false, bool FP8 = false, bool GATHER = false>
__device__ __forceinline__ void gemm_phase(PG8_LAS unsigned char* lds, const Gemm g, const Sched& S, const Epi& E, const PG8_LAS int* rowtab = nullptr) {
    int tid_ = threadIdx.x; asm volatile("" : "+v"(tid_));
    const int tid = tid_, wid = __builtin_amdgcn_readfirstlane(tid >> 6), lane = tid & 63, wr = wid >> 2, wc = wid & 3, fr = lane & 15, fq = lane >> 4;
    const int K = g.K, nt = K / BK;
    unsigned voffA, voffB;
    { int R, C; stage_rc(tid * 16, R, C); const int Rb = Epi::PERM ? ((R & ~31) + perm32(R & 31)) : R; voffA = (unsigned)(R * K + C) * 2u; voffB = (unsigned)(Rb * K + C) * 2u; }
    const unsigned qstep = 64u * K * 2;
    const unsigned kstep = (unsigned)(BK * 2);
    const unsigned hstep = (unsigned)HALF * K * 2;
    const unsigned tstep = 2 * hstep;
    const unsigned ldsw = (unsigned)wid * 1024u;
    const int aoff = lds_byte(wr * 64 + fr, fq * 8), boff = lds_byte(wc * 32 + fr, fq * 8);
#define PG8_SA(b, h) (((b) * 2 + (h)) * HTB)
#define PG8_SB(b, h) ((4 + (b) * 2 + (h)) * HTB)
#define PG8_STAGE(bufoff, goff, voff) do { _Pragma("unroll") for (int _i = 0; _i < 2; ++_i) \
        __builtin_amdgcn_raw_ptr_buffer_load_lds(srd_##voff, (PG8_LAS unsigned*)(lds + (bufoff) + ldsw + _i * 8192), 16, (int)(voff), (int)((goff) + _i * qstep), 0, 0); } while (0)
#define PG8_STAGE_A(bufoff, goff, VS) do { _Pragma("unroll") for (int _i = 0; _i < 2; ++_i) \
        __builtin_amdgcn_raw_ptr_buffer_load_lds(srd_voffA, (PG8_LAS unsigned*)(lds + (bufoff) + ldsw + _i * 8192), 16, GATHER ? (int)VS[((bufoff) / HTB) & 1][_i] : (int)voffA, GATHER ? (int)(goff) : (int)((goff) + _i * qstep), 0, 0); } while (0)
#define PG8_LDA(dst, b, h) do { if constexpr (FP8) { _Pragma("unroll") for (int m = 0; m < 4; ++m) { const v4i_t l_ = *(const PG8_LAS v4i_t*)(lds + PG8_SA(b, h) + aoff + m * 2048), h_ = *(const PG8_LAS v4i_t*)(lds + PG8_SA(b, h) + aoff + m * 2048 + 1024); dst##8[m] = __builtin_shufflevector(l_, h_, 0, 1, 2, 3, 4, 5, 6, 7); } } else { _Pragma("unroll") for (int m = 0; m < 4; ++m) _Pragma("unroll") for (int k = 0; k < 2; ++k) dst[m][k] = *(const PG8_LAS bf16x8*)(lds + PG8_SA(b, h) + aoff + m * 2048 + k * 1024); } } while (0)
#define PG8_LDB(dst, b, h) do { if constexpr (FP8) { _Pragma("unroll") for (int n = 0; n < 2; ++n) { const v4i_t l_ = *(const PG8_LAS v4i_t*)(lds + PG8_SB(b, h) + boff + n * 2048), h_ = *(const PG8_LAS v4i_t*)(lds + PG8_SB(b, h) + boff + n * 2048 + 1024); dst##8[n] = __builtin_shufflevector(l_, h_, 0, 1, 2, 3, 4, 5, 6, 7); } } else { _Pragma("unroll") for (int n = 0; n < 2; ++n) _Pragma("unroll") for (int k = 0; k < 2; ++k) dst[n][k] = *(const PG8_LAS bf16x8*)(lds + PG8_SB(b, h) + boff + n * 2048 + k * 1024); } } while (0)
#define PG8_MMA(ai, bj, At, Bt) do { __builtin_amdgcn_s_setprio(1); if constexpr (FP8) { _Pragma("unroll") for (int m = 0; m < 4; ++m) _Pragma("unroll") for (int n = 0; n < 2; ++n) \
        asm volatile("v_mfma_f32_16x16x128_f8f6f4 %0, %1, %2, %0" : "+v"(acc[ai][bj][m][n]) : "v"(Bt##8[n]), "v"(At##8[m])); } else { \
        _Pragma("unroll") for (int m = 0; m < 4; ++m) _Pragma("unroll") for (int n = 0; n < 2; ++n) _Pragma("unroll") for (int k = 0; k < 2; ++k) \
        acc[ai][bj][m][n] = __builtin_amdgcn_mfma_f32_16x16x32_bf16(Bt[n][k], At[m][k], acc[ai][bj][m][n], 0, 0, 0); } __builtin_amdgcn_s_setprio(0); } while (0)
#define PG8_WAIT_V(n) asm volatile("s_waitcnt vmcnt(" #n ")" ::: "memory")
#define PG8_WAIT_L(n) asm volatile("s_waitcnt lgkmcnt(" #n ")" ::: "memory")
#define PG8_BAR __builtin_amdgcn_s_barrier()
#define PG8_SCHED __builtin_amdgcn_sched_barrier(0)
    Unit cur, nxt; int ui = 0;
    if (!S.next(0, cur)) return;
    f32x4 acc[2][2][4][2];
#pragma unroll
    for (int a = 0; a < 2; ++a)
#pragma unroll
        for (int b = 0; b < 2; ++b)
#pragma unroll
            for (int m = 0; m < 4; ++m)
#pragma unroll
                for (int n = 0; n < 2; ++n) acc[a][b][m][n] = (f32x4){0.f, 0.f, 0.f, 0.f};
    typedef int v8i_t __attribute__((ext_vector_type(8))); typedef int v4i_t __attribute__((ext_vector_type(4)));
    bf16x8 At[4][2], B0[2][2], B1[2][2]; v8i_t At8[4], B08[2], B18[2];
    const __amdgpu_buffer_rsrc_t srd_voffA = __builtin_amdgcn_make_buffer_rsrc((void*)g.A, 0, 0x7ffffff0, 0x00020000), srd_voffB = __builtin_amdgcn_make_buffer_rsrc((void*)g.Bt, 0, 0x7ffffff0, 0x00020000);
    unsigned cA = GATHER ? 0u : (unsigned)cur.pm * tstep, cB = (unsigned)cur.pn * tstep;
    const unsigned hstepA = GATHER ? 0u : hstep;
    unsigned ca_[2][2] = {{0u, 0u}, {0u, 0u}}, na_[2][2] = {{0u, 0u}, {0u, 0u}}, va2_[2][2] = {{0u, 0u}, {0u, 0u}};
    int gR_ = 0, gC2_ = 0;
    if constexpr (GATHER) { int R, C; stage_rc(tid * 16, R, C); gR_ = R; gC2_ = C * 2;
#pragma unroll
        for (int h = 0; h < 2; ++h)
#pragma unroll
            for (int i = 0; i < 2; ++i) ca_[h][i] = (unsigned)rowtab[128 * h + 64 * i + R] + (unsigned)gC2_; }
    S.a_ready(cur);
    if constexpr (SP2) {
        PG8_STAGE(PG8_SB(0, 0), cB, voffB); PG8_STAGE(PG8_SB(0, 1), cB + hstep, voffB); PG8_STAGE_A(PG8_SA(0, 0), cA, ca_); PG8_STAGE_A(PG8_SA(0, 1), cA + hstepA, ca_);
        if (wr == 1) PG8_BAR;
        PG8_WAIT_V(2); PG8_BAR;
        PG8_STAGE(PG8_SB(1, 0), cB + kstep, voffB); PG8_STAGE_A(PG8_SA(1, 0), cA + kstep, ca_); PG8_STAGE(PG8_SB(1, 1), cB + hstep + kstep, voffB);
        PG8_WAIT_V(6); PG8_BAR;
    } else {
        PG8_STAGE(PG8_SB(0, 0), cB, voffB); PG8_STAGE_A(PG8_SA(0, 0), cA, ca_); PG8_STAGE(PG8_SB(0, 1), cB + hstep, voffB); PG8_STAGE_A(PG8_SA(0, 1), cA + hstepA, ca_);
        if (wr == 1) PG8_BAR;
        PG8_WAIT_V(4); PG8_BAR;
        PG8_STAGE(PG8_SB(1, 0), cB + kstep, voffB); PG8_STAGE_A(PG8_SA(1, 0), cA + kstep, ca_); PG8_STAGE(PG8_SB(1, 1), cB + hstep + kstep, voffB);
        PG8_WAIT_V(6); PG8_BAR;
    }
    for (;;) {
        const bool has_next = S.next(ui + 1, nxt);
        const unsigned nA = GATHER ? 0u : (has_next ? (unsigned)nxt.pm * tstep : cA); const unsigned nB = has_next ? (unsigned)nxt.pn * tstep : cB;
        if constexpr (GATHER) {
#pragma unroll
            for (int h = 0; h < 2; ++h)
#pragma unroll
                for (int i = 0; i < 2; ++i) na_[h][i] = has_next ? (unsigned)rowtab[(ui + 1) * 256 + 128 * h + 64 * i + gR_] + (unsigned)gC2_ : ca_[h][i]; }
#pragma nounroll
        for (int t = 0; t < nt; t += 2) {
            const bool last = (t == nt - 2);
            const unsigned a1 = cA + (unsigned)(t + 1) * kstep;
            const unsigned a2 = last ? nA : cA + (unsigned)(t + 2) * kstep; const unsigned b2 = last ? nB : cB + (unsigned)(t + 2) * kstep;
            const unsigned a3 = a2 + kstep; const unsigned b3 = b2 + kstep;
            if constexpr (GATHER) {
#pragma unroll
                for (int h = 0; h < 2; ++h)
#pragma unroll
                    for (int i = 0; i < 2; ++i) va2_[h][i] = last ? na_[h][i] : ca_[h][i]; }
            if (last && has_next) S.a_ready(nxt);
            if constexpr (SP2) {
            PG8_LDB(B0, 0, 0); PG8_LDB(B1, 0, 1); PG8_SCHED; PG8_LDA(At, 0, 0); PG8_STAGE_A(PG8_SA(1, 1), a1 + hstepA, ca_);
            PG8_WAIT_V(8); PG8_WAIT_L(0); PG8_BAR; PG8_MMA(0, 0, At, B0); PG8_MMA(0, 1, At, B1); PG8_BAR; PG8_SCHED;
            PG8_LDA(At, 0, 1); PG8_STAGE(PG8_SB(0, 0), b2, voffB); PG8_STAGE(PG8_SB(0, 1), b2 + hstep, voffB); PG8_STAGE_A(PG8_SA(0, 0), a2, va2_);
            PG8_WAIT_V(8); PG8_WAIT_L(0); PG8_BAR; PG8_MMA(1, 0, At, B0); PG8_MMA(1, 1, At, B1); PG8_BAR; PG8_SCHED;
            PG8_LDB(B0, 1, 0); PG8_LDB(B1, 1, 1); PG8_SCHED; PG8_LDA(At, 1, 0); PG8_STAGE_A(PG8_SA(0, 1), a2 + hstepA, va2_);
            PG8_WAIT_V(8); PG8_WAIT_L(0); PG8_BAR; PG8_MMA(0, 0, At, B0); PG8_MMA(0, 1, At, B1); PG8_BAR; PG8_SCHED;
            PG8_LDA(At, 1, 1); PG8_STAGE(PG8_SB(1, 0), b3, voffB); PG8_STAGE(PG8_SB(1, 1), b3 + hstep, voffB); PG8_STAGE_A(PG8_SA(1, 0), a3, va2_);
            PG8_WAIT_V(8); PG8_WAIT_L(0); PG8_BAR; PG8_MMA(1, 0, At, B0); PG8_MMA(1, 1, At, B1); PG8_BAR; PG8_SCHED;
            } else {
            PG8_LDB(B0, 0, 0); PG8_SCHED; PG8_LDA(At, 0, 0); PG8_STAGE_A(PG8_SA(1, 1), a1 + hstepA, ca_);
            PG8_WAIT_L(8); PG8_BAR; PG8_WAIT_L(0); PG8_MMA(0, 0, At, B0); PG8_BAR; PG8_SCHED;
            PG8_LDB(B1, 0, 1); PG8_STAGE(PG8_SB(0, 0), b2, voffB);
            PG8_BAR; PG8_WAIT_L(0); PG8_MMA(0, 1, At, B1); PG8_BAR;
            PG8_LDA(At, 0, 1); PG8_STAGE_A(PG8_SA(0, 0), a2, va2_);
            PG8_BAR; PG8_WAIT_L(0); PG8_MMA(1, 0, At, B0); PG8_BAR; PG8_SCHED;
            PG8_STAGE(PG8_SB(0, 1), b2 + hstep, voffB);
            PG8_WAIT_V(6); PG8_BAR; PG8_MMA(1, 1, At, B1); PG8_BAR;
            PG8_LDB(B0, 1, 0); PG8_SCHED; PG8_LDA(At, 1, 0); PG8_STAGE_A(PG8_SA(0, 1), a2 + hstepA, va2_);
            PG8_WAIT_L(8); PG8_BAR; PG8_WAIT_L(0); PG8_MMA(0, 0, At, B0); PG8_BAR; PG8_SCHED;
            PG8_LDB(B1, 1, 1); PG8_STAGE(PG8_SB(1, 0), b3, voffB);
            PG8_BAR; PG8_WAIT_L(0); PG8_MMA(0, 1, At, B1); PG8_BAR;
            PG8_LDA(At, 1, 1); PG8_STAGE_A(PG8_SA(1, 0), a3, va2_);
            PG8_BAR; PG8_WAIT_L(0); PG8_MMA(1, 0, At, B0); PG8_BAR; PG8_SCHED;
            PG8_STAGE(PG8_SB(1, 1), b3 + hstep, voffB);
            PG8_WAIT_V(6); PG8_BAR; PG8_MMA(1, 1, At, B1); PG8_BAR;
            }
        }
        if constexpr (ALIGN_EPI) { if (wr == 0) PG8_BAR; }
        if constexpr (FP8) asm volatile("s_nop 15\n\ts_nop 15" ::: "memory");
        if constexpr (!Epi::AFTER_DRAIN) { E(acc, cur, wr, wc, fr, fq); S.done(cur); }
        if (!has_next) break;
#pragma unroll
        for (int a = 0; a < 2; ++a)
#pragma unroll
            for (int b = 0; b < 2; ++b)
#pragma unroll
                for (int m = 0; m < 4; ++m)
#pragma unroll
                    for (int n = 0; n < 2; ++n) acc[a][b][m][n] = (f32x4){0.f, 0.f, 0.f, 0.f};
        cur = nxt; cA = nA; cB = nB; ++ui;
        if constexpr (GATHER) {
#pragma unroll
            for (int h = 0; h < 2; ++h)
#pragma unroll
                for (int i = 0; i < 2; ++i) ca_[h][i] = na_[h][i]; }
        if constexpr (ALIGN_EPI) { if (wr == 1) PG8_BAR; }
    }
    PG8_WAIT_V(0);
    if constexpr (!ALIGN_EPI) { if (wr == 0) PG8_BAR; }
    PG8_BAR;
    if constexpr (Epi::AFTER_DRAIN) { E.fused(acc, cur, wr, wc, fr, fq, lds, wid, lane); S.done(cur); }
#undef PG8_SA
#undef PG8_SB
#undef PG8_STAGE
#undef PG8_LDA
#undef PG8_LDB
#undef PG8_MMA
#undef PG8_WAIT_V
#undef PG8_WAIT_L
#undef PG8_BAR
#undef PG8_SCHED
}
}

namespace pg8 {
struct EpiResGate {
    static constexpr bool PERM = false, AFTER_DRAIN = false;
    const float* base; unsigned short* out; int ldc; const float* gate; int gate_bstride; int rows_per_batch;
    __device__ __forceinline__ void operator()(const f32x4 (&acc)[2][2][4][2], const Unit& u, int wr, int wc, int fr, int fq) const {
        const int b = (u.pm * BM) / rows_per_batch;
        const int col0 = u.pn * BM + wc * 32 + 4 * fq;
        f32x4 gv[2][2];
#pragma unroll
        for (int bj = 0; bj < 2; ++bj)
#pragma unroll
            for (int n = 0; n < 2; ++n) gv[bj][n] = *(const f32x4*)(gate + (size_t)b * gate_bstride + col0 + bj * HALF + n * 16);
#pragma unroll
        for (int ai = 0; ai < 2; ++ai)
#pragma unroll
            for (int mp = 0; mp < 2; ++mp) {
                f32x4 bs[2][2][2];
#pragma unroll
                for (int mm = 0; mm < 2; ++mm) { const int m = 2 * mp + mm; const size_t off = (size_t)(u.pm * BM + ai * HALF + wr * 64 + m * 16 + fr) * ldc + col0;
#pragma unroll
                    for (int bj = 0; bj < 2; ++bj)
#pragma unroll
                        for (int n = 0; n < 2; ++n) bs[mm][bj][n] = *(const f32x4*)(base + off + bj * HALF + n * 16); }
                asm volatile("s_waitcnt vmcnt(0)" ::: "memory");
#pragma unroll
                for (int mm = 0; mm < 2; ++mm) { const int m = 2 * mp + mm; const size_t off = (size_t)(u.pm * BM + ai * HALF + wr * 64 + m * 16 + fr) * ldc + col0;
#pragma unroll
                    for (int bj = 0; bj < 2; ++bj)
#pragma unroll
                        for (int n = 0; n < 2; ++n) { const f32x4 r = bs[mm][bj][n] + gv[bj][n] * acc[ai][bj][m][n]; typedef unsigned u32x2_ __attribute__((ext_vector_type(2)));
                            u32x2_ w; w.x = cvt_pk_bf16(r[0], r[1]); w.y = cvt_pk_bf16(r[2], r[3]); *(u32x2_*)(out + off + bj * HALF + n * 16) = w; } }
                asm volatile("" ::: "memory");
            }
    }
};
__device__ __forceinline__ unsigned pk4_fp8(float a, float b, float c, float d) {
    a = __builtin_fminf(__builtin_fmaxf(a, -448.f), 448.f); b = __builtin_fminf(__builtin_fmaxf(b, -448.f), 448.f); c = __builtin_fminf(__builtin_fmaxf(c, -448.f), 448.f); d = __builtin_fminf(__builtin_fmaxf(d, -448.f), 448.f);
    int w = 0; w = __builtin_amdgcn_cvt_pk_fp8_f32(a, b, w, false); w = __builtin_amdgcn_cvt_pk_fp8_f32(c, d, w, true); return (unsigned)w; }
__device__ __forceinline__ unsigned pk4_fp8_nc(float a, float b, float c, float d) {
    int w = 0; w = __builtin_amdgcn_cvt_pk_fp8_f32(a, b, w, false); w = __builtin_amdgcn_cvt_pk_fp8_f32(c, d, w, true); return (unsigned)w; }
struct EpiSwiglu {
    static constexpr bool PERM = true, AFTER_DRAIN = false;
    unsigned char* O; const float* bgu; float asc, osc;
    __device__ __forceinline__ float act1(float g, float u) const {
        g = __builtin_fminf(g, 7.0f); u = __builtin_fminf(__builtin_fmaxf(u, -7.0f), 7.0f);
        const float s = __builtin_amdgcn_rcpf(1.0f + __builtin_amdgcn_exp2f(g * (-1.702f * 1.4426950408889634f)));
        return (u + 1.0f) * (g * s) * osc;
    }
    __device__ __forceinline__ void operator()(const f32x4 (&acc)[2][2][4][2], const Unit& u, int wr, int wc, int fr, int fq) const {
        const int e = u.pn >> 3, pnl = u.pn & 7;
        const int row0 = u.pm * BM + wr * 64 + fr;
        const int ocol0 = pnl * 128 + wc * 32 + 8 * fq;
        f32x4 bg[2], bu[2];
#pragma unroll
        for (int n = 0; n < 2; ++n) { bg[n] = *(const f32x4*)(bgu + (size_t)e * 2048 + ocol0 + 4 * n); bu[n] = *(const f32x4*)(bgu + (size_t)e * 2048 + 1024 + ocol0 + 4 * n); }
#pragma unroll
        for (int ai = 0; ai < 2; ++ai)
#pragma unroll
            for (int m = 0; m < 4; ++m) { unsigned char* rowp = O + (size_t)(row0 + ai * HALF + m * 16) * 1024 + ocol0;
                const f32x4 g0 = acc[ai][0][m][0] * asc + bg[0], g1 = acc[ai][0][m][1] * asc + bg[1], u0 = acc[ai][1][m][0] * asc + bu[0], u1 = acc[ai][1][m][1] * asc + bu[1];
                typedef unsigned u32x2 __attribute__((ext_vector_type(2)));
                u32x2 w; w.x = pk4_fp8_nc(act1(g0[0], u0[0]), act1(g0[1], u0[1]), act1(g0[2], u0[2]), act1(g0[3], u0[3]));
                w.y = pk4_fp8_nc(act1(g1[0], u1[0]), act1(g1[1], u1[1]), act1(g1[2], u1[2]), act1(g1[3], u1[3]));
                *(u32x2*)rowp = w; asm volatile("" ::: "memory"); }
    }
};
struct EpiDown {
    static constexpr bool PERM = true, AFTER_DRAIN = false;
    bf16_t* O; const float* bias; float asc;
    __device__ __forceinline__ void operator()(const f32x4 (&acc)[2][2][4][2], const Unit& u, int wr, int wc, int fr, int fq) const {
        const int row0 = u.pm * BM + wr * 64 + fr; const int pnl = u.pn & 3;
        const int col0 = pnl * BM + wc * 32 + 8 * fq, bcol0 = u.pn * BM + wc * 32 + 8 * fq;
        f32x4 bv[2][2];
#pragma unroll
        for (int bj = 0; bj < 2; ++bj)
#pragma unroll
            for (int n = 0; n < 2; ++n) bv[bj][n] = *(const f32x4*)(bias + bcol0 + bj * HALF + 4 * n);
#pragma unroll
        for (int ai = 0; ai < 2; ++ai)
#pragma unroll
            for (int m = 0; m < 4; ++m) { bf16_t* rowp = O + (size_t)(row0 + ai * HALF + m * 16) * 1024 + col0;
#pragma unroll
                for (int bj = 0; bj < 2; ++bj) { const f32x4 v0 = acc[ai][bj][m][0] * asc + bv[bj][0], v1 = acc[ai][bj][m][1] * asc + bv[bj][1];
                    u32x4 w; w.x = cvt_pk_bf16(v0[0], v0[1]); w.y = cvt_pk_bf16(v0[2], v0[3]); w.z = cvt_pk_bf16(v1[0], v1[1]); w.w = cvt_pk_bf16(v1[2], v1[3]);
                    *(u32x4*)(rowp + bj * HALF) = w; } }
    }
};
#ifndef GROUPED_WGM
#define GROUPED_WGM 16
#endif
struct GroupedOrder {
    const int* tile_e; int nM, nNl, nwg, G, c;
    __device__ void init(const int* te, int ntm, int nNl_, int G_, int c_) { tile_e = te; nM = ntm; nNl = nNl_; nwg = ntm * nNl_; G = G_; c = c_; }
    __device__ bool next(int i, Unit& u) const {
        const long L = (long)i * G + c; if (L >= nwg) return false;
        int wgid = (int)L; { const int q = nwg / NXCD, r = nwg % NXCD, xcd = wgid % NXCD, off = wgid / NXCD; wgid = (xcd < r ? xcd * (q + 1) : r * (q + 1) + (xcd - r) * q) + off; }
        constexpr int WG = GROUPED_WGM; const int nig = WG * nNl, gid = wgid / nig, fm = gid * WG, gsz = (nM - fm) < WG ? (nM - fm) : WG;
        u.pm = fm + ((wgid % nig) % gsz); const int pl = (wgid % nig) / gsz;
        u.pn = __builtin_amdgcn_readfirstlane(tile_e[u.pm]) * nNl + pl; return true;
    }
    __device__ __forceinline__ void a_ready(const Unit&) const {}
    __device__ __forceinline__ void done(const Unit&) const {}
};
}

constexpr int NWAVES = 8;
constexpr int NB = 4, SEQ = 4096, DM = 1024, TT = NB * SEQ, DH = 512, NHEAD = 8, HD = 64, NEXP = 32, TOPK = 4, INCOLS = 2560, NMOD = 6 * DM, DE2 = 2048;
constexpr float NORM_EPS = 1e-6f;
constexpr float C2 = 0.125f * 1.4426950408889634f;
constexpr float SC_H = 16.0f, SC_W = 512.0f, SC_ACT = 4.0f;
constexpr int MAXSLOT = TT * TOPK + NEXP * 256, MAXTILE = MAXSLOT / 256;
#ifndef MK_N_LAUNCHES
#define MK_N_LAUNCHES 1
#endif
constexpr int PER_PHASE = 11;
constexpr int N_LAUNCHES = MK_N_LAUNCHES;

constexpr size_t MiB = 1u << 20;
constexpr size_t WS_CTL = 0, CTL_ZERO_BYTES = 1 * MiB;
constexpr size_t WS_MISC = 1 * MiB;
constexpr size_t WS_WRT = 2 * MiB;
constexpr size_t WS_WIN = 3 * MiB, WS_WOUT = 8 * MiB, WS_WGU = 16 * MiB, WS_WD = 144 * MiB;
constexpr size_t WS_XN = 208 * MiB, WS_QKV = 240 * MiB, WS_OP = 320 * MiB, WS_LSE = 368 * MiB, WS_MIX = 370 * MiB, WS_X1 = 402 * MiB;
constexpr size_t WS_ROUTE = 466 * MiB;
constexpr size_t WS_XG = 468 * MiB, WS_ACT = 612 * MiB, WS_MODP = 756 * MiB, WS_END = 758 * MiB;
constexpr int CW_TMO = 0, CW_CODE = 1, CW_BAR = 4096, CW_CNT = 8192, CW_RFLAG = 12288, CW_MOD = 16384, CW_RX = 65536;
static_assert((size_t)CW_RX * 4 + (size_t)NB * 8 * 16 * 64 * 8 <= CTL_ZERO_BYTES, "ctl rx");
static_assert((CW_MOD + NB * NMOD) * 4 <= (int)CTL_ZERO_BYTES, "ctl");
constexpr int RING_OFF = 0, RING_BYTES = 131072, LDSCTL_OFF = RING_BYTES, MISC_OFF = LDSCTL_OFF + 320, SUMM_OFF = RING_BYTES + 1024, TILE_OFF = SUMM_OFF + 4096, ROWTAB_OFF = TILE_OFF + 1024, ROWTAB_UNITS = 9, LDS_BYTES = 147456;
static_assert(ROWTAB_OFF + ROWTAB_UNITS * 1024 <= LDS_BYTES && (MAXTILE * 8 + 255) / 256 <= ROWTAB_UNITS, "lds");
#define GAS __attribute__((address_space(1)))
#define LAS __attribute__((address_space(3)))
typedef unsigned short bf16;
typedef unsigned v4u __attribute__((ext_vector_type(4)));
typedef float f32x4 __attribute__((ext_vector_type(4)));
typedef short bf16x8 __attribute__((ext_vector_type(8)));
typedef GAS unsigned gu32;
typedef GAS unsigned long long gu64;
#define RLX_AGENT __ATOMIC_RELAXED, __HIP_MEMORY_SCOPE_AGENT
#define LDS_WAIT() asm volatile("s_waitcnt lgkmcnt(0)" ::: "memory")
#define VM_WAIT() asm volatile("s_waitcnt vmcnt(0)" ::: "memory")
__device__ __forceinline__ unsigned long long rt() { return __builtin_amdgcn_s_memrealtime(); }
__device__ __forceinline__ unsigned f2bf(float f) { unsigned u = __builtin_bit_cast(unsigned, f); return (u + 0x7fffu + ((u >> 16) & 1u)) >> 16; }
__device__ __forceinline__ unsigned pk2(float lo, float hi) { return f2bf(lo) | (f2bf(hi) << 16); }

#define XB_TMO      128
#define XB_XCNT(j)  (256  + 64 * (j))
#define XB_XSUB(j)  (1280 + 64 * (j))
#define XB_XGEN(j)  (2304 + 64 * (j))
#define XB_TOP      3328
#define XB_TOPGEN   3392
#define XCD_BAR_WORDS 3456
#define XB_SPIN_CAP (1u << 18)

__device__ __forceinline__ unsigned xb_ld(unsigned* p)              { return __hip_atomic_load(p, __ATOMIC_RELAXED, __HIP_MEMORY_SCOPE_AGENT); }
__device__ __forceinline__ unsigned xb_add(unsigned* p, unsigned v) { return __hip_atomic_fetch_add(p, v, __ATOMIC_RELAXED, __HIP_MEMORY_SCOPE_AGENT); }
__device__ __forceinline__ unsigned xb_xcc_id() { return (unsigned)__builtin_amdgcn_s_getreg((3 << 11) | 20) & 0xFu; }
#define XB_SPIN(cond, bar) do { unsigned _sp = 0; while (cond) { __builtin_amdgcn_s_sleep(1); \
    if ((++_sp & 255u) == 0u) { if (xb_ld(&(bar)[XB_TMO])) break; if (_sp > XB_SPIN_CAP) { atomicAdd(&(bar)[XB_TMO], 1u); break; } } } } while (0)

struct XcdBarrier {
    unsigned* bar; unsigned x;
    volatile LAS unsigned* st;
};

__device__ __forceinline__ XcdBarrier xcd_barrier_post(unsigned* bar, volatile LAS unsigned* st) {
    XcdBarrier b; b.bar = bar; b.x = xb_xcc_id(); b.st = st;
    if (threadIdx.x == 0) (void)xb_add(&bar[XB_XCNT(b.x)], 1u);
    return b;
}
__device__ __forceinline__ void xcd_barrier_complete(unsigned* bar, unsigned x, unsigned& nloc, unsigned& nx) {
    const unsigned G = gridDim.x * gridDim.y * gridDim.z;
    unsigned sum, cnt, mine, sp = 0u;
    for (;;) {
        sum = 0u; cnt = 0u; mine = 0u;
#pragma unroll
        for (unsigned j = 0; j < 16; ++j) { const unsigned c = xb_ld(&bar[XB_XCNT(j)]); sum += c; cnt += (c > 0u) ? 1u : 0u; mine = (j == x) ? c : mine; }
        if (sum == G) break;
        __builtin_amdgcn_s_sleep(1);
        if ((++sp & 255u) == 0u) { if (xb_ld(&bar[XB_TMO])) break; if (sp > XB_SPIN_CAP) { atomicAdd(&bar[XB_TMO], 1u); break; } }
    }
    nloc = mine > 0u ? mine : 1u; nx = cnt > 0u ? cnt : 1u;
}

__device__ __forceinline__ void xcd_barrier(const XcdBarrier& b) {
    asm volatile("s_waitcnt vmcnt(0)" ::: "memory");
    __syncthreads();
    if (threadIdx.x == 0) {
        unsigned* bar = b.bar;
        __builtin_amdgcn_s_waitcnt(0);
        unsigned nloc = b.st[0], nx = b.st[1];
        if (nloc == 0u) { xcd_barrier_complete(bar, b.x, nloc, nx); b.st[0] = nloc; b.st[1] = nx; }
        const unsigned old = xb_add(&bar[XB_XSUB(b.x)], 1u);
        const unsigned gen = old / nloc;
        if (old + 1u == (gen + 1u) * nloc) {
            __builtin_amdgcn_fence(__ATOMIC_RELEASE, "agent");
            asm volatile("s_waitcnt vmcnt(0)" ::: "memory");
            const unsigned og = xb_add(&bar[XB_TOP], 1u);
            const unsigned tg = og / nx;
            if (og + 1u == (tg + 1u) * nx) xb_add(&bar[XB_TOPGEN], 1u);
            else XB_SPIN(xb_ld(&bar[XB_TOPGEN]) == tg, bar);
            __builtin_amdgcn_fence(__ATOMIC_ACQUIRE, "agent");
            xb_add(&bar[XB_XGEN(b.x)], 1u);
            asm volatile("s_waitcnt vmcnt(0)" ::: "memory");
        } else {
            XB_SPIN(xb_ld(&bar[XB_XGEN(b.x)]) == gen, bar);
            __builtin_amdgcn_fence(__ATOMIC_ACQUIRE, "agent");
            asm volatile("s_waitcnt vmcnt(0)" ::: "memory");
        }
    }
    __syncthreads();
}

typedef float f32x16 __attribute__((ext_vector_type(16)));
typedef short v4i16_t __attribute__((ext_vector_type(4)));
typedef unsigned v2u __attribute__((ext_vector_type(2)));
struct Frame {
    LAS unsigned char* lds;
    int tid, lane, wave, vcu, G;
    unsigned char* ws;
    const __attribute__((address_space(4))) void* ka;
    __device__ __forceinline__ const float* in(int k) const {
        const unsigned long long v = *(const volatile __attribute__((address_space(4))) unsigned long long*)((const __attribute__((address_space(4))) char*)ka + 8 * k);
        const unsigned lo = (unsigned)__builtin_amdgcn_readfirstlane((int)(unsigned)v), hi = (unsigned)__builtin_amdgcn_readfirstlane((int)(unsigned)(v >> 32));
        return (const float*)(const GAS float*)(((unsigned long long)hi << 32) | lo);
    }
};
enum InIdx { I_x = 0, I_c, I_w_ada, I_b_ada, I_g_mix, I_w_in, I_conv_w, I_conv_b, I_w_rg_a, I_b_rg_a, I_w_rg_x, I_b_rg_x, I_lam, I_w_out, I_g_ffn, I_w_router, I_b_router, I_w_gate_up, I_b_gate_up, I_w_down, I_b_down, I_g_final };
#define WSP(T, off) ((T*)(F.ws + (off)))
#define P_MOD   (WSP(float, WS_CTL) + CW_MOD)
#define P_BCNT  WSP(int, WS_MISC + 8192)
#define P_TILE_E WSP(int, WS_MISC)
#define P_TILE_N WSP(int, WS_MISC + 4096)
#define P_RSUM  WSP(float, WS_MISC + 65536)
#define P_WRT   WSP(float, WS_WRT)
#define P_WA_T  WSP(bf16, WS_WRT + 262144)
#define P_WX_T  WSP(bf16, WS_WRT + 393216)
#define P_WIN_T WSP(bf16, WS_WIN)
#define P_WOUT_T WSP(bf16, WS_WOUT)
#define P_WGU8 WSP(unsigned char, WS_WGU)
#define P_WD8  WSP(unsigned char, WS_WD)
#define P_XN    WSP(bf16, WS_XN)
#define P_QB    WSP(bf16, WS_QKV)
#define P_KB    (WSP(bf16, WS_QKV) + (size_t)TT * DH)
#define P_VB    (WSP(bf16, WS_QKV) + (size_t)2 * TT * DH)
#define P_XR    (WSP(bf16, WS_QKV) + (size_t)3 * TT * DH)
#define P_GR    (WSP(bf16, WS_QKV) + (size_t)4 * TT * DH)
#define P_OP    WSP(bf16, WS_OP)
#define P_LSE   WSP(float, WS_LSE)
#define P_MIX   WSP(bf16, WS_MIX)
#define P_X1    WSP(bf16, WS_X1)
#define P_TOK_E WSP(int, WS_ROUTE)
#define P_TOK_POS (WSP(int, WS_ROUTE) + TT * TOPK)
#define P_TOK_GATE (WSP(float, WS_ROUTE) + 2 * TT * TOPK)
#define P_TOK_SLOT (WSP(int, WS_ROUTE) + 3 * TT * TOPK)
#define P_SLOT_TOK (WSP(int, WS_ROUTE + 1048576))
#define P_Y2    WSP(bf16, WS_XG)
#define P_XN8   WSP(unsigned char, WS_XN)
#define P_ACT8  WSP(unsigned char, WS_ACT)
__device__ __forceinline__ float bf2f(unsigned short v) { return __uint_as_float(((unsigned)v) << 16); }
template <int N> __device__ __forceinline__ float dpp_ror(float v) { return __builtin_bit_cast(float, __builtin_amdgcn_update_dpp(0, __builtin_bit_cast(int, v), 0x120 + N, 0xf, 0xf, false)); }
__device__ __forceinline__ float row_sum16(float v) { v += dpp_ror<8>(v); v += dpp_ror<4>(v); v += dpp_ror<2>(v); v += dpp_ror<1>(v); return v; }
__device__ __forceinline__ float row_max16(float v) { v = fmaxf(v, dpp_ror<8>(v)); v = fmaxf(v, dpp_ror<4>(v)); v = fmaxf(v, dpp_ror<2>(v)); v = fmaxf(v, dpp_ror<1>(v)); return v; }
__device__ __forceinline__ float wave_sum(float v) {
    v = row_sum16(v);
    const float s0 = __builtin_bit_cast(float, __builtin_amdgcn_readlane(__builtin_bit_cast(int, v), 0)), s1 = __builtin_bit_cast(float, __builtin_amdgcn_readlane(__builtin_bit_cast(int, v), 16)),
                s2 = __builtin_bit_cast(float, __builtin_amdgcn_readlane(__builtin_bit_cast(int, v), 32)), s3 = __builtin_bit_cast(float, __builtin_amdgcn_readlane(__builtin_bit_cast(int, v), 48));
    return ((s0 + s1) + s2) + s3;
}
__device__ __forceinline__ float wave_max(float v) {
#pragma unroll
    for (int o = 1; o < 64; o <<= 1) v = fmaxf(v, __shfl_xor(v, o));
    return v;
}
__device__ __forceinline__ int crow(int r, int hi) { return (r & 3) + 8 * (r >> 2) + 4 * hi; }

__device__ __forceinline__ void p0_transpose_item(const float* W, int K, int N, bf16* WT, int k0, int n0, int drow0, LAS float* scr, int lane) {
#pragma unroll 8
    for (int i = 0; i < 32; ++i) { const int kk = 2 * i + (lane >> 5); scr[kk * 33 + (lane & 31)] = W[(size_t)(k0 + kk) * N + n0 + (lane & 31)]; }
    LDS_WAIT(); asm volatile("" ::: "memory");
    const int c = lane & 7;
#pragma unroll
    for (int j = 0; j < 4; ++j) { const int n = (lane >> 3) + 8 * j; const LAS float* s = scr + (8 * c) * 33 + n;
        v4u o; o.x = pk2(s[0 * 33], s[1 * 33]); o.y = pk2(s[2 * 33], s[3 * 33]); o.z = pk2(s[4 * 33], s[5 * 33]); o.w = pk2(s[6 * 33], s[7 * 33]);
        *(GAS v4u*)(WT + (size_t)(drow0 + n) * K + k0 + 8 * c) = o; }
    LDS_WAIT(); asm volatile("" ::: "memory");
}
__device__ __forceinline__ void p0_transpose_item8(const float* W, int K, int N, unsigned char* WT, int k0, int n0, int drow0, float sc, LAS float* scr, int lane) {
#pragma unroll 8
    for (int i = 0; i < 32; ++i) { const int kk = 2 * i + (lane >> 5); scr[kk * 33 + (lane & 31)] = W[(size_t)(k0 + kk) * N + n0 + (lane & 31)]; }
    LDS_WAIT(); asm volatile("" ::: "memory");
    const int c = lane & 7;
#pragma unroll
    for (int j = 0; j < 4; ++j) { const int n = (lane >> 3) + 8 * j; const LAS float* s = scr + (8 * c) * 33 + n;
        v2u o; o.x = pg8::pk4_fp8(s[0 * 33] * sc, s[1 * 33] * sc, s[2 * 33] * sc, s[3 * 33] * sc); o.y = pg8::pk4_fp8(s[4 * 33] * sc, s[5 * 33] * sc, s[6 * 33] * sc, s[7 * 33] * sc);
        *(GAS v2u*)(WT + (size_t)(drow0 + n) * K + k0 + 8 * c) = o; }
    LDS_WAIT(); asm volatile("" ::: "memory");
}
struct TDesc { const float* src; unsigned char* dst; int N, K, k0, n0, drow0, fp8; };
__device__ __forceinline__ void p0_dma_issue(const TDesc& d, LAS unsigned char* buf, int lane) {
    const __amdgpu_buffer_rsrc_t rs = __builtin_amdgcn_make_buffer_rsrc((void*)d.src, 0, 0x7ffffff0, 0x00020000);
#pragma unroll
    for (int j = 0; j < 16; ++j) { const int voff = ((lane >> 3) * d.N + 4 * ((lane & 7) ^ (j & 7))) * 4, soff = ((d.k0 + 8 * j) * d.N + d.n0) * 4;
        __builtin_amdgcn_raw_ptr_buffer_load_lds(rs, (LAS unsigned*)(buf + j * 1024), 16, voff, soff, 0, 0); }
}
__device__ __forceinline__ void p0_read(LAS unsigned char* buf, int lane, f32x4 (&f)[2][8]) {
    const int c = lane & 15;
#pragma unroll
    for (int jj = 0; jj < 2; ++jj) { const int nq = (lane >> 4) + 4 * jj; const LAS unsigned char* s = buf + (8 * c) * 128 + ((nq ^ (c & 7)) * 16);
#pragma unroll
        for (int i = 0; i < 8; ++i) f[jj][i] = *(const LAS f32x4*)(s + i * 128); }
}
__device__ __forceinline__ void p0_emit(const TDesc& d, int lane, const f32x4 (&f)[2][8]) {
    const int c = lane & 15;
#pragma unroll
    for (int jj = 0; jj < 2; ++jj)
#pragma unroll
        for (int t = 0; t < 4; ++t) { const int n = 4 * ((lane >> 4) + 4 * jj) + t;
            if (d.fp8) { v2u o; o.x = pg8::pk4_fp8(f[jj][0][t] * SC_W, f[jj][1][t] * SC_W, f[jj][2][t] * SC_W, f[jj][3][t] * SC_W); o.y = pg8::pk4_fp8(f[jj][4][t] * SC_W, f[jj][5][t] * SC_W, f[jj][6][t] * SC_W, f[jj][7][t] * SC_W);
                *(GAS v2u*)(d.dst + (size_t)(d.drow0 + n) * d.K + d.k0 + 8 * c) = o; }
            else { v4u o; o.x = pk2(f[jj][0][t], f[jj][1][t]); o.y = pk2(f[jj][2][t], f[jj][3][t]); o.z = pk2(f[jj][4][t], f[jj][5][t]); o.w = pk2(f[jj][6][t], f[jj][7][t]);
                *(GAS v4u*)((bf16*)d.dst + (size_t)(d.drow0 + n) * d.K + d.k0 + 8 * c) = o; } }
}
constexpr int PT_WGU = NEXP * 8 * 64, PT_WD = NEXP * 8 * 32, PT_WIN = 8 * 80, PT_WOUT = 8 * 32, P0T_EXPERTS = PT_WGU + PT_WD, P0T_ALL = P0T_EXPERTS + PT_WIN + PT_WOUT;
__device__ __forceinline__ void p0_transposes(Frame& F, int lo, int hi, int rank = -1, int nranks = 0) {
    const int lane = F.lane;
    const float *in_w_in = F.in(I_w_in), *in_w_out = F.in(I_w_out), *in_w_gate_up = F.in(I_w_gate_up), *in_w_down = F.in(I_w_down);
    const int gw = (rank < 0 ? F.vcu : rank) * NWAVES + F.wave, NGW = (rank < 0 ? F.G : nranks) * NWAVES;
    LAS unsigned char* lb = F.lds + RING_OFF + F.wave * 16384;
#define P0_DECODE(IT, D) do { int r = (IT); \
        if (r < PT_WGU) { const int e = r >> 9, rr = r & 511, kb = rr >> 6, nb = rr & 63, n0 = 32 * nb, j = n0 & 1023; \
            (D).src = in_w_gate_up + (size_t)e * DM * DE2; (D).dst = P_WGU8 + (size_t)e * DE2 * DM; (D).N = DE2; (D).K = DM; (D).k0 = 128 * kb; (D).n0 = n0; (D).drow0 = (j >> 7) * 256 + (n0 >= 1024 ? 128 : 0) + (j & 127); (D).fp8 = 1; break; } \
        r -= PT_WGU; \
        if (r < PT_WD) { const int e = r >> 8, rr = r & 255, kb = rr >> 5, nb = rr & 31; \
            (D).src = in_w_down + (size_t)e * DM * DM; (D).dst = P_WD8 + (size_t)e * DM * DM; (D).N = DM; (D).K = DM; (D).k0 = 128 * kb; (D).n0 = 32 * nb; (D).drow0 = 32 * nb; (D).fp8 = 1; break; } \
        r -= PT_WD; \
        if (r < PT_WIN) { const int kb = r / 80, nb = r % 80; (D).src = in_w_in; (D).dst = (unsigned char*)P_WIN_T; (D).N = INCOLS; (D).K = DM; (D).k0 = 128 * kb; (D).n0 = 32 * nb; (D).drow0 = 32 * nb; (D).fp8 = 0; break; } \
        r -= PT_WIN; \
        { const int kb = r / 32, nb = r % 32; (D).src = in_w_out; (D).dst = (unsigned char*)P_WOUT_T; (D).N = DM; (D).K = DM; (D).k0 = 128 * kb; (D).n0 = 32 * nb; (D).drow0 = 32 * nb; (D).fp8 = 0; } \
    } while (0)
    int it = lo + gw;
    if (it < hi) {
        TDesc d, d1; P0_DECODE(it, d); d1 = d;
        p0_dma_issue(d, lb, lane);
        asm volatile("s_waitcnt vmcnt(0)" ::: "memory");
        for (;;) {
            f32x4 f[2][8]; p0_read(lb, lane, f);
            LDS_WAIT(); asm volatile("" ::: "memory");
            const bool has = it + NGW < hi;
            if (has) { P0_DECODE(it + NGW, d1); p0_dma_issue(d1, lb, lane); }
            p0_emit(d, lane, f);
            asm volatile("" ::: "memory");
            if (!has) break;
            asm volatile("s_waitcnt vmcnt(8)" ::: "memory");
            it += NGW; d = d1;
        }
    }
#undef P0_DECODE
}
__device__ __forceinline__ void p0_prologue(Frame& F) {
    const int lane = F.lane;
    const float *in_w_ada = F.in(I_w_ada), *in_c = F.in(I_c), *in_b_ada = F.in(I_b_ada), *in_w_in = F.in(I_w_in), *in_w_out = F.in(I_w_out), *in_w_gate_up = F.in(I_w_gate_up), *in_w_down = F.in(I_w_down),
        *in_w_rg_a = F.in(I_w_rg_a), *in_w_rg_x = F.in(I_w_rg_x), *in_w_router = F.in(I_w_router);
    const int gw = F.vcu * NWAVES + F.wave, NGW = F.G * NWAVES;
    for (int cb = F.vcu; cb < NMOD / 24; cb += F.G) {
        LAS f32x4* part = (LAS f32x4*)(F.lds + RING_OFF);
        const int q = lane % 6, kk = lane / 6, col0 = cb * 24;
        if (kk < 8) { const int kb = F.wave * 128 + kk * 16;
            f32x4 a[4] = {(f32x4){0.f, 0.f, 0.f, 0.f}, (f32x4){0.f, 0.f, 0.f, 0.f}, (f32x4){0.f, 0.f, 0.f, 0.f}, (f32x4){0.f, 0.f, 0.f, 0.f}};
#pragma unroll
            for (int hf = 0; hf < 2; ++hf) {
                f32x4 wv[8];
#pragma unroll
                for (int t = 0; t < 8; ++t) wv[t] = *(const f32x4*)(in_w_ada + (size_t)(kb + 8 * hf + t) * NMOD + col0 + 4 * q);
#pragma unroll
                for (int b4 = 0; b4 < 4; ++b4) { const f32x4 c0 = *(const f32x4*)(in_c + b4 * DM + kb + 8 * hf), c1 = *(const f32x4*)(in_c + b4 * DM + kb + 8 * hf + 4);
                    a[b4] += c0.x * wv[0]; a[b4] += c0.y * wv[1]; a[b4] += c0.z * wv[2]; a[b4] += c0.w * wv[3]; a[b4] += c1.x * wv[4]; a[b4] += c1.y * wv[5]; a[b4] += c1.z * wv[6]; a[b4] += c1.w * wv[7]; }
                asm volatile("" ::: "memory"); }
#pragma unroll
            for (int b4 = 0; b4 < 4; ++b4) part[((F.wave * 8 + kk) * 6 + q) * 4 + b4] = a[b4]; }
        LDS_WAIT(); __syncthreads();
        if (F.tid < 96) { const int b4 = F.tid / 24, cc = F.tid % 24, qq = cc >> 2, comp = cc & 3; float s = 0.f;
            for (int p = 0; p < 64; ++p) s += part[(p * 6 + qq) * 4 + b4][comp];
            P_MOD[(size_t)b4 * NMOD + col0 + cc] = s + in_b_ada[col0 + cc]; }
        LDS_WAIT(); __syncthreads();
    }
    for (int r = gw; r < 512; r += NGW) { const int idx = r * 64 + lane, e = idx >> 10, k = idx & 1023; P_WRT[idx] = in_w_router[k * NEXP + e]; }
    asm volatile("s_waitcnt vmcnt(0)" ::: "memory");
    p0_transposes(F, P0T_EXPERTS, P0T_ALL);
    asm volatile("s_waitcnt vmcnt(0)" ::: "memory"); LDS_WAIT();
    for (int r = gw; r < 32; r += NGW) { const int which = r >> 4, rr = r & 15, n = rr >> 1, nb = rr & 1;
        p0_transpose_item((which ? in_w_rg_x : in_w_rg_a) + n * 4096, 64, 64, (which ? P_WX_T : P_WA_T) + n * 4096, 0, 32 * nb, 32 * nb, (LAS float*)(F.lds + RING_OFF + F.wave * 16384), lane); }
}
__device__ __forceinline__ void p1_norm(Frame& F) {
    const float* in_x = F.in(I_x); const float* in_g_mix = F.in(I_g_mix);
    const int gw = F.vcu * NWAVES + F.wave, NGW = F.G * NWAVES, lane = F.lane;
    for (int m = gw; m < TT; m += NGW) {
        const int b = m / SEQ;
        const GAS f32x4* xr = (const GAS f32x4*)(in_x + (size_t)m * DM) + lane;
        f32x4 v[4]; float ss = 0.f;
#pragma unroll
        for (int j = 0; j < 4; ++j) { v[j] = xr[64 * j]; ss += (v[j].x * v[j].x + v[j].y * v[j].y) + (v[j].z * v[j].z + v[j].w * v[j].w); }
        const float rstd = 1.0f / sqrtf(wave_sum(ss) * (1.0f / DM) + NORM_EPS);
        const float* mb = P_MOD + (size_t)b * NMOD;
#pragma unroll
        for (int j = 0; j < 4; ++j) { const int col = 4 * lane + 256 * j;
            const f32x4 g = *(const f32x4*)(in_g_mix + col), sc = *(const f32x4*)(mb + DM + col), sh = *(const f32x4*)(mb + col);
            const f32x4 h = (v[j] * rstd) * g * (sc + 1.0f) + sh;
            v2u o; o.x = pk2(h.x, h.y); o.y = pk2(h.z, h.w); *(GAS v2u*)(P_XN + (size_t)m * DM + col) = o; }
        asm volatile("" ::: "memory");
    }
}
template <bool FINAL> __device__ __forceinline__ void rglru_items(Frame& F) {
    LAS unsigned char* wl = F.lds + RING_OFF + F.wave * 16384;
    LAS float* summ = (LAS float*)(F.lds + SUMM_OFF);
    const float* in_conv_w = F.in(I_conv_w); const float* in_conv_b = F.in(I_conv_b); const float* in_b_rg_a = F.in(I_b_rg_a); const float* in_b_rg_x = F.in(I_b_rg_x); const float* in_lam = F.in(I_lam);
    const int lane = F.lane, w = F.wave;
    for (int it = F.vcu; it < NB * 8 * 16; it += F.G) {
        const int sp = it & 15, n = (it >> 4) & 7, b = it >> 7;
        const int gc = n * 64 + lane, t0 = sp * 256 + w * 32;
        const bf16* xrp = P_XR + ((size_t)b * SEQ) * DH + gc;
        float xin[35];
#pragma unroll
        for (int i = 0; i < 35; ++i) { const int tt = t0 - 3 + i, tc = tt < 0 ? 0 : tt; const float v = bf2f(xrp[(size_t)tc * DH]); xin[i] = tt < 0 ? 0.f : v; }
        const float cw0 = in_conv_w[gc], cw1 = in_conv_w[DH + gc], cw2 = in_conv_w[2 * DH + gc], cw3 = in_conv_w[3 * DH + gc], cb = in_conv_b[gc];
        float xc[32];
#pragma unroll
        for (int t = 0; t < 32; ++t) xc[t] = ((cw0 * xin[t] + cw1 * xin[t + 1]) + (cw2 * xin[t + 2] + cw3 * xin[t + 3])) + cb;
        LAS unsigned short* w16 = (LAS unsigned short*)wl;
#pragma unroll
        for (int t = 0; t < 32; ++t) w16[t * 64 + lane] = (unsigned short)f2bf(xc[t]);
        LDS_WAIT(); asm volatile("" ::: "memory");
        const int tok = lane & 31, hh = lane >> 5;
        bf16x8 af[4];
#pragma unroll
        for (int s = 0; s < 4; ++s) af[s] = *(const LAS bf16x8*)(wl + (tok * 64 + 16 * s + 8 * hh) * 2);
        f32x16 ga[2], gx[2];
#pragma unroll
        for (int nt = 0; nt < 2; ++nt) { ga[nt] = f32x16{}; gx[nt] = f32x16{};
            const size_t wo = ((size_t)(n * 64 + tok + 32 * nt)) * 64 + 8 * hh;
#pragma unroll
            for (int s = 0; s < 4; ++s) { const bf16x8 ba = *(const GAS bf16x8*)(P_WA_T + wo + 16 * s), bx = *(const GAS bf16x8*)(P_WX_T + wo + 16 * s);
                ga[nt] = __builtin_amdgcn_mfma_f32_32x32x16_bf16(af[s], ba, ga[nt], 0, 0, 0); gx[nt] = __builtin_amdgcn_mfma_f32_32x32x16_bf16(af[s], bx, gx[nt], 0, 0, 0); } }
        LDS_WAIT(); asm volatile("" ::: "memory");
        LAS float* wf = (LAS float*)wl;
#pragma unroll
        for (int nt = 0; nt < 2; ++nt)
#pragma unroll
            for (int rr = 0; rr < 16; ++rr) { const int tr = crow(rr, hh); wf[tr * 64 + tok + 32 * nt] = ga[nt][rr]; wf[2048 + tr * 64 + tok + 32 * nt] = gx[nt][rr]; }
        LDS_WAIT(); asm volatile("" ::: "memory");
        const float ba_ = in_b_rg_a[gc], bx_ = in_b_rg_x[gc], spc = log1pf(expf(-in_lam[gc]));
        float av[32], uv[32];
#pragma unroll
        for (int t = 0; t < 32; ++t) { const float pa = wf[t * 64 + lane] + ba_, px = wf[2048 + t * 64 + lane] + bx_;
            const float rg = __builtin_amdgcn_rcpf(1.0f + __builtin_amdgcn_exp2f(-1.4426950408889634f * pa)), ig = __builtin_amdgcn_rcpf(1.0f + __builtin_amdgcn_exp2f(-1.4426950408889634f * px));
            const float a = __builtin_amdgcn_exp2f((-8.0f * 1.4426950408889634f) * rg * spc);
            av[t] = a; uv[t] = __builtin_amdgcn_sqrtf(fmaxf(1.0f - a * a, 0.f)) * (ig * xc[t]); }
        LDS_WAIT(); asm volatile("" ::: "memory");
        float h = 0.f, P = 1.f;
#pragma unroll
        for (int t = 0; t < 32; ++t) { h = av[t] * h + uv[t]; P *= av[t]; }
        summ[(w * 64 + lane) * 2] = P; summ[(w * 64 + lane) * 2 + 1] = h;
        LDS_WAIT(); __syncthreads();
        if (!FINAL) {
            if (w == 0) { float Pt = 1.f, Ht = 0.f;
#pragma unroll
                for (int q = 0; q < 8; ++q) { const float p = summ[(q * 64 + lane) * 2], hq = summ[(q * 64 + lane) * 2 + 1]; Ht = p * Ht + hq; Pt *= p; }
                float* o = P_RSUM + ((size_t)(b * 16 + sp) * DH + gc) * 2; o[0] = Pt; o[1] = Ht; }
        } else {
            float hc = 0.f;
            { float pq[16], hq[16];
#pragma unroll
              for (int q = 0; q < 16; ++q) { const float* r2 = P_RSUM + ((size_t)(b * 16 + (q < sp ? q : 0)) * DH + gc) * 2; pq[q] = r2[0]; hq[q] = r2[1]; }
#pragma unroll
              for (int q = 0; q < 16; ++q) if (q < sp) hc = pq[q] * hc + hq[q]; }
            for (int q = 0; q < w; ++q) hc = summ[(q * 64 + lane) * 2] * hc + summ[(q * 64 + lane) * 2 + 1];
            h = hc;
            const bf16* grp = P_GR + ((size_t)b * SEQ + t0) * DH + gc; bf16* op = P_MIX + ((size_t)b * SEQ + t0) * DM + DH + gc;
            float gv[32];
#pragma unroll
            for (int t = 0; t < 32; ++t) gv[t] = bf2f(grp[(size_t)t * DH]);
            asm volatile("s_waitcnt vmcnt(0)" ::: "memory");
#pragma unroll
            for (int t = 0; t < 32; ++t) { h = av[t] * h + uv[t]; const float g = gv[t]; const float y = 0.7978845608028654f * (g + 0.044715f * g * g * g);
                const float th = 1.0f - 2.0f * __builtin_amdgcn_rcpf(1.0f + __builtin_amdgcn_exp2f((2.0f * 1.4426950408889634f) * y)); op[(size_t)t * DM] = (bf16)f2bf(h * (0.5f * g * (1.0f + th))); }
        }
        asm volatile("s_waitcnt vmcnt(0)" ::: "memory");
        LDS_WAIT(); __syncthreads();
    }
}
__device__ __forceinline__ void rglru_single(Frame& F) {
    LAS unsigned char* wl = F.lds + RING_OFF + F.wave * 16384;
    LAS float* summ = (LAS float*)(F.lds + SUMM_OFF);
    const float* in_conv_w = F.in(I_conv_w); const float* in_conv_b = F.in(I_conv_b); const float* in_b_rg_a = F.in(I_b_rg_a); const float* in_b_rg_x = F.in(I_b_rg_x); const float* in_lam = F.in(I_lam);
    const int lane = F.lane, w = F.wave;
    for (int it = F.vcu; it < NB * 8 * 16; it += F.G) {
        const int sp = it & 15, n = (it >> 4) & 7, b = it >> 7;
        const int gc = n * 64 + lane, t0 = sp * 256 + w * 32;
        const bf16* xrp = P_XR + ((size_t)b * SEQ) * DH + gc;
        float xin[35];
#pragma unroll
        for (int i = 0; i < 35; ++i) { const int tt = t0 - 3 + i, tc = tt < 0 ? 0 : tt; const float v = bf2f(xrp[(size_t)tc * DH]); xin[i] = tt < 0 ? 0.f : v; }
        const float cw0 = in_conv_w[gc], cw1 = in_conv_w[DH + gc], cw2 = in_conv_w[2 * DH + gc], cw3 = in_conv_w[3 * DH + gc], cb = in_conv_b[gc];
        float xc[32];
#pragma unroll
        for (int t = 0; t < 32; ++t) xc[t] = ((cw0 * xin[t] + cw1 * xin[t + 1]) + (cw2 * xin[t + 2] + cw3 * xin[t + 3])) + cb;
        LAS unsigned short* w16 = (LAS unsigned short*)wl;
#pragma unroll
        for (int t = 0; t < 32; ++t) w16[t * 64 + lane] = (unsigned short)f2bf(xc[t]);
        LDS_WAIT(); asm volatile("" ::: "memory");
        const int tok = lane & 31, hh = lane >> 5;
        bf16x8 af[4];
#pragma unroll
        for (int s = 0; s < 4; ++s) af[s] = *(const LAS bf16x8*)(wl + (tok * 64 + 16 * s + 8 * hh) * 2);
        f32x16 ga[2], gx[2];
#pragma unroll
        for (int nt = 0; nt < 2; ++nt) { ga[nt] = f32x16{}; gx[nt] = f32x16{};
            const size_t wo = ((size_t)(n * 64 + tok + 32 * nt)) * 64 + 8 * hh;
#pragma unroll
            for (int s = 0; s < 4; ++s) { const bf16x8 ba = *(const GAS bf16x8*)(P_WA_T + wo + 16 * s), bx = *(const GAS bf16x8*)(P_WX_T + wo + 16 * s);
                ga[nt] = __builtin_amdgcn_mfma_f32_32x32x16_bf16(af[s], ba, ga[nt], 0, 0, 0); gx[nt] = __builtin_amdgcn_mfma_f32_32x32x16_bf16(af[s], bx, gx[nt], 0, 0, 0); } }
        LDS_WAIT(); asm volatile("" ::: "memory");
        LAS float* wf = (LAS float*)wl;
#pragma unroll
        for (int nt = 0; nt < 2; ++nt)
#pragma unroll
            for (int rr = 0; rr < 16; ++rr) { const int tr = crow(rr, hh); wf[tr * 64 + tok + 32 * nt] = ga[nt][rr]; wf[2048 + tr * 64 + tok + 32 * nt] = gx[nt][rr]; }
        LDS_WAIT(); asm volatile("" ::: "memory");
        const float ba_ = in_b_rg_a[gc], bx_ = in_b_rg_x[gc], spc = log1pf(expf(-in_lam[gc]));
        float av[32], uv[32];
#pragma unroll
        for (int t = 0; t < 32; ++t) { const float pa = wf[t * 64 + lane] + ba_, px = wf[2048 + t * 64 + lane] + bx_;
            const float rg = __builtin_amdgcn_rcpf(1.0f + __builtin_amdgcn_exp2f(-1.4426950408889634f * pa)), ig = __builtin_amdgcn_rcpf(1.0f + __builtin_amdgcn_exp2f(-1.4426950408889634f * px));
            const float a = __builtin_amdgcn_exp2f((-8.0f * 1.4426950408889634f) * rg * spc);
            av[t] = a; uv[t] = __builtin_amdgcn_sqrtf(fmaxf(1.0f - a * a, 0.f)) * (ig * xc[t]); }
        LDS_WAIT(); asm volatile("" ::: "memory");
        float h = 0.f, P = 1.f;
#pragma unroll
        for (int t = 0; t < 32; ++t) { h = av[t] * h + uv[t]; P *= av[t]; }
        summ[(w * 64 + lane) * 2] = P; summ[(w * 64 + lane) * 2 + 1] = h;
        LDS_WAIT(); __syncthreads();
        const bf16* grp = P_GR + ((size_t)b * SEQ + t0) * DH + gc; bf16* op = P_MIX + ((size_t)b * SEQ + t0) * DM + DH + gc;
        float gv[32];
#pragma unroll
        for (int t = 0; t < 32; ++t) gv[t] = bf2f(grp[(size_t)t * DH]);
        LAS float* hspan = (LAS float*)(F.lds + TILE_OFF);
        if (w == 0) {
            float Pt = 1.f, Ht = 0.f;
#pragma unroll
            for (int q = 0; q < 8; ++q) { const float p = summ[(q * 64 + lane) * 2], hq = summ[(q * 64 + lane) * 2 + 1]; Ht = p * Ht + hq; Pt *= p; }
            unsigned long long* rx = (unsigned long long*)(F.ws + WS_CTL + (size_t)CW_RX * 4) + ((size_t)((b * 8 + n) * 16) * 64 + lane);
            __hip_atomic_store(rx + sp * 64, ((unsigned long long)__float_as_uint(Ht) << 32) | (unsigned long long)(__float_as_uint(Pt) | 1u), RLX_AGENT);
            unsigned long long v[15]; unsigned spins = 0u;
            for (;;) { bool ok = true;
#pragma unroll
                for (int q = 0; q < 15; ++q) { v[q] = q < sp ? __hip_atomic_load(rx + q * 64, RLX_AGENT) : 1ull; ok = ok && (v[q] != 0ull); }
                if (__all(ok)) break;
                __builtin_amdgcn_s_sleep(1); if (++spins > (1u << 20)) { if (lane == 0) __hip_atomic_store((unsigned*)(F.ws + WS_CTL) + CW_TMO, 0xA11u, RLX_AGENT); break; } }
            float hc = 0.f;
#pragma unroll
            for (int q = 0; q < 15; ++q) if (q < sp) hc = __uint_as_float((unsigned)v[q]) * hc + __uint_as_float((unsigned)(v[q] >> 32));
            hspan[lane] = hc;
        }
        LDS_WAIT(); __syncthreads();
        {   float hc = hspan[lane];
            for (int q = 0; q < w; ++q) hc = summ[(q * 64 + lane) * 2] * hc + summ[(q * 64 + lane) * 2 + 1];
            h = hc;
            asm volatile("s_waitcnt vmcnt(0)" ::: "memory");
#pragma unroll
            for (int t = 0; t < 32; ++t) { h = av[t] * h + uv[t]; const float g = gv[t]; const float y = 0.7978845608028654f * (g + 0.044715f * g * g * g);
                const float th = 1.0f - 2.0f * __builtin_amdgcn_rcpf(1.0f + __builtin_amdgcn_exp2f((2.0f * 1.4426950408889634f) * y)); op[(size_t)t * DM] = (bf16)f2bf(h * (0.5f * g * (1.0f + th))); }
        }
        asm volatile("s_waitcnt vmcnt(0)" ::: "memory");
        LDS_WAIT(); __syncthreads();
    }
}
typedef float cvt_f32x2 __attribute__((ext_vector_type(2))); typedef __bf16 cvt_bf16x2 __attribute__((ext_vector_type(2)));
__device__ __forceinline__ unsigned cvt2bf(float lo, float hi) { const cvt_f32x2 v = {lo, hi}; return __builtin_bit_cast(unsigned, __builtin_convertvector(v, cvt_bf16x2)); }
struct AttnUnit { int p, dsh, r, L0; size_t hb; };
__device__ __forceinline__ void attn_decode(int u, AttnUnit& a) {
    const int uu = u & 15, bh = (u >> 4) & 31; a.p = u >> 9; a.dsh = 2 * a.p;
    const int spr = 16 >> a.dsh;
    a.r = uu / spr; a.L0 = (uu % spr) * 256; a.hb = ((size_t)(bh >> 3) * SEQ) * DH + (bh & 7) * HD;
}
constexpr int ATT_KS = 144, ATT_VS = 192, ATT_VOFF = 384 * ATT_KS;
static_assert(ATT_VOFF + 384 * ATT_VS <= RING_BYTES, "attention LDS");
__device__ __forceinline__ void attn_items(Frame& F) {
    LAS unsigned char* kl = F.lds + RING_OFF; LAS unsigned char* vl = F.lds + RING_OFF + ATT_VOFF;
    const int lane = F.lane, c = lane & 31, hh = lane >> 5, w = F.wave, tid = F.tid;
    const float NEG = -1e30f;
    const int gi = lane >> 4, li = lane & 15;
    const int tr_base = (4 * hh + (li >> 2)) * ATT_VS + (16 * (gi & 1) + 4 * (li & 3)) * 2;
    const bf16 *QB = P_QB, *KB = P_KB, *VB = P_VB;
    constexpr int NUNIT = 3 * NB * NHEAD * 16;
    int u = F.vcu; if (u >= NUNIT) return;
    AttnUnit cu; attn_decode(u, cu);
    v4u kr[6], vr[6]; bf16x8 qn[4];
#define ATT_LOAD(A) do { _Pragma("unroll") for (int i = 0; i < 6; ++i) { const int cid = tid + 512 * i, rho = cid >> 3, ch = cid & 7; const int sub = (A).L0 - 128 + rho; \
        const int subc = sub < 0 ? 0 : sub; const size_t go = (A).hb + (size_t)((subc << (A).dsh) + (A).r) * DH + ch * 8; kr[i] = *(const GAS v4u*)(KB + go); vr[i] = *(const GAS v4u*)(VB + go); } \
        { const int tq = (((A).L0 + 32 * w + c) << (A).dsh) + (A).r; _Pragma("unroll") for (int s = 0; s < 4; ++s) qn[s] = *(const GAS bf16x8*)(QB + (A).hb + (size_t)tq * DH + 16 * s + 8 * hh); } } while (0)
    ATT_LOAD(cu);
    for (;;) {
#pragma unroll
        for (int i = 0; i < 6; ++i) { const int cid = tid + 512 * i, rho = cid >> 3, ch = cid & 7;
            *(LAS v4u*)(kl + rho * ATT_KS + ch * 16) = kr[i]; *(LAS v4u*)(vl + rho * ATT_VS + ch * 16) = vr[i]; }
        bf16x8 qf[4];
#pragma unroll
        for (int s = 0; s < 4; ++s) qf[s] = qn[s];
        const int un = u + F.G; const bool more = un < NUNIT; AttnUnit nx = cu;
        if (more) { attn_decode(un, nx); ATT_LOAD(nx); }
        LDS_WAIT(); __syncthreads();
        float m = NEG, l = 0.f; f32x16 o0 = f32x16{}, o1 = f32x16{};
        for (int j = 0; j < 5; ++j) {
            const int rho0 = 32 * w + 32 * j; if (cu.L0 - 128 + rho0 < 0) continue;
            bf16x8 kf[4];
#pragma unroll
            for (int s = 0; s < 4; ++s) kf[s] = *(const LAS bf16x8*)(kl + (rho0 + c) * ATT_KS + (16 * s + 8 * hh) * 2);
            f32x16 sc = f32x16{};
#pragma unroll
            for (int s = 0; s < 4; ++s) sc = __builtin_amdgcn_mfma_f32_32x32x16_bf16(kf[s], qf[s], sc, 0, 0, 0);
            if (j == 0) {
#pragma unroll
                for (int rr = 0; rr < 16; ++rr) if (crow(rr, hh) < c) sc[rr] = NEG;
            }
            if (j == 4) {
#pragma unroll
                for (int rr = 0; rr < 16; ++rr) if (crow(rr, hh) > c) sc[rr] = NEG;
            }
            float mx = fmaxf(fmaxf(sc[0], sc[1]), fmaxf(sc[2], sc[3]));
#pragma unroll
            for (int rr = 4; rr < 16; rr += 4) mx = fmaxf(mx, fmaxf(fmaxf(sc[rr], sc[rr + 1]), fmaxf(sc[rr + 2], sc[rr + 3])));
            mx = fmaxf(mx, __shfl_xor(mx, 32));
            if (__any(mx > m)) { const float mn = fmaxf(m, mx), alpha = __builtin_amdgcn_exp2f(m - mn); m = mn; l *= alpha;
#pragma unroll
                for (int rr = 0; rr < 16; ++rr) { o0[rr] *= alpha; o1[rr] *= alpha; } }
            float ps = 0.f;
#pragma unroll
            for (int rr = 0; rr < 16; ++rr) { sc[rr] = __builtin_amdgcn_exp2f(sc[rr] - m); ps += sc[rr]; }
            l += ps;
            v4u pb0, pb1;
            pb0.x = cvt2bf(sc[0], sc[1]); pb0.y = cvt2bf(sc[2], sc[3]); pb0.z = cvt2bf(sc[4], sc[5]); pb0.w = cvt2bf(sc[6], sc[7]);
            pb1.x = cvt2bf(sc[8], sc[9]); pb1.y = cvt2bf(sc[10], sc[11]); pb1.z = cvt2bf(sc[12], sc[13]); pb1.w = cvt2bf(sc[14], sc[15]);
            LAS unsigned char* vt = vl + rho0 * ATT_VS + tr_base;
#pragma unroll
            for (int dt = 0; dt < 2; ++dt)
#pragma unroll
                for (int s = 0; s < 2; ++s) {
                    const v4i16_t lo = __builtin_amdgcn_ds_read_tr16_b64_v4i16((LAS v4i16_t*)(vt + (16 * s) * ATT_VS + 64 * dt));
                    const v4i16_t hi = __builtin_amdgcn_ds_read_tr16_b64_v4i16((LAS v4i16_t*)(vt + (16 * s + 8) * ATT_VS + 64 * dt));
                    const bf16x8 af = (bf16x8){lo[0], lo[1], lo[2], lo[3], hi[0], hi[1], hi[2], hi[3]};
                    const bf16x8 pf = __builtin_bit_cast(bf16x8, s ? pb1 : pb0);
                    if (dt == 0) o0 = __builtin_amdgcn_mfma_f32_32x32x16_bf16(af, pf, o0, 0, 0, 0); else o1 = __builtin_amdgcn_mfma_f32_32x32x16_bf16(af, pf, o1, 0, 0, 0);
                }
        }
        asm volatile("s_waitcnt vmcnt(0)" ::: "memory");
        {   l += __shfl_xor(l, 32);
            const float inv = 1.0f / l;
            const int tq = ((cu.L0 + 32 * w + c) << cu.dsh) + cu.r;
            bf16* op = P_OP + (size_t)cu.p * TT * DH + cu.hb + (size_t)tq * DH;
#pragma unroll
            for (int g4 = 0; g4 < 4; ++g4) {
                v2u w0, w1; w0.x = cvt2bf(o0[4 * g4] * inv, o0[4 * g4 + 1] * inv); w0.y = cvt2bf(o0[4 * g4 + 2] * inv, o0[4 * g4 + 3] * inv);
                w1.x = cvt2bf(o1[4 * g4] * inv, o1[4 * g4 + 1] * inv); w1.y = cvt2bf(o1[4 * g4 + 2] * inv, o1[4 * g4 + 3] * inv);
                *(GAS v2u*)(op + 8 * g4 + 4 * hh) = w0; *(GAS v2u*)(op + 32 + 8 * g4 + 4 * hh) = w1; }
            if (hh == 0) P_LSE[(((size_t)cu.p * TT * DH + cu.hb + (size_t)tq * DH) >> 6)] = m + __builtin_amdgcn_logf(l); }
        LDS_WAIT(); __syncthreads();
        if (!more) break;
        u = un; cu = nx;
    }
#undef ATT_LOAD
}
__device__ __forceinline__ void attn_merge(Frame& F) {
    const int gt = F.vcu * (NWAVES * 64) + F.tid, NGT = F.G * NWAVES * 64;
    for (int idx = gt; idx < TT * 64; idx += NGT) {
        const int t = idx >> 6, ch = idx & 63, h = ch >> 3;
        const float l0 = P_LSE[(size_t)t * NHEAD + h], l1 = P_LSE[((size_t)TT + t) * NHEAD + h], l2 = P_LSE[((size_t)2 * TT + t) * NHEAD + h];
        const float mx = fmaxf(l0, fmaxf(l1, l2));
        float w0 = __builtin_amdgcn_exp2f(l0 - mx), w1 = __builtin_amdgcn_exp2f(l1 - mx), w2 = __builtin_amdgcn_exp2f(l2 - mx);
        const float inv = 1.0f / (w0 + w1 + w2); w0 *= inv; w1 *= inv; w2 *= inv;
        const v4u a = *(const GAS v4u*)(P_OP + (size_t)t * DH + ch * 8), bq = *(const GAS v4u*)(P_OP + ((size_t)TT + t) * DH + ch * 8), cq = *(const GAS v4u*)(P_OP + ((size_t)2 * TT + t) * DH + ch * 8);
        v4u o;
#pragma unroll
        for (int k = 0; k < 4; ++k) {
            const float lo = w0 * bf2f((unsigned short)(a[k] & 0xffffu)) + w1 * bf2f((unsigned short)(bq[k] & 0xffffu)) + w2 * bf2f((unsigned short)(cq[k] & 0xffffu));
            const float hi = w0 * bf2f((unsigned short)(a[k] >> 16)) + w1 * bf2f((unsigned short)(bq[k] >> 16)) + w2 * bf2f((unsigned short)(cq[k] >> 16));
            o[k] = pk2(lo, hi); }
        *(GAS v4u*)(P_MIX + (size_t)t * DM + ch * 8) = o;
        asm volatile("" ::: "memory");
    }
}

#ifndef ROUTER_SPLIT
#define ROUTER_SPLIT 2
#endif
__device__ __forceinline__ void p6_rows(Frame& F, int only = 0) {
    const float* in_g_ffn = F.in(I_g_ffn); const float* in_b_router = F.in(I_b_router);
    constexpr int RS = ROUTER_SPLIT;
    const bool split = (F.G % RS) == 0;
    if (split && (F.vcu % RS) != 0) { if (only != 1) p0_transposes(F, 0, PT_WGU, (F.vcu / RS) * (RS - 1) + (F.vcu % RS) - 1, (F.G / RS) * (RS - 1)); return; }
    const int rrank = split ? F.vcu / RS : F.vcu, rn = split ? F.G / RS : F.G;
    if (only >= 2) return;
    LAS unsigned char* hl = F.lds + RING_OFF;
    LAS int* wc = (LAS int*)(F.lds + SUMM_OFF);
    const int lane = F.lane, w = F.wave, e = lane & 31, hh = lane >> 5;
    float wreg[64];
#pragma unroll
    for (int i4 = 0; i4 < 16; ++i4) { const f32x4 t = *(const GAS f32x4*)(P_WRT + (size_t)e * DM + 128 * w + 64 * hh + 4 * i4); wreg[4 * i4] = t.x; wreg[4 * i4 + 1] = t.y; wreg[4 * i4 + 2] = t.z; wreg[4 * i4 + 3] = t.w; }
    const float bias = in_b_router[e];
    const __amdgpu_buffer_rsrc_t rs_x1 = __builtin_amdgcn_make_buffer_rsrc((void*)P_X1, 0, 0x7ffffff0, 0x00020000), rs_h8 = __builtin_amdgcn_make_buffer_rsrc((void*)P_XN8, 0, 0x7ffffff0, 0x00020000);
#define P6_LOADROW(dst, m) do { _Pragma("unroll") for (int j_ = 0; j_ < 4; ++j_) (dst)[j_] = __builtin_bit_cast(v2u, __builtin_amdgcn_raw_buffer_load_b64(rs_x1, lane * 8 + j_ * 512, (m) * (DM * 2), 0)); } while (0)
    v2u xa[4][4];
    if (rrank < TT / 64) {
#pragma unroll
      for (int q = 0; q < 4; ++q) P6_LOADROW(xa[q], rrank * 64 + 4 * w + q); }
    for (int chunk = rrank; chunk < TT / 64; chunk += rn) {
      int wcount = 0;
      const int b = (chunk * 64) / SEQ;
      const float* mb = P_MOD + (size_t)b * NMOD;
#pragma nounroll
      for (int bl = 0; bl < 2; ++bl) {
        const int mblk = chunk * 64 + bl * 32;
#pragma unroll
        for (int q = 0; q < 4; ++q) { f32x4 v[4]; float sa = 0.f; const int tok = 4 * w + q;
#pragma unroll
            for (int j = 0; j < 4; ++j) { const v2u t = xa[q][j]; v[j] = (f32x4){bf2f((unsigned short)(t.x & 0xffffu)), bf2f((unsigned short)(t.x >> 16)), bf2f((unsigned short)(t.y & 0xffffu)), bf2f((unsigned short)(t.y >> 16))};
                sa += (v[j].x * v[j].x + v[j].y * v[j].y) + (v[j].z * v[j].z + v[j].w * v[j].w); }
            const float ra = 1.0f / sqrtf(wave_sum(sa) * (1.0f / DM) + NORM_EPS);
#pragma unroll
            for (int j = 0; j < 4; ++j) { const int col = 4 * lane + 256 * j;
                const f32x4 Gm = *(const f32x4*)(in_g_ffn + col) * (*(const f32x4*)(mb + 4 * DM + col) + 1.0f), Sm = *(const f32x4*)(mb + 3 * DM + col);
                const f32x4 h = (v[j] * ra) * Gm + Sm;
                __builtin_amdgcn_raw_buffer_store_b32(pg8::pk4_fp8(h.x * SC_H, h.y * SC_H, h.z * SC_H, h.w * SC_H), rs_h8, lane * 4 + j * 256, (mblk + tok) * DM, 0);
                *(LAS f32x4*)(hl + tok * 4096 + (((lane + 64 * j) ^ (tok & 15)) * 16)) = h; } }
        {
            const int mn = bl == 0 ? mblk + 32 : (chunk + rn < TT / 64 ? (chunk + rn) * 64 : mblk);
#pragma unroll
            for (int q = 0; q < 4; ++q) P6_LOADROW(xa[q], mn + 4 * w + q); }
        LDS_WAIT(); __syncthreads();
        f32x16 acc = f32x16{};
        { const LAS unsigned char* hrow = hl + e * 4096;
#pragma unroll
          for (int i4 = 0; i4 < 16; ++i4) { const f32x4 a4 = *(const LAS f32x4*)(hrow + (((32 * w + 16 * hh + i4) ^ (e & 15)) * 16));
              acc = __builtin_amdgcn_mfma_f32_32x32x2f32(wreg[4 * i4], a4.x, acc, 0, 0, 0); acc = __builtin_amdgcn_mfma_f32_32x32x2f32(wreg[4 * i4 + 1], a4.y, acc, 0, 0, 0);
              acc = __builtin_amdgcn_mfma_f32_32x32x2f32(wreg[4 * i4 + 2], a4.z, acc, 0, 0, 0); acc = __builtin_amdgcn_mfma_f32_32x32x2f32(wreg[4 * i4 + 3], a4.w, acc, 0, 0, 0); } }
        LDS_WAIT(); __syncthreads();
#pragma unroll
        for (int g = 0; g < 4; ++g) *(LAS f32x4*)(hl + (w * 32 + e) * 128 + (((2 * g + hh) ^ (e & 7)) * 16)) = (f32x4){acc[4 * g], acc[4 * g + 1], acc[4 * g + 2], acc[4 * g + 3]};
        LDS_WAIT(); __syncthreads();
#pragma unroll
        for (int pr = 0; pr < 2; ++pr) {
          const int tl = 4 * w + 2 * pr + hh;
          float val = bias;
#pragma unroll
          for (int q = 0; q < 8; ++q) val += *(const LAS float*)(hl + (q * 32 + tl) * 128 + (((e >> 2) ^ (tl & 7)) * 16) + (e & 3) * 4);
          float tv[4]; int te[4];
#pragma unroll
          for (int r = 0; r < 4; ++r) { float mx = val;
              mx = row_max16(mx); mx = fmaxf(mx, __shfl_xor(mx, 16));
              const unsigned long long bal = __ballot(val == mx); const unsigned hb = hh ? (unsigned)(bal >> 32) : (unsigned)bal;
              const int es = __builtin_ctz(hb | 0x80000000u);
              te[r] = es; tv[r] = mx; if (e == es) val = -INFINITY; }
          const float e1 = expf(tv[1] - tv[0]), e2 = expf(tv[2] - tv[0]), e3 = expf(tv[3] - tv[0]); const float inv = 1.0f / (1.0f + e1 + e2 + e3);
          int lpv = 0;
#pragma unroll
          for (int h2 = 0; h2 < 2; ++h2)
#pragma unroll
            for (int r = 0; r < 4; ++r) { const int es = __builtin_amdgcn_readlane(te[r], 32 * h2); const int lp = __builtin_amdgcn_readlane(wcount, es);
                if (lane == es) ++wcount; if (lane == 32 * h2 + r) lpv = lp; }
          if (e < 4) { const int m = mblk + tl, ti = 4 * bl + 2 * pr + hh;
              const int ee = e == 0 ? te[0] : e == 1 ? te[1] : e == 2 ? te[2] : te[3];
              const float g = (e == 0 ? 1.0f : e == 1 ? e1 : e == 2 ? e2 : e3) * inv;
              P_TOK_E[m * 4 + e] = ee; P_TOK_GATE[m * 4 + e] = g;
              wc[512 + ((w * 8 + ti) * 4 + e) * 2] = ee; wc[512 + ((w * 8 + ti) * 4 + e) * 2 + 1] = lpv; }
        }
        LDS_WAIT(); __syncthreads();
      }
      if (lane < 32) wc[w * 32 + lane] = wcount;
      LDS_WAIT(); __syncthreads();
      if (lane < 32) { int pre = 0; for (int q = 0; q < w; ++q) pre += wc[q * 32 + lane]; wc[256 + w * 32 + lane] = pre;
          if (w == 7) P_BCNT[chunk * 32 + lane] = pre + wcount; }
      LDS_WAIT(); asm volatile("" ::: "memory");
      if (lane < 32) { const int ti = lane >> 2, r = lane & 3; const int ee = wc[512 + ((w * 8 + ti) * 4 + r) * 2], l = wc[512 + ((w * 8 + ti) * 4 + r) * 2 + 1];
          P_TOK_POS[(chunk * 64 + (ti >> 2) * 32 + 4 * w + (ti & 3)) * 4 + r] = wc[256 + w * 32 + ee] + l; }
      LDS_WAIT(); __syncthreads();
    }
#undef P6_LOADROW
}
__device__ __forceinline__ void p7_gather(Frame& F) {
    LAS int* pt = (LAS int*)(F.lds + RING_OFF);
    volatile LAS int* lb = (volatile LAS int*)(F.lds + TILE_OFF);
    { const int e = F.tid & 31, seg = F.tid >> 5; int s = 0;
      for (int j = 0; j < 16; ++j) s += P_BCNT[(seg * 16 + j) * 32 + e];
      pt[8192 + seg * 32 + e] = s; LDS_WAIT(); __syncthreads();
      int base = 0, tot = 0; for (int q = 0; q < 16; ++q) { const int x = pt[8192 + q * 32 + e]; if (q < seg) base += x; tot += x; }
      for (int j = 0; j < 16; ++j) { pt[(seg * 16 + j) * 32 + e] = base; base += P_BCNT[(seg * 16 + j) * 32 + e]; }
      if (seg == 0) lb[64 + e] = tot; }
    LDS_WAIT(); __syncthreads();
    if (F.tid == 0) { int acc = 0, nt = 0;
        for (int e = 0; e < NEXP; ++e) { const int c = lb[64 + e]; lb[e] = acc; const int tiles = (c + 255) >> 8;
            if (blockIdx.x == 0) for (int k = 0; k < tiles; ++k) P_TILE_E[nt + k] = e;
            nt += tiles; acc += tiles * 256; }
        lb[32] = acc; if (blockIdx.x == 0) P_TILE_N[0] = nt; }
    LDS_WAIT(); __syncthreads();
    const int gt = F.vcu * (NWAVES * 64) + F.tid, NGT = F.G * NWAVES * 64;
    for (int idx = gt; idx < TT * TOPK + NEXP * 256; idx += NGT) {
        if (idx < TT * TOPK) { const int e = P_TOK_E[idx], pos = P_TOK_POS[idx]; const int slot = lb[e] + pt[(idx >> 8) * 32 + e] + pos; P_TOK_SLOT[idx] = slot; P_SLOT_TOK[slot] = idx >> 2; }
        else { const int q = idx - TT * TOPK, e = q >> 8, i = q & 255; const int c = lb[64 + e]; const int padded = ((c + 255) >> 8) << 8; if (c + i < padded) P_SLOT_TOK[lb[e] + c + i] = TT; }
    }
    if (blockIdx.x == 0 && F.tid < 64) ((GAS v4u*)(P_XN8 + (size_t)TT * DM))[F.tid] = (v4u){0u, 0u, 0u, 0u};
    asm volatile("s_waitcnt vmcnt(0)" ::: "memory");
    LDS_WAIT(); __syncthreads();
    if (F.G % ROUTER_SPLIT) p0_transposes(F, 0, PT_WGU);
}
__device__ __forceinline__ void p10_final(Frame& F) {
    const float* in_g_final = F.in(I_g_final); float* out_p = (float*)F.in(22);
    const int gw = F.vcu * NWAVES + F.wave, NGW = F.G * NWAVES, lane = F.lane;
    const bf16* Y2 = P_Y2;
    for (int m = gw; m < TT; m += NGW) {
        const int b = m / SEQ;
        const GAS v2u* xr = (const GAS v2u*)(P_X1 + (size_t)m * DM) + lane;
        f32x4 v[4], a[4];
#pragma unroll
        for (int j = 0; j < 4; ++j) { const v2u t = xr[64 * j]; v[j] = (f32x4){bf2f((unsigned short)(t.x & 0xffffu)), bf2f((unsigned short)(t.x >> 16)), bf2f((unsigned short)(t.y & 0xffffu)), bf2f((unsigned short)(t.y >> 16))}; a[j] = (f32x4){0.f, 0.f, 0.f, 0.f}; }
#pragma unroll
        for (int k = 0; k < 4; ++k) { const int slot = P_TOK_SLOT[m * 4 + k]; const float g = P_TOK_GATE[m * 4 + k];
            const GAS v2u* yr = (const GAS v2u*)(Y2 + (size_t)slot * DM) + lane;
#pragma unroll
            for (int j = 0; j < 4; ++j) { const v2u y = yr[64 * j];
                a[j].x += g * bf2f((unsigned short)(y.x & 0xffffu)); a[j].y += g * bf2f((unsigned short)(y.x >> 16)); a[j].z += g * bf2f((unsigned short)(y.y & 0xffffu)); a[j].w += g * bf2f((unsigned short)(y.y >> 16)); } }
        const float* gf = P_MOD + (size_t)b * NMOD + 5 * DM; float ss = 0.f;
#pragma unroll
        for (int j = 0; j < 4; ++j) { const f32x4 gt = *(const f32x4*)(gf + 4 * lane + 256 * j); v[j] = v[j] + gt * a[j]; ss += (v[j].x * v[j].x + v[j].y * v[j].y) + (v[j].z * v[j].z + v[j].w * v[j].w); }
        const float rstd = 1.0f / sqrtf(wave_sum(ss) * (1.0f / DM) + NORM_EPS);
        GAS f32x4* orow = (GAS f32x4*)(out_p + (size_t)m * DM) + lane;
#pragma unroll
        for (int j = 0; j < 4; ++j) { const f32x4 g = *(const f32x4*)(in_g_final + 4 * lane + 256 * j); orow[64 * j] = (v[j] * rstd) * g; }        asm volatile("" ::: "memory");
    }
}

#ifndef DUP_MASK
#define DUP_MASK 0
#endif
struct Args { const float* in[22]; float* out; unsigned char* ws; int ph_lo, ph_hi, li, pad; };
__global__ void __launch_bounds__(NWAVES * 64, 2) hymba_fwd(Args args) {
    extern __shared__ __attribute__((aligned(16))) unsigned char lds[];
    Frame F;
    F.lds = (LAS unsigned char*)lds;
    F.tid = threadIdx.x; F.lane = F.tid & 63; F.wave = __builtin_amdgcn_readfirstlane(F.tid >> 6);
    F.G = gridDim.x; { const int bx = blockIdx.x; F.vcu = (F.G % 8 == 0) ? (bx % 8) * (F.G / 8) + bx / 8 : bx; }
    unsigned char* ws = args.ws;
    F.ws = ws; F.ka = (const __attribute__((address_space(4))) void*)__builtin_amdgcn_kernarg_segment_ptr();
    for (int u = F.tid; u < (LDS_BYTES - LDSCTL_OFF) / 4; u += NWAVES * 64) ((LAS unsigned*)(F.lds + LDSCTL_OFF))[u] = 0u;
    __syncthreads();
#define CTLP ((gu32*)(F.ws + WS_CTL))
#define MISCP ((volatile LAS unsigned*)(F.lds + MISC_OFF))
    if (N_LAUNCHES != PER_PHASE) (void)xcd_barrier_post((unsigned*)(CTLP + CW_BAR), MISCP + 8);
#define GRID_BAR(seam) do { if (N_LAUNCHES == PER_PHASE) { if (F.tid == 0) __hip_atomic_store(CTLP + CW_TMO, 0xBADBA0u | (unsigned)(seam), RLX_AGENT); } \
    else { XcdBarrier bar_; bar_.bar = (unsigned*)(CTLP + CW_BAR); bar_.x = xb_xcc_id(); bar_.st = MISCP + 8; xcd_barrier(bar_); if (DUPK(13)) xcd_barrier(bar_); } asm volatile("" : "+v"(F.tid), "+v"(F.lane)); } while (0)
    const int lo = (N_LAUNCHES == 1) ? 0 : args.ph_lo, hi = (N_LAUNCHES == 1) ? PER_PHASE : args.ph_hi;
#ifndef PHASE_MASK
#define PHASE_MASK 0x7ff
#endif
#define IN(k) (((PHASE_MASK >> (k)) & 1) && lo <= (k) && (k) < hi)
#define BOTH(k) (IN(k) && IN((k) + 1))
#define DUPK(k) ((DUP_MASK >> (k)) & 1)
#define RUN_P2() do { pg8::Gemm g{P_XN, P_WIN_T, TT, INCOLS, DM}; pg8::StaticOrder S; S.init(TT, INCOLS, F.G, (int)blockIdx.x); \
        pg8::EpiBf16<0> E{P_QB, DH, nullptr, DH, (size_t)TT * DH, C2}; \
        pg8::gemm_phase<pg8::EpiBf16<0>, pg8::StaticOrder, true, true>(F.lds + RING_OFF, g, S, E); } while (0)
#define RUN_P5() do { pg8::Gemm g{P_MIX, P_WOUT_T, TT, DM, DM}; pg8::StaticOrder S; S.init(TT, DM, F.G, (int)blockIdx.x); \
        pg8::EpiResGate E{F.in(I_x), P_X1, DM, P_MOD + 2 * DM, NMOD, SEQ}; \
        pg8::gemm_phase<pg8::EpiResGate, pg8::StaticOrder, true, true>(F.lds + RING_OFF, g, S, E); } while (0)
#define RUN_P8() do { const int ntm = P_TILE_N[0]; \
        pg8::Gemm g{(const pg8::bf16_t*)P_XN8, (const pg8::bf16_t*)P_WGU8, ntm * 256, DE2, DM / 2}; pg8::GroupedOrder S; S.init(P_TILE_E, ntm, 8, F.G, (int)blockIdx.x); \
        LAS int* rt = (LAS int*)(F.lds + ROWTAB_OFF); { pg8::Unit u_; for (int i_ = 0; i_ < ROWTAB_UNITS && S.next(i_, u_); ++i_) if (F.tid < 256) rt[i_ * 256 + F.tid] = P_SLOT_TOK[u_.pm * 256 + F.tid] * DM; } \
        LDS_WAIT(); __syncthreads(); \
        pg8::EpiSwiglu E{P_ACT8, F.in(I_b_gate_up), 1.0f / (SC_H * SC_W), SC_ACT}; \
        pg8::gemm_phase<pg8::EpiSwiglu, pg8::GroupedOrder, true, true, true, true>(F.lds + RING_OFF, g, S, E, rt); \
        asm volatile("s_waitcnt vmcnt(0)" ::: "memory"); __syncthreads(); p0_transposes(F, PT_WGU, P0T_EXPERTS); } while (0)
#define RUN_P9() do { const int ntm = P_TILE_N[0]; \
        pg8::Gemm g{(const pg8::bf16_t*)P_ACT8, (const pg8::bf16_t*)P_WD8, ntm * 256, DM, DM / 2}; pg8::GroupedOrder S; S.init(P_TILE_E, ntm, 4, F.G, (int)blockIdx.x); \
        pg8::EpiDown E{P_Y2, F.in(I_b_down), 1.0f / (SC_ACT * SC_W)}; \
        pg8::gemm_phase<pg8::EpiDown, pg8::GroupedOrder, true, true, true>(F.lds + RING_OFF, g, S, E); } while (0)
    if (IN(0)) { p0_prologue(F); if (BOTH(0)) GRID_BAR(0); if (DUPK(0)) { p0_prologue(F); GRID_BAR(0); } }
    if (IN(1)) { p1_norm(F); if (BOTH(1)) GRID_BAR(1); if (DUPK(1)) { p1_norm(F); GRID_BAR(1); } }
    if (IN(2)) { RUN_P2(); if (BOTH(2)) GRID_BAR(2); if (DUPK(2)) { RUN_P2(); GRID_BAR(2); } }
    if (IN(3)) { rglru_single(F); attn_items(F); if (BOTH(3)) GRID_BAR(3);  if (DUPK(11)) { attn_items(F); GRID_BAR(3); }  }
    if (IN(4)) { attn_merge(F); if (BOTH(4)) GRID_BAR(4); if (DUPK(4)) { attn_merge(F); GRID_BAR(4); } }
    if (IN(5)) { RUN_P5(); if (BOTH(5)) GRID_BAR(5); if (DUPK(5)) { RUN_P5(); GRID_BAR(5); } }
    if (IN(6)) { p6_rows(F); if (BOTH(6)) GRID_BAR(6); if (DUPK(6)) { p6_rows(F); GRID_BAR(6); } if (DUPK(14)) { p6_rows(F, 1); GRID_BAR(6); } if (DUPK(15)) { p6_rows(F, 2); GRID_BAR(6); } }
    if (IN(7)) { p7_gather(F); if (BOTH(7)) GRID_BAR(7); if (DUPK(7)) { p7_gather(F); GRID_BAR(7); } }
    if (IN(8)) { RUN_P8(); if (BOTH(8)) GRID_BAR(8); if (DUPK(8)) { RUN_P8(); GRID_BAR(8); } }
    if (IN(9)) { RUN_P9(); if (BOTH(9)) GRID_BAR(9); if (DUPK(9)) { RUN_P9(); GRID_BAR(9); } }
    if (IN(10)) { p10_final(F); if (DUPK(10)) { GRID_BAR(10); p10_final(F); } }
#undef IN
#undef BOTH
}

extern "C" void kernel_launch(void* const* d_in, const int* in_sizes, int n_in, void* d_out, int out_size, void* d_ws, size_t ws_size, hipStream_t stream) {
    static int grid = 0;
    if (grid == 0) {
        if (n_in != 22 || in_sizes[0] != TT * DM || out_size != TT * DM || ws_size < WS_END) { fprintf(stderr, "kernel_launch: unexpected shapes (n_in %d, in0 %d, out %d, ws %zu); nothing launched\n", n_in, n_in > 0 ? in_sizes[0] : -1, out_size, ws_size); grid = -1; return; }
        int dev = 0, cus = 0, per_cu = 0;
        if (hipGetDevice(&dev) != hipSuccess || hipDeviceGetAttribute(&cus, hipDeviceAttributeMultiprocessorCount, dev) != hipSuccess) { fprintf(stderr, "kernel_launch: device query failed\n"); grid = -1; return; }
        if (hipFuncSetAttribute((const void*)hymba_fwd, hipFuncAttributeMaxDynamicSharedMemorySize, LDS_BYTES) != hipSuccess) { fprintf(stderr, "kernel_launch: hipFuncSetAttribute failed\n"); grid = -1; return; }
        if (hipOccupancyMaxActiveBlocksPerMultiprocessor(&per_cu, (const void*)hymba_fwd, NWAVES * 64, LDS_BYTES) != hipSuccess || per_cu < 1) { fprintf(stderr, "kernel_launch: occupancy query reports %d workgroups per CU\n", per_cu); per_cu = 1; }
        (void)hipGetLastError();
        if (cus < 256) { fprintf(stderr, "kernel_launch: built for a 256-CU device (one workgroup per CU), found %d CUs; nothing launched\n", cus); grid = -1; return; }
        grid = 256;
    }
    if (grid < 0) return;
    if (hipMemsetAsync((char*)d_ws + WS_CTL, 0, CTL_ZERO_BYTES, stream) != hipSuccess) { fprintf(stderr, "kernel_launch: memset failed\n"); return; }
    Args a{};
    for (int i = 0; i < 22; ++i) a.in[i] = (const float*)d_in[i];
    a.out = (float*)d_out; a.ws = (unsigned char*)d_ws; a.pad = DUP_MASK;
    for (int li = 0; li < N_LAUNCHES; ++li) {
        a.ph_lo = (N_LAUNCHES == PER_PHASE) ? li : 0; a.ph_hi = (N_LAUNCHES == PER_PHASE) ? li + 1 : PER_PHASE; a.li = li;
        hipLaunchKernelGGL(hymba_fwd, dim3(grid), dim3(NWAVES * 64), LDS_BYTES, stream, a);
        const hipError_t le = hipPeekAtLastError();
        if (le != hipSuccess) { fprintf(stderr, "kernel_launch: launch %d failed: %s\n", li, hipGetErrorName(le)); break; }
    }
}
```

```cpp
#include <hip/hip_runtime.h>
#include <cstdio>
#include <cstdint>
#define MK_N_LAUNCHES 1
#define DUP_MASK 0
namespace pg8 {
#define PG8_LAS __attribute__((address_space(3)))
typedef unsigned short bf16_t;
typedef short bf16x8 __attribute__((ext_vector_type(8)));
typedef float f32x4 __attribute__((ext_vector_type(4)));
typedef unsigned u32x4 __attribute__((ext_vector_type(4)));
constexpr int BM = 256, BK = 64, HALF = 128, HTB = HALF * BK * 2  , STAGE_BYTES = 8 * HTB, NXCD = 8, WGM = 8;

__host__ __device__ __forceinline__ int lds_byte(int r, int c) { const int st = (r >> 4) * 2 + (c >> 5), rr = r & 15, cc = c & 31, ob = rr * 64 + cc * 2; return st * 1024 + (ob ^ (((ob >> 9) & 1) << 5)); }
__host__ __device__ __forceinline__ void stage_rc(int b, int& R, int& C) { const int st = b / 1024, sb = b % 1024, swz = sb ^ (((sb >> 9) & 1) << 5); R = (st >> 1) * 16 + swz / 64; C = (st & 1) * 32 + (swz % 64) / 2; }
__host__ __device__ __forceinline__ int perm32(int rho) { const int n = rho >> 4, i = rho & 15; return 8 * (i >> 2) + 4 * n + (i & 3); }

struct Unit { int pm, pn, hs; };
struct Gemm { const bf16_t* A; const bf16_t* Bt; int M, N, K; };

struct StaticOrder {
    int nM, nN, nwg, G, c;
    __host__ __device__ void init(int M, int N, int G_, int c_) { nM = M / BM; nN = N / BM; nwg = nM * nN; G = G_; c = c_; }
    __host__ __device__ bool next(int i, Unit& u) const {
        const long L = (long)i * G + c; if (L >= nwg) return false;
        int wgid = (int)L; { const int q = nwg / NXCD, r = nwg % NXCD, xcd = wgid % NXCD, off = wgid / NXCD; wgid = (xcd < r ? xcd * (q + 1) : r * (q + 1) + (xcd - r) * q) + off; }
        const int nig = WGM * nN, gid = wgid / nig, fm = gid * WGM, gsz = (nM - fm) < WGM ? (nM - fm) : WGM;
        u.pm = fm + ((wgid % nig) % gsz); u.pn = (wgid % nig) / gsz; u.hs = -1; return true;
    }
    __device__ __forceinline__ void a_ready(const Unit&) const {}
    __device__ __forceinline__ void done(const Unit&) const {}
};

typedef float cvtf32x2_t __attribute__((ext_vector_type(2))); typedef __bf16 cvtbf16x2_t __attribute__((ext_vector_type(2)));
__device__ __forceinline__ unsigned cvt_pk_bf16(float lo, float hi) { const cvtf32x2_t v = {lo, hi}; return __builtin_bit_cast(unsigned, __builtin_convertvector(v, cvtbf16x2_t)); }
typedef float f32x2 __attribute__((ext_vector_type(2)));
__device__ __forceinline__ f32x2 gelu_pk(f32x2 v) {
    const f32x2 av = __builtin_elementwise_abs(v), d = av * 0.2316418882f + 1.0f;
    f32x2 t; t.x = __builtin_amdgcn_rcpf(d.x); t.y = __builtin_amdgcn_rcpf(d.y);
    f32x2 q = t * 0.5307027145f + (-0.7265760135f); q = q * t + 0.7107068705f; q = q * t + (-0.142248368f); q = q * t + 0.127414796f; q = q * t;
    const f32x2 s = (v * v) * (-0.72134752044f);
    f32x2 e; e.x = __builtin_amdgcn_exp2f(s.x); e.y = __builtin_amdgcn_exp2f(s.y);
    const f32x2 m = v * (q * e), r = v - m;
    f32x2 o; o.x = v.x < 0.f ? m.x : r.x; o.y = v.y < 0.f ? m.y : r.y; return o;
}

template <int ACT  > struct EpiBf16 {
    static constexpr bool PERM = true, AFTER_DRAIN = false; static constexpr int STORES = 8;     static_assert(ACT == 0 || ACT == 1, "EpiBf16: ACT is 0 (none) or 1 (gelu_pk)");
    bf16_t* O; int ldc; const float* bias; int split_cols; size_t split_stride; float scale0;
    __device__ __forceinline__ void operator()(const f32x4 (&acc)[2][2][4][2], const Unit& u, int wr, int wc, int fr, int fq) const {
        const int row0 = u.pm * BM + wr * 64 + fr; int colt = u.pn * BM; bf16_t* base = O;
        float sc = 1.f; if (split_cols) { const int t = colt / split_cols; base += (size_t)t * split_stride; colt -= t * split_cols; if (t == 0) sc = scale0; }
        const int col0 = colt + wc * 32 + 8 * fq, bcol0 = u.pn * BM + wc * 32 + 8 * fq;
        f32x4 bv[2][2];
#pragma unroll
        for (int bj = 0; bj < 2; ++bj)
#pragma unroll
            for (int n = 0; n < 2; ++n) bv[bj][n] = bias ? *(const f32x4*)(bias + bcol0 + bj * HALF + 4 * n) : (f32x4){0.f, 0.f, 0.f, 0.f};
        const __amdgpu_buffer_rsrc_t rs_o = __builtin_amdgcn_make_buffer_rsrc((void*)base, 0, 0x7ffffff0, 0x00020000);
#pragma unroll
        for (int ai = 0; ai < 2; ++ai)
#pragma unroll
            for (int m = 0; m < 4; ++m) { bf16_t* rowp = base + (size_t)(row0 + ai * HALF + m * 16) * ldc + col0;
#pragma unroll
                for (int bj = 0; bj < 2; ++bj) { if (u.hs >= 0 && u.hs != bj) continue; f32x4 v0 = acc[ai][bj][m][0] + bv[bj][0], v1 = acc[ai][bj][m][1] + bv[bj][1];
                    if (ACT == 1) { f32x2 a = gelu_pk((f32x2){v0[0], v0[1]}), b = gelu_pk((f32x2){v0[2], v0[3]}), c = gelu_pk((f32x2){v1[0], v1[1]}), d = gelu_pk((f32x2){v1[2], v1[3]});
                        v0 = (f32x4){a.x, a.y, b.x, b.y}; v1 = (f32x4){c.x, c.y, d.x, d.y}; }
                    v0 = v0 * sc; v1 = v1 * sc; u32x4 w; w.x = cvt_pk_bf16(v0[0], v0[1]); w.y = cvt_pk_bf16(v0[2], v0[3]); w.z = cvt_pk_bf16(v1[0], v1[1]); w.w = cvt_pk_bf16(v1[2], v1[3]);
                    __builtin_amdgcn_raw_buffer_store_b128(w, rs_o, (int)((rowp + bj * HALF - base) * 2), 0, 16); } }
    }
};
template <class Epi, class Sched, bool ALIGN_EPI = false, bool SP2 = false, bool FP8 = false, bool GATHER = false, bool HALFN = false>
__device__ __forceinline__ void gemm_phase(PG8_LAS unsigned char* lds, const Gemm g, const Sched& S, const Epi& E, const PG8_LAS int* rowtab = nullptr) {
    int tid_ = threadIdx.x; asm volatile("" : "+v"(tid_));
    const int tid = tid_, wid = __builtin_amdgcn_readfirstlane(tid >> 6), lane = tid & 63, wr = wid >> 2, wc = wid & 3, fr = lane & 15, fq = lane >> 4;
    const int K = g.K, nt = K / BK;
    unsigned voffA, voffB;
    constexpr int PERMK = (int)Epi::PERM;
    { int R, C; stage_rc(tid * 16, R, C);
      const int Rb = PERMK == 2 ? ((R >> 5) * 64 + 16 * ((R & 15) >> 2) + 4 * ((R >> 4) & 1) + (R & 3)) : PERMK ? ((R & ~31) + perm32(R & 31)) : R;
      voffA = (unsigned)(R * K + C) * 2u; voffB = (unsigned)(Rb * K + C) * 2u; }
    const unsigned qstep = 64u * K * 2;
    const unsigned kstep = (unsigned)(BK * 2);
    const unsigned hstep = (unsigned)HALF * K * 2;
    const unsigned tstep = 2 * hstep;
    const unsigned qstepB = PERMK == 2 ? 128u * K * 2 : qstep, hstepB = PERMK == 2 ? 8u * K * 2 : hstep;
    const unsigned ldsw = (unsigned)wid * 1024u;
    const int aoff = lds_byte(wr * 64 + fr, fq * 8), boff = lds_byte(wc * 32 + fr, fq * 8);
#define PG8_SA(b, h) (((b) * 2 + (h)) * HTB)
#define PG8_SB(b, h) ((4 + (b) * 2 + (h)) * HTB)
#define PG8_STAGE(bufoff, goff, voff) do { _Pragma("unroll") for (int _i = 0; _i < 2; ++_i) \
        __builtin_amdgcn_raw_ptr_buffer_load_lds(srd_##voff, (PG8_LAS unsigned*)(lds + (bufoff) + ldsw + _i * 8192), 16, (int)(voff), (int)((goff) + _i * qstepB), 0, 0); } while (0)
#define PG8_STAGE_A(bufoff, goff, VS) do { _Pragma("unroll") for (int _i = 0; _i < 2; ++_i) \
        __builtin_amdgcn_raw_ptr_buffer_load_lds(srd_voffA, (PG8_LAS unsigned*)(lds + (bufoff) + ldsw + _i * 8192), 16, GATHER ? (int)VS[((bufoff) / HTB) & 1][_i] : (int)voffA, GATHER ? (int)(goff) : (int)((goff) + _i * qstep), 0, 0); } while (0)
#define PG8_LDA(dst, b, h) do { if constexpr (FP8) { _Pragma("unroll") for (int m = 0; m < 4; ++m) { const v4i_t l_ = *(const PG8_LAS v4i_t*)(lds + PG8_SA(b, h) + aoff + m * 2048), h_ = *(const PG8_LAS v4i_t*)(lds + PG8_SA(b, h) + aoff + m * 2048 + 1024); dst##8[m] = __builtin_shufflevector(l_, h_, 0, 1, 2, 3, 4, 5, 6, 7); } } else { _Pragma("unroll") for (int m = 0; m < 4; ++m) _Pragma("unroll") for (int k = 0; k < 2; ++k) dst[m][k] = *(const PG8_LAS bf16x8*)(lds + PG8_SA(b, h) + aoff + m * 2048 + k * 1024); } } while (0)
#define PG8_LDB(dst, b, h) do { if constexpr (FP8) { _Pragma("unroll") for (int n = 0; n < 2; ++n) { const v4i_t l_ = *(const PG8_LAS v4i_t*)(lds + PG8_SB(b, h) + boff + n * 2048), h_ = *(const PG8_LAS v4i_t*)(lds + PG8_SB(b, h) + boff + n * 2048 + 1024); dst##8[n] = __builtin_shufflevector(l_, h_, 0, 1, 2, 3, 4, 5, 6, 7); } } else { _Pragma("unroll") for (int n = 0; n < 2; ++n) _Pragma("unroll") for (int k = 0; k < 2; ++k) dst[n][k] = *(const PG8_LAS bf16x8*)(lds + PG8_SB(b, h) + boff + n * 2048 + k * 1024); } } while (0)
#define PG8_MMA(ai, bj, At, Bt) do { if constexpr (HALFN) { if (cur.hs >= 0 && cur.hs != (bj)) break; } __builtin_amdgcn_s_setprio(1); if constexpr (FP8) { _Pragma("unroll") for (int m = 0; m < 4; ++m) _Pragma("unroll") for (int n = 0; n < 2; ++n) \
        asm volatile("v_mfma_f32_16x16x128_f8f6f4 %0, %1, %2, %0" : "+v"(acc[ai][bj][m][n]) : "v"(Bt##8[n]), "v"(At##8[m])); } else { \
        _Pragma("unroll") for (int m = 0; m < 4; ++m) _Pragma("unroll") for (int n = 0; n < 2; ++n) _Pragma("unroll") for (int k = 0; k < 2; ++k) \
        acc[ai][bj][m][n] = __builtin_amdgcn_mfma_f32_16x16x32_bf16(Bt[n][k], At[m][k], acc[ai][bj][m][n], 0, 0, 0); } __builtin_amdgcn_s_setprio(0); } while (0)
#define PG8_WAIT_V(n) asm volatile("s_waitcnt vmcnt(" #n ")" ::: "memory")
#define PG8_WAIT_L(n) asm volatile("s_waitcnt lgkmcnt(" #n ")" ::: "memory")
#define PG8_WAIT_V8E() do { if (Epi::STORES > 0 && epi_pending) asm volatile("s_waitcnt vmcnt(%0)" :: "n"(8 + Epi::STORES) : "memory"); else PG8_WAIT_V(8); } while (0)
#define PG8_BAR __builtin_amdgcn_s_barrier()
#define PG8_SCHED __builtin_amdgcn_sched_barrier(0)
    Unit cur, nxt; int ui = 0; bool epi_pending = false;
    if (!S.next(0, cur)) return;
    f32x4 acc[2][2][4][2];
#pragma unroll
    for (int a = 0; a < 2; ++a)
#pragma unroll
        for (int b = 0; b < 2; ++b)
#pragma unroll
            for (int m = 0; m < 4; ++m)
#pragma unroll
                for (int n = 0; n < 2; ++n) acc[a][b][m][n] = (f32x4){0.f, 0.f, 0.f, 0.f};
    typedef int v8i_t __attribute__((ext_vector_type(8))); typedef int v4i_t __attribute__((ext_vector_type(4)));
    bf16x8 At[4][2], B0[2][2], B1[2][2]; v8i_t At8[4], B08[2], B18[2];
    const __amdgpu_buffer_rsrc_t srd_voffA = __builtin_amdgcn_make_buffer_rsrc((void*)g.A, 0, 0x7ffffff0, 0x00020000), srd_voffB = __builtin_amdgcn_make_buffer_rsrc((void*)g.Bt, 0, 0x7ffffff0, 0x00020000);
    unsigned cA = GATHER ? 0u : (unsigned)cur.pm * tstep, cB = (unsigned)cur.pn * tstep;
    const unsigned hstepA = GATHER ? 0u : hstep;
    unsigned ca_[2][2] = {{0u, 0u}, {0u, 0u}}, na_[2][2] = {{0u, 0u}, {0u, 0u}}, va2_[2][2] = {{0u, 0u}, {0u, 0u}};
    int gR_ = 0, gC2_ = 0;
    if constexpr (GATHER) { int R, C; stage_rc(tid * 16, R, C); gR_ = R; gC2_ = C * 2;
#pragma unroll
        for (int h = 0; h < 2; ++h)
#pragma unroll
            for (int i = 0; i < 2; ++i) ca_[h][i] = (unsigned)rowtab[128 * h + 64 * i + R] + (unsigned)gC2_; }
    S.a_ready(cur);
    if constexpr (SP2) {
        PG8_STAGE(PG8_SB(0, 0), cB, voffB); PG8_STAGE(PG8_SB(0, 1), cB + hstepB, voffB); PG8_STAGE_A(PG8_SA(0, 0), cA, ca_); PG8_STAGE_A(PG8_SA(0, 1), cA + hstepA, ca_);
        if (wr == 1) PG8_BAR;
        PG8_WAIT_V(2); PG8_BAR;
        PG8_STAGE(PG8_SB(1, 0), cB + kstep, voffB); PG8_STAGE_A(PG8_SA(1, 0), cA + kstep, ca_); PG8_STAGE(PG8_SB(1, 1), cB + hstepB + kstep, voffB);
        PG8_WAIT_V(6); PG8_BAR;
    } else {
        PG8_STAGE(PG8_SB(0, 0), cB, voffB); PG8_STAGE_A(PG8_SA(0, 0), cA, ca_); PG8_STAGE(PG8_SB(0, 1), cB + hstepB, voffB); PG8_STAGE_A(PG8_SA(0, 1), cA + hstepA, ca_);
        if (wr == 1) PG8_BAR;
        PG8_WAIT_V(4); PG8_BAR;
        PG8_STAGE(PG8_SB(1, 0), cB + kstep, voffB); PG8_STAGE_A(PG8_SA(1, 0), cA + kstep, ca_); PG8_STAGE(PG8_SB(1, 1), cB + hstepB + kstep, voffB);
        PG8_WAIT_V(6); PG8_BAR;
    }
    for (;;) {
        const bool has_next = S.next(ui + 1, nxt);
        const unsigned nA = GATHER ? 0u : (has_next ? (unsigned)nxt.pm * tstep : cA); const unsigned nB = has_next ? (unsigned)nxt.pn * tstep : cB;
        if constexpr (GATHER) {
#pragma unroll
            for (int h = 0; h < 2; ++h)
#pragma unroll
                for (int i = 0; i < 2; ++i) na_[h][i] = has_next ? (unsigned)rowtab[(ui + 1) * 256 + 128 * h + 64 * i + gR_] + (unsigned)gC2_ : ca_[h][i]; }
#pragma nounroll
        for (int t = 0; t < nt; t += 2) {
            const bool last = (t == nt - 2);
            const unsigned a1 = cA + (unsigned)(t + 1) * kstep;
            const unsigned a2 = last ? nA : cA + (unsigned)(t + 2) * kstep; const unsigned b2 = last ? nB : cB + (unsigned)(t + 2) * kstep;
            const unsigned a3 = a2 + kstep; const unsigned b3 = b2 + kstep;
            if constexpr (GATHER) {
#pragma unroll
                for (int h = 0; h < 2; ++h)
#pragma unroll
                    for (int i = 0; i < 2; ++i) va2_[h][i] = last ? na_[h][i] : ca_[h][i]; }
            if (last && has_next) S.a_ready(nxt);
            if constexpr (SP2) {
            PG8_LDB(B0, 0, 0); PG8_LDB(B1, 0, 1); PG8_SCHED; PG8_LDA(At, 0, 0); PG8_STAGE_A(PG8_SA(1, 1), a1 + hstepA, ca_);
            PG8_WAIT_V8E(); PG8_WAIT_L(0); PG8_BAR; PG8_MMA(0, 0, At, B0); PG8_MMA(0, 1, At, B1); PG8_BAR; PG8_SCHED;
            PG8_LDA(At, 0, 1); PG8_STAGE(PG8_SB(0, 0), b2, voffB); PG8_STAGE(PG8_SB(0, 1), b2 + hstepB, voffB); PG8_STAGE_A(PG8_SA(0, 0), a2, va2_);
            PG8_WAIT_V8E(); epi_pending = false; PG8_WAIT_L(0); PG8_BAR; PG8_MMA(1, 0, At, B0); PG8_MMA(1, 1, At, B1); PG8_BAR; PG8_SCHED;
            PG8_LDB(B0, 1, 0); PG8_LDB(B1, 1, 1); PG8_SCHED; PG8_LDA(At, 1, 0); PG8_STAGE_A(PG8_SA(0, 1), a2 + hstepA, va2_);
            PG8_WAIT_V(8); PG8_WAIT_L(0); PG8_BAR; PG8_MMA(0, 0, At, B0); PG8_MMA(0, 1, At, B1); PG8_BAR; PG8_SCHED;
            PG8_LDA(At, 1, 1); PG8_STAGE(PG8_SB(1, 0), b3, voffB); PG8_STAGE(PG8_SB(1, 1), b3 + hstepB, voffB); PG8_STAGE_A(PG8_SA(1, 0), a3, va2_);
            PG8_WAIT_V(8); PG8_WAIT_L(0); PG8_BAR; PG8_MMA(1, 0, At, B0); PG8_MMA(1, 1, At, B1); PG8_BAR; PG8_SCHED;
            } else {
            PG8_LDB(B0, 0, 0); PG8_SCHED; PG8_LDA(At, 0, 0); PG8_STAGE_A(PG8_SA(1, 1), a1 + hstepA, ca_);
            PG8_WAIT_L(8); PG8_BAR; PG8_WAIT_L(0); PG8_MMA(0, 0, At, B0); PG8_BAR; PG8_SCHED;
            PG8_LDB(B1, 0, 1); PG8_STAGE(PG8_SB(0, 0), b2, voffB);
            PG8_BAR; PG8_WAIT_L(0); PG8_MMA(0, 1, At, B1); PG8_BAR;
            PG8_LDA(At, 0, 1); PG8_STAGE_A(PG8_SA(0, 0), a2, va2_);
            PG8_BAR; PG8_WAIT_L(0); PG8_MMA(1, 0, At, B0); PG8_BAR; PG8_SCHED;
            PG8_STAGE(PG8_SB(0, 1), b2 + hstepB, voffB);
            PG8_WAIT_V(6); PG8_BAR; PG8_MMA(1, 1, At, B1); PG8_BAR;
            PG8_LDB(B0, 1, 0); PG8_SCHED; PG8_LDA(At, 1, 0); PG8_STAGE_A(PG8_SA(0, 1), a2 + hstepA, va2_);
            PG8_WAIT_L(8); PG8_BAR; PG8_WAIT_L(0); PG8_MMA(0, 0, At, B0); PG8_BAR; PG8_SCHED;
            PG8_LDB(B1, 1, 1); PG8_STAGE(PG8_SB(1, 0), b3, voffB);
            PG8_BAR; PG8_WAIT_L(0); PG8_MMA(0, 1, At, B1); PG8_BAR;
            PG8_LDA(At, 1, 1); PG8_STAGE_A(PG8_SA(1, 0), a3, va2_);
            PG8_BAR; PG8_WAIT_L(0); PG8_MMA(1, 0, At, B0); PG8_BAR; PG8_SCHED;
            PG8_STAGE(PG8_SB(1, 1), b3 + hstepB, voffB);
            PG8_WAIT_V(6); PG8_BAR; PG8_MMA(1, 1, At, B1); PG8_BAR;
            }
        }
        if constexpr (ALIGN_EPI) { if (wr == 0) PG8_BAR; }
        if constexpr (FP8) asm volatile("s_nop 15\n\ts_nop 15" ::: "memory");
        if constexpr (!Epi::AFTER_DRAIN) { E(acc, cur, wr, wc, fr, fq); S.done(cur); epi_pending = true; }
        if (!has_next) break;
#pragma unroll
        for (int a = 0; a < 2; ++a)
#pragma unroll
            for (int b = 0; b < 2; ++b)
#pragma unroll
                for (int m = 0; m < 4; ++m)
#pragma unroll
                    for (int n = 0; n < 2; ++n) acc[a][b][m][n] = (f32x4){0.f, 0.f, 0.f, 0.f};
        cur = nxt; cA = nA; cB = nB; ++ui;
        if constexpr (GATHER) {
#pragma unroll
            for (int h = 0; h < 2; ++h)
#pragma unroll
                for (int i = 0; i < 2; ++i) ca_[h][i] = na_[h][i]; }
        if constexpr (ALIGN_EPI) { if (wr == 1) PG8_BAR; }
    }
    PG8_WAIT_V(0);
    if constexpr (!ALIGN_EPI) { if (wr == 0) PG8_BAR; }
    PG8_BAR;
    if constexpr (Epi::AFTER_DRAIN) { E.fused(acc, cur, wr, wc, fr, fq, lds, wid, lane); S.done(cur); }
#undef PG8_SA
#undef PG8_SB
#undef PG8_STAGE
#undef PG8_LDA
#undef PG8_LDB
#undef PG8_MMA
#undef PG8_WAIT_V
#undef PG8_WAIT_V8E
#undef PG8_WAIT_L
#undef PG8_BAR
#undef PG8_SCHED
}
}

namespace pg8 {
struct EpiResGate {
    static constexpr bool PERM = false, AFTER_DRAIN = false; static constexpr int STORES = 0;
    const float* base; unsigned short* out; int ldc; const float* gate; int gate_bstride; int rows_per_batch;
    __device__ __forceinline__ void operator()(const f32x4 (&acc)[2][2][4][2], const Unit& u, int wr, int wc, int fr, int fq) const {
        const int b = (u.pm * BM) / rows_per_batch;
        const int col0 = u.pn * BM + wc * 32 + 4 * fq;
        f32x4 gv[2][2];
#pragma unroll
        for (int bj = 0; bj < 2; ++bj)
#pragma unroll
            for (int n = 0; n < 2; ++n) gv[bj][n] = *(const f32x4*)(gate + (size_t)b * gate_bstride + col0 + bj * HALF + n * 16);
#pragma unroll
        for (int ai = 0; ai < 2; ++ai)
#pragma unroll
            for (int mp = 0; mp < 2; ++mp) {
                f32x4 bs[2][2][2];
#pragma unroll
                for (int mm = 0; mm < 2; ++mm) { const int m = 2 * mp + mm; const size_t off = (size_t)(u.pm * BM + ai * HALF + wr * 64 + m * 16 + fr) * ldc + col0;
#pragma unroll
                    for (int bj = 0; bj < 2; ++bj)
#pragma unroll
                        for (int n = 0; n < 2; ++n) bs[mm][bj][n] = *(const f32x4*)(base + off + bj * HALF + n * 16); }
                asm volatile("s_waitcnt vmcnt(0)" ::: "memory");
#pragma unroll
                for (int mm = 0; mm < 2; ++mm) { const int m = 2 * mp + mm; const size_t off = (size_t)(u.pm * BM + ai * HALF + wr * 64 + m * 16 + fr) * ldc + col0;
#pragma unroll
                    for (int bj = 0; bj < 2; ++bj)
#pragma unroll
                        for (int n = 0; n < 2; ++n) { const f32x4 r = bs[mm][bj][n] + gv[bj][n] * acc[ai][bj][m][n]; typedef unsigned u32x2_ __attribute__((ext_vector_type(2)));
                            u32x2_ w; w.x = cvt_pk_bf16(r[0], r[1]); w.y = cvt_pk_bf16(r[2], r[3]); *(u32x2_*)(out + off + bj * HALF + n * 16) = w; } }
                asm volatile("" ::: "memory");
            }
    }
};
__device__ __forceinline__ unsigned pk4_fp8(float a, float b, float c, float d) {
    a = __builtin_fminf(__builtin_fmaxf(a, -448.f), 448.f); b = __builtin_fminf(__builtin_fmaxf(b, -448.f), 448.f); c = __builtin_fminf(__builtin_fmaxf(c, -448.f), 448.f); d = __builtin_fminf(__builtin_fmaxf(d, -448.f), 448.f);
    int w = 0; w = __builtin_amdgcn_cvt_pk_fp8_f32(a, b, w, false); w = __builtin_amdgcn_cvt_pk_fp8_f32(c, d, w, true); return (unsigned)w; }
__device__ __forceinline__ unsigned pk4_fp8_nc(float a, float b, float c, float d) {
    int w = 0; w = __builtin_amdgcn_cvt_pk_fp8_f32(a, b, w, false); w = __builtin_amdgcn_cvt_pk_fp8_f32(c, d, w, true); return (unsigned)w; }
struct EpiSwiglu {
    static constexpr bool PERM = true, AFTER_DRAIN = false; static constexpr int STORES = 8;
    unsigned char* O; const float* bgu; float asc, osc;
    __device__ __forceinline__ float act1(float g, float u) const {
        g = __builtin_fminf(g, 7.0f); u = __builtin_fminf(__builtin_fmaxf(u, -7.0f), 7.0f);
        const float s = __builtin_amdgcn_rcpf(1.0f + __builtin_amdgcn_exp2f(g * (-1.702f * 1.4426950408889634f)));
        return (u + 1.0f) * (g * s) * osc;
    }
    typedef float f32x2_e __attribute__((ext_vector_type(2)));
    __device__ __forceinline__ f32x2_e act2(float ga, float gb, float ua, float ub) const {
        f32x2_e g = (f32x2_e){__builtin_fminf(ga, 7.0f), __builtin_fminf(gb, 7.0f)};
        const f32x2_e u = (f32x2_e){__builtin_fminf(__builtin_fmaxf(ua, -7.0f), 7.0f), __builtin_fminf(__builtin_fmaxf(ub, -7.0f), 7.0f)};
        const f32x2_e x = g * (-1.702f * 1.4426950408889634f);
        const f32x2_e d = (f32x2_e){__builtin_amdgcn_exp2f(x.x), __builtin_amdgcn_exp2f(x.y)} + 1.0f;
        const f32x2_e sg = (f32x2_e){__builtin_amdgcn_rcpf(d.x), __builtin_amdgcn_rcpf(d.y)};
        return ((u + 1.0f) * (g * sg)) * osc;
    }
    __device__ __forceinline__ void operator()(const f32x4 (&acc)[2][2][4][2], const Unit& u, int wr, int wc, int fr, int fq) const {
        const int e = u.pn >> 3, pnl = u.pn & 7;
        const int row0 = u.pm * BM + wr * 64 + fr;
        const int ocol0 = pnl * 128 + wc * 32 + 8 * fq;
        f32x4 bg[2], bu[2];
#pragma unroll
        for (int n = 0; n < 2; ++n) { bg[n] = *(const f32x4*)(bgu + (size_t)e * 2048 + ocol0 + 4 * n); bu[n] = *(const f32x4*)(bgu + (size_t)e * 2048 + 1024 + ocol0 + 4 * n); }
#pragma unroll
        for (int ai = 0; ai < 2; ++ai)
#pragma unroll
            for (int m = 0; m < 4; ++m) { unsigned char* rowp = O + (size_t)(row0 + ai * HALF + m * 16) * 1024 + ocol0;
                const f32x4 g0 = acc[ai][0][m][0] * asc + bg[0], g1 = acc[ai][0][m][1] * asc + bg[1], u0 = acc[ai][1][m][0] * asc + bu[0], u1 = acc[ai][1][m][1] * asc + bu[1];
                typedef unsigned u32x2 __attribute__((ext_vector_type(2)));
                const f32x2_e a00 = act2(g0[0], g0[1], u0[0], u0[1]), a01 = act2(g0[2], g0[3], u0[2], u0[3]), a10 = act2(g1[0], g1[1], u1[0], u1[1]), a11 = act2(g1[2], g1[3], u1[2], u1[3]);
                u32x2 w; w.x = pk4_fp8_nc(a00.x, a00.y, a01.x, a01.y);
                w.y = pk4_fp8_nc(a10.x, a10.y, a11.x, a11.y);
                *(u32x2*)rowp = w; asm volatile("" ::: "memory"); }
    }
};
struct EpiDown {
    static constexpr int PERM = 2; static constexpr bool AFTER_DRAIN = false; static constexpr int STORES = 8;
    bf16_t* O; const float* bias; float asc; int nostore; float osc;
    __device__ __forceinline__ void operator()(const f32x4 (&acc)[2][2][4][2], const Unit& u, int wr, int wc, int fr, int fq) const {
        if (nostore == 2) { asm volatile("" :: "v"(acc[0][0][0][0]), "v"(acc[1][1][3][1])); return; }
        const int row0 = u.pm * BM + wr * 64 + fr; const int pnl = u.pn & 3;
        const int col0 = pnl * BM + wc * 64 + 16 * fq, bcol0 = u.pn * BM + wc * 64 + 16 * fq;
        f32x4 bv[2][2];
#pragma unroll
        for (int bj = 0; bj < 2; ++bj)
#pragma unroll
            for (int n = 0; n < 2; ++n) bv[bj][n] = *(const f32x4*)(bias + bcol0 + 8 * bj + 4 * n);
        const __amdgpu_buffer_rsrc_t rs_o = __builtin_amdgcn_make_buffer_rsrc((void*)O, 0, 0x7ffffff0, 0x00020000);
#pragma unroll
        for (int ai = 0; ai < 2; ++ai)
#pragma unroll
            for (int m = 0; m < 4; ++m) { const int off = (row0 + ai * HALF + m * 16) * 1024 + col0;
                u32x4 w;
#pragma unroll
                for (int bj = 0; bj < 2; ++bj) { const f32x4 v0 = (acc[ai][bj][m][0] * asc + bv[bj][0]) * osc, v1 = (acc[ai][bj][m][1] * asc + bv[bj][1]) * osc;
                    w[2 * bj] = pk4_fp8(v0[0], v0[1], v0[2], v0[3]); w[2 * bj + 1] = pk4_fp8(v1[0], v1[1], v1[2], v1[3]); }
                if (!nostore) __builtin_amdgcn_raw_buffer_store_b128(w, rs_o, off, 0, 16); else asm volatile("" :: "v"(w)); }
    }
};
#ifndef GROUPED_WGM
#define GROUPED_WGM 16
#endif
struct GroupedOrder {
    const PG8_LAS int* tile_e; int nM, nNl, nwg, G, c;
    __device__ void init(const PG8_LAS int* te, int ntm, int nNl_, int G_, int c_) { tile_e = te; nM = ntm; nNl = nNl_; nwg = ntm * nNl_; G = G_; c = c_; }
    __device__ bool next(int i, Unit& u) const {
        const long L = (long)i * G + c; if (L >= nwg) return false;
        int wgid = (int)L; { const int q = nwg / NXCD, r = nwg % NXCD, xcd = wgid % NXCD, off = wgid / NXCD; wgid = (xcd < r ? xcd * (q + 1) : r * (q + 1) + (xcd - r) * q) + off; }
        constexpr int WG = GROUPED_WGM; const int nig = WG * nNl, gid = wgid / nig, fm = gid * WG, gsz = (nM - fm) < WG ? (nM - fm) : WG;
        u.pm = fm + ((wgid % nig) % gsz); const int pl = (wgid % nig) / gsz;
        u.pn = __builtin_amdgcn_readfirstlane(tile_e[u.pm]) * nNl + pl; u.hs = -1; return true;
    }
    __device__ __forceinline__ void a_ready(const Unit&) const {}
    __device__ __forceinline__ void done(const Unit&) const {}
};
struct HalfTailOrder {
    StaticOrder S; int full;
    __device__ void init(int M, int N, int G_, int c_) { S.init(M, N, G_, c_); full = (S.nwg / G_) * G_; if (2 * (S.nwg - full) > G_) full = S.nwg; }
    __device__ bool next(int i, Unit& u) const {
        if ((long)i * S.G < full) return S.next(i, u);
        if ((long)i * S.G > full || full == S.nwg) return false;
        StaticOrder T = S; T.G = 1; const int L = full + (S.c >> 1); if (L >= S.nwg) return false;
        T.c = L; const bool ok = T.next(0, u); u.hs = S.c & 1; return ok;
    }
    __device__ __forceinline__ void a_ready(const Unit&) const {}
    __device__ __forceinline__ void done(const Unit&) const {}
};
}

constexpr int NWAVES = 8;
constexpr int NB = 4, SEQ = 4096, DM = 1024, TT = NB * SEQ, DH = 512, NHEAD = 8, HD = 64, NEXP = 32, TOPK = 4, INCOLS = 2560, NMOD = 6 * DM, DE2 = 2048;
constexpr float NORM_EPS = 1e-6f;
constexpr float C2 = 0.125f * 1.4426950408889634f;
constexpr float SC_H = 16.0f, SC_W = 512.0f, SC_ACT = 4.0f, SC_Y = 4.0f;
constexpr int MAXSLOT = TT * TOPK + NEXP * 256, MAXTILE = MAXSLOT / 256;
#ifndef MK_N_LAUNCHES
#define MK_N_LAUNCHES 1
#endif
constexpr int PER_PHASE = 11;
constexpr int N_LAUNCHES = MK_N_LAUNCHES;

constexpr size_t MiB = 1u << 20;
constexpr size_t WS_CTL = 0, CTL_ZERO_BYTES = 1 * MiB;
constexpr size_t WS_MISC = 1 * MiB;
constexpr size_t WS_WRT = 2 * MiB;
constexpr size_t WS_WIN = 3 * MiB, WS_WOUT = 8 * MiB, WS_WGU = 16 * MiB, WS_WD = 144 * MiB;
constexpr size_t WS_XN = 208 * MiB, WS_QKV = 240 * MiB, WS_OP = 320 * MiB, WS_LSE = 368 * MiB, WS_MIX = 370 * MiB, WS_X1 = 402 * MiB;
constexpr size_t WS_ROUTE = 466 * MiB;
constexpr size_t WS_XG = 468 * MiB, WS_ACT = 612 * MiB, WS_MODP = 756 * MiB, WS_END = 758 * MiB;
constexpr int CW_TMO = 0, CW_CODE = 1, CW_BAR = 4096, CW_CNT = 8192, CW_RFLAG = 12288, CW_MOD = 16384, CW_RX = 65536;
static_assert((size_t)CW_RX * 4 + (size_t)NB * 8 * 16 * 64 * 8 <= CTL_ZERO_BYTES, "ctl rx");
static_assert((CW_MOD + NB * NMOD) * 4 <= (int)CTL_ZERO_BYTES, "ctl");
constexpr int RING_OFF = 0, RING_BYTES = 131072, LDSCTL_OFF = RING_BYTES, MISC_OFF = LDSCTL_OFF + 320, SUMM_OFF = RING_BYTES + 1024, TILE_OFF = SUMM_OFF + 4096, ROWTAB_OFF = TILE_OFF + 1024, ROWTAB_UNITS = 9, LDS_BYTES = 147456;
static_assert(ROWTAB_OFF + ROWTAB_UNITS * 1024 <= LDS_BYTES && (MAXTILE * 8 + 255) / 256 <= ROWTAB_UNITS, "lds");
#define GAS __attribute__((address_space(1)))
#define LAS __attribute__((address_space(3)))
typedef unsigned short bf16;
typedef unsigned v4u __attribute__((ext_vector_type(4)));
typedef float f32x4 __attribute__((ext_vector_type(4)));
typedef short bf16x8 __attribute__((ext_vector_type(8)));
typedef GAS unsigned gu32;
typedef GAS unsigned long long gu64;
#define RLX_AGENT __ATOMIC_RELAXED, __HIP_MEMORY_SCOPE_AGENT
#define LDS_WAIT() asm volatile("s_waitcnt lgkmcnt(0)" ::: "memory")
#define VM_WAIT() asm volatile("s_waitcnt vmcnt(0)" ::: "memory")
__device__ __forceinline__ unsigned long long rt() { return __builtin_amdgcn_s_memrealtime(); }
__device__ __forceinline__ unsigned f2bf(float f) { unsigned u = __builtin_bit_cast(unsigned, f); return (u + 0x7fffu + ((u >> 16) & 1u)) >> 16; }
__device__ __forceinline__ unsigned pk2(float lo, float hi) { return f2bf(lo) | (f2bf(hi) << 16); }

#define XB_EARLY_INV 1
#define XB_TMO      128
#define XB_XCNT(j)  (256  + 64 * (j))
#define XB_XSUB(j)  (1280 + 64 * (j))
#define XB_XGEN(j)  (2304 + 64 * (j))
#define XB_TOP      3328
#define XB_TOPGEN   3392
#define XCD_BAR_WORDS 3456
#define XB_SPIN_CAP (1u << 18)

__device__ __forceinline__ unsigned xb_ld(unsigned* p)              { return __hip_atomic_load(p, __ATOMIC_RELAXED, __HIP_MEMORY_SCOPE_AGENT); }
__device__ __forceinline__ unsigned xb_add(unsigned* p, unsigned v) { return __hip_atomic_fetch_add(p, v, __ATOMIC_RELAXED, __HIP_MEMORY_SCOPE_AGENT); }
__device__ __forceinline__ unsigned xb_xcc_id() { return (unsigned)__builtin_amdgcn_s_getreg((3 << 11) | 20) & 0xFu; }
#define XB_SPIN(cond, bar) do { unsigned _sp = 0; while (cond) { __builtin_amdgcn_s_sleep(1); \
    if ((++_sp & 255u) == 0u) { if (xb_ld(&(bar)[XB_TMO])) break; if (_sp > XB_SPIN_CAP) { atomicAdd(&(bar)[XB_TMO], 1u); break; } } } } while (0)

struct XcdBarrier {
    unsigned* bar; unsigned x;
    volatile LAS unsigned* st;
};

__device__ __forceinline__ XcdBarrier xcd_barrier_post(unsigned* bar, volatile LAS unsigned* st) {
    XcdBarrier b; b.bar = bar; b.x = xb_xcc_id(); b.st = st;
    if (threadIdx.x == 0) (void)xb_add(&bar[XB_XCNT(b.x)], 1u);
    return b;
}
__device__ __forceinline__ void xcd_barrier_complete(unsigned* bar, unsigned x, unsigned& nloc, unsigned& nx) {
    const unsigned G = gridDim.x * gridDim.y * gridDim.z;
    unsigned sum, cnt, mine, sp = 0u;
    for (;;) {
        sum = 0u; cnt = 0u; mine = 0u;
#pragma unroll
        for (unsigned j = 0; j < 16; ++j) { const unsigned c = xb_ld(&bar[XB_XCNT(j)]); sum += c; cnt += (c > 0u) ? 1u : 0u; mine = (j == x) ? c : mine; }
        if (sum == G) break;
        __builtin_amdgcn_s_sleep(1);
        if ((++sp & 255u) == 0u) { if (xb_ld(&bar[XB_TMO])) break; if (sp > XB_SPIN_CAP) { atomicAdd(&bar[XB_TMO], 1u); break; } }
    }
    nloc = mine > 0u ? mine : 1u; nx = cnt > 0u ? cnt : 1u;
}

__device__ __forceinline__ void xcd_barrier(const XcdBarrier& b) {
    asm volatile("s_waitcnt vmcnt(0)" ::: "memory");
    __syncthreads();
    if (threadIdx.x == 0) {
        unsigned* bar = b.bar;
        __builtin_amdgcn_s_waitcnt(0);
        unsigned nloc = b.st[0], nx = b.st[1];
        if (nloc == 0u) { xcd_barrier_complete(bar, b.x, nloc, nx); b.st[0] = nloc; b.st[1] = nx; }
        const unsigned old = xb_add(&bar[XB_XSUB(b.x)], 1u);
        const unsigned gen = old / nloc;
#ifdef XB_EARLY_INV
        __builtin_amdgcn_fence(__ATOMIC_ACQUIRE, "agent");
#endif
        if (old + 1u == (gen + 1u) * nloc) {
            __builtin_amdgcn_fence(__ATOMIC_RELEASE, "agent");
            asm volatile("s_waitcnt vmcnt(0)" ::: "memory");
            const unsigned og = xb_add(&bar[XB_TOP], 1u);
            const unsigned tg = og / nx;
            if (og + 1u == (tg + 1u) * nx) xb_add(&bar[XB_TOPGEN], 1u);
            else XB_SPIN(xb_ld(&bar[XB_TOPGEN]) == tg, bar);
#ifndef XB_EARLY_INV
            __builtin_amdgcn_fence(__ATOMIC_ACQUIRE, "agent");
#endif
            xb_add(&bar[XB_XGEN(b.x)], 1u);
            asm volatile("s_waitcnt vmcnt(0)" ::: "memory");
        } else {
            XB_SPIN(xb_ld(&bar[XB_XGEN(b.x)]) == gen, bar);
#ifndef XB_EARLY_INV
            __builtin_amdgcn_fence(__ATOMIC_ACQUIRE, "agent");
#endif
            asm volatile("s_waitcnt vmcnt(0)" ::: "memory");
        }
    }
    __syncthreads();
}

typedef float f32x16 __attribute__((ext_vector_type(16)));
typedef short v4i16_t __attribute__((ext_vector_type(4)));
typedef unsigned v2u __attribute__((ext_vector_type(2)));
struct Frame {
    LAS unsigned char* lds;
    int tid, lane, wave, vcu, G;
    unsigned char* ws;
    const __attribute__((address_space(4))) void* ka;
    __device__ __forceinline__ const float* in(int k) const {
        const unsigned long long v = *(const volatile __attribute__((address_space(4))) unsigned long long*)((const __attribute__((address_space(4))) char*)ka + 8 * k);
        const unsigned lo = (unsigned)__builtin_amdgcn_readfirstlane((int)(unsigned)v), hi = (unsigned)__builtin_amdgcn_readfirstlane((int)(unsigned)(v >> 32));
        return (const float*)(const GAS float*)(((unsigned long long)hi << 32) | lo);
    }
};
enum InIdx { I_x = 0, I_c, I_w_ada, I_b_ada, I_g_mix, I_w_in, I_conv_w, I_conv_b, I_w_rg_a, I_b_rg_a, I_w_rg_x, I_b_rg_x, I_lam, I_w_out, I_g_ffn, I_w_router, I_b_router, I_w_gate_up, I_b_gate_up, I_w_down, I_b_down, I_g_final };
#define WSP(T, off) ((T*)(F.ws + (off)))
#define P_MOD   (WSP(float, WS_CTL) + CW_MOD)
#define P_BCNT  WSP(int, WS_MISC + 8192)
#define P_TILE_E WSP(int, WS_MISC)
#define P_TILE_N WSP(int, WS_MISC + 4096)
#define P_RSUM  WSP(float, WS_MISC + 65536)
#define P_WRT   WSP(float, WS_WRT)
#define P_WA_T  WSP(bf16, WS_WRT + 262144)
#define P_WX_T  WSP(bf16, WS_WRT + 393216)
#define P_WIN_T WSP(bf16, WS_WIN)
#define P_WOUT_T WSP(bf16, WS_WOUT)
#define P_WGU8 WSP(unsigned char, WS_WGU)
#define P_WD8  WSP(unsigned char, WS_WD)
#define P_XN    WSP(bf16, WS_XN)
#define P_QB    WSP(bf16, WS_QKV)
#define P_KB    (WSP(bf16, WS_QKV) + (size_t)TT * DH)
#define P_VB    (WSP(bf16, WS_QKV) + (size_t)2 * TT * DH)
#define P_XR    (WSP(bf16, WS_QKV) + (size_t)3 * TT * DH)
#define P_GR    (WSP(bf16, WS_QKV) + (size_t)4 * TT * DH)
#define P_OP    WSP(bf16, WS_OP)
#define P_LSE   WSP(float, WS_LSE)
#define P_MIX   WSP(bf16, WS_MIX)
#define P_X1    WSP(bf16, WS_X1)
#define P_TOK_E WSP(int, WS_ROUTE)
#define P_TOK_POS (WSP(int, WS_ROUTE) + TT * TOPK)
#define P_TOK_GATE (WSP(float, WS_ROUTE) + 2 * TT * TOPK)
#define P_TOK_SLOT (WSP(int, WS_ROUTE) + 3 * TT * TOPK)
#define P_SLOT_TOK (WSP(int, WS_ROUTE + 1048576))
#define P_Y2    WSP(bf16, WS_XG)
#define P_XN8   WSP(unsigned char, WS_XN)
#define P_ACT8  WSP(unsigned char, WS_ACT)
__device__ __forceinline__ float bf2f(unsigned short v) { return __uint_as_float(((unsigned)v) << 16); }
template <int N> __device__ __forceinline__ float dpp_ror(float v) { return __builtin_bit_cast(float, __builtin_amdgcn_update_dpp(0, __builtin_bit_cast(int, v), 0x120 + N, 0xf, 0xf, false)); }
__device__ __forceinline__ float row_sum16(float v) { v += dpp_ror<8>(v); v += dpp_ror<4>(v); v += dpp_ror<2>(v); v += dpp_ror<1>(v); return v; }
__device__ __forceinline__ float row_max16(float v) { v = fmaxf(v, dpp_ror<8>(v)); v = fmaxf(v, dpp_ror<4>(v)); v = fmaxf(v, dpp_ror<2>(v)); v = fmaxf(v, dpp_ror<1>(v)); return v; }
__device__ __forceinline__ float wave_sum(float v) {
    v = row_sum16(v);
    const float s0 = __builtin_bit_cast(float, __builtin_amdgcn_readlane(__builtin_bit_cast(int, v), 0)), s1 = __builtin_bit_cast(float, __builtin_amdgcn_readlane(__builtin_bit_cast(int, v), 16)),
                s2 = __builtin_bit_cast(float, __builtin_amdgcn_readlane(__builtin_bit_cast(int, v), 32)), s3 = __builtin_bit_cast(float, __builtin_amdgcn_readlane(__builtin_bit_cast(int, v), 48));
    return ((s0 + s1) + s2) + s3;
}
__device__ __forceinline__ float wave_max(float v) {
#pragma unroll
    for (int o = 1; o < 64; o <<= 1) v = fmaxf(v, __shfl_xor(v, o));
    return v;
}
__device__ __forceinline__ int crow(int r, int hi) { return (r & 3) + 8 * (r >> 2) + 4 * hi; }

__device__ __forceinline__ void p0_transpose_item(const float* W, int K, int N, bf16* WT, int k0, int n0, int drow0, LAS float* scr, int lane) {
#pragma unroll 8
    for (int i = 0; i < 32; ++i) { const int kk = 2 * i + (lane >> 5); scr[kk * 33 + (lane & 31)] = W[(size_t)(k0 + kk) * N + n0 + (lane & 31)]; }
    LDS_WAIT(); asm volatile("" ::: "memory");
    const int c = lane & 7;
#pragma unroll
    for (int j = 0; j < 4; ++j) { const int n = (lane >> 3) + 8 * j; const LAS float* s = scr + (8 * c) * 33 + n;
        v4u o; o.x = pk2(s[0 * 33], s[1 * 33]); o.y = pk2(s[2 * 33], s[3 * 33]); o.z = pk2(s[4 * 33], s[5 * 33]); o.w = pk2(s[6 * 33], s[7 * 33]);
        *(GAS v4u*)(WT + (size_t)(drow0 + n) * K + k0 + 8 * c) = o; }
    LDS_WAIT(); asm volatile("" ::: "memory");
}
__device__ __forceinline__ void p0_transpose_item8(const float* W, int K, int N, unsigned char* WT, int k0, int n0, int drow0, float sc, LAS float* scr, int lane) {
#pragma unroll 8
    for (int i = 0; i < 32; ++i) { const int kk = 2 * i + (lane >> 5); scr[kk * 33 + (lane & 31)] = W[(size_t)(k0 + kk) * N + n0 + (lane & 31)]; }
    LDS_WAIT(); asm volatile("" ::: "memory");
    const int c = lane & 7;
#pragma unroll
    for (int j = 0; j < 4; ++j) { const int n = (lane >> 3) + 8 * j; const LAS float* s = scr + (8 * c) * 33 + n;
        v2u o; o.x = pg8::pk4_fp8(s[0 * 33] * sc, s[1 * 33] * sc, s[2 * 33] * sc, s[3 * 33] * sc); o.y = pg8::pk4_fp8(s[4 * 33] * sc, s[5 * 33] * sc, s[6 * 33] * sc, s[7 * 33] * sc);
        *(GAS v2u*)(WT + (size_t)(drow0 + n) * K + k0 + 8 * c) = o; }
    LDS_WAIT(); asm volatile("" ::: "memory");
}
struct TDesc { const float* src; unsigned char* dst; int N, K, k0, n0, drow0, fp8; };
__device__ __forceinline__ void p0_dma_issue(const TDesc& d, LAS unsigned char* buf, int lane) {
    const __amdgpu_buffer_rsrc_t rs = __builtin_amdgcn_make_buffer_rsrc((void*)d.src, 0, 0x7ffffff0, 0x00020000);
#pragma unroll
    for (int j = 0; j < 16; ++j) { const int voff = ((lane >> 3) * d.N + 4 * ((lane & 7) ^ (j & 7))) * 4, soff = ((d.k0 + 8 * j) * d.N + d.n0) * 4;
        __builtin_amdgcn_raw_ptr_buffer_load_lds(rs, (LAS unsigned*)(buf + j * 1024), 16, voff, soff, 0, 0); }
}
__device__ __forceinline__ void p0_read(LAS unsigned char* buf, int lane, f32x4 (&f)[2][8]) {
    const int c = lane & 15;
#pragma unroll
    for (int jj = 0; jj < 2; ++jj) { const int nq = (lane >> 4) + 4 * jj; const LAS unsigned char* s = buf + (8 * c) * 128 + ((nq ^ (c & 7)) * 16);
#pragma unroll
        for (int i = 0; i < 8; ++i) f[jj][i] = *(const LAS f32x4*)(s + i * 128); }
}
__device__ __forceinline__ void p0_emit(const TDesc& d, int lane, const f32x4 (&f)[2][8]) {
    const int c = lane & 15;
#pragma unroll
    for (int jj = 0; jj < 2; ++jj)
#pragma unroll
        for (int t = 0; t < 4; ++t) { const int n = 4 * ((lane >> 4) + 4 * jj) + t;
            if (d.fp8) { v2u o; o.x = pg8::pk4_fp8(f[jj][0][t] * SC_W, f[jj][1][t] * SC_W, f[jj][2][t] * SC_W, f[jj][3][t] * SC_W); o.y = pg8::pk4_fp8(f[jj][4][t] * SC_W, f[jj][5][t] * SC_W, f[jj][6][t] * SC_W, f[jj][7][t] * SC_W);
                *(GAS v2u*)(d.dst + (size_t)(d.drow0 + n) * d.K + d.k0 + 8 * c) = o; }
            else { v4u o; o.x = pk2(f[jj][0][t], f[jj][1][t]); o.y = pk2(f[jj][2][t], f[jj][3][t]); o.z = pk2(f[jj][4][t], f[jj][5][t]); o.w = pk2(f[jj][6][t], f[jj][7][t]);
                *(GAS v4u*)((bf16*)d.dst + (size_t)(d.drow0 + n) * d.K + d.k0 + 8 * c) = o; } }
}
constexpr int PT_WGU = NEXP * 8 * 64, PT_WD = NEXP * 8 * 32, PT_WIN = 8 * 80, PT_WOUT = 8 * 32, P0T_EXPERTS = PT_WGU + PT_WD, P0T_ALL = P0T_EXPERTS + PT_WIN + PT_WOUT;
__device__ __forceinline__ void p0_transposes(Frame& F, int lo, int hi, int rank = -1, int nranks = 0) {
    const int lane = F.lane;
    const float *in_w_in = F.in(I_w_in), *in_w_out = F.in(I_w_out), *in_w_gate_up = F.in(I_w_gate_up), *in_w_down = F.in(I_w_down);
    const int gw = (rank < 0 ? F.vcu : rank) * NWAVES + F.wave, NGW = (rank < 0 ? F.G : nranks) * NWAVES;
    LAS unsigned char* lb = F.lds + RING_OFF + F.wave * 16384;
#define P0_DECODE(IT, D) do { int r = (IT); \
        if (r < PT_WGU) { const int e = r >> 9, rr = r & 511, kb = rr >> 6, nb = rr & 63, n0 = 32 * nb, j = n0 & 1023; \
            (D).src = in_w_gate_up + (size_t)e * DM * DE2; (D).dst = P_WGU8 + (size_t)e * DE2 * DM; (D).N = DE2; (D).K = DM; (D).k0 = 128 * kb; (D).n0 = n0; (D).drow0 = (j >> 7) * 256 + (n0 >= 1024 ? 128 : 0) + (j & 127); (D).fp8 = 1; break; } \
        r -= PT_WGU; \
        if (r < PT_WD) { const int e = r >> 8, rr = r & 255, kb = rr >> 5, nb = rr & 31; \
            (D).src = in_w_down + (size_t)e * DM * DM; (D).dst = P_WD8 + (size_t)e * DM * DM; (D).N = DM; (D).K = DM; (D).k0 = 128 * kb; (D).n0 = 32 * nb; (D).drow0 = 32 * nb; (D).fp8 = 1; break; } \
        r -= PT_WD; \
        if (r < PT_WIN) { const int kb = r / 80, nb = r % 80; (D).src = in_w_in; (D).dst = (unsigned char*)P_WIN_T; (D).N = INCOLS; (D).K = DM; (D).k0 = 128 * kb; (D).n0 = 32 * nb; (D).drow0 = 32 * nb; (D).fp8 = 0; break; } \
        r -= PT_WIN; \
        { const int kb = r / 32, nb = r % 32; (D).src = in_w_out; (D).dst = (unsigned char*)P_WOUT_T; (D).N = DM; (D).K = DM; (D).k0 = 128 * kb; (D).n0 = 32 * nb; (D).drow0 = 32 * nb; (D).fp8 = 0; } \
    } while (0)
    int it = lo + gw;
    if (it < hi) {
        TDesc d, d1; P0_DECODE(it, d); d1 = d;
        p0_dma_issue(d, lb, lane);
        asm volatile("s_waitcnt vmcnt(0)" ::: "memory");
        for (;;) {
            f32x4 f[2][8]; p0_read(lb, lane, f);
            LDS_WAIT(); asm volatile("" ::: "memory");
            const bool has = it + NGW < hi;
            if (has) { P0_DECODE(it + NGW, d1); p0_dma_issue(d1, lb, lane); }
            p0_emit(d, lane, f);
            asm volatile("" ::: "memory");
            if (!has) break;
            asm volatile("s_waitcnt vmcnt(8)" ::: "memory");
            it += NGW; d = d1;
        }
    }
#undef P0_DECODE
}
__device__ __forceinline__ void p0_prologue(Frame& F) {
    const int lane = F.lane;
    const float *in_w_ada = F.in(I_w_ada), *in_c = F.in(I_c), *in_b_ada = F.in(I_b_ada), *in_w_in = F.in(I_w_in), *in_w_out = F.in(I_w_out), *in_w_gate_up = F.in(I_w_gate_up), *in_w_down = F.in(I_w_down),
        *in_w_rg_a = F.in(I_w_rg_a), *in_w_rg_x = F.in(I_w_rg_x), *in_w_router = F.in(I_w_router);
    const int gw = F.vcu * NWAVES + F.wave, NGW = F.G * NWAVES;
    for (int cb = F.vcu; cb < NMOD / 24; cb += F.G) {
        LAS f32x4* part = (LAS f32x4*)(F.lds + RING_OFF);
        const int q = lane % 6, kk = lane / 6, col0 = cb * 24;
        if (kk < 8) { const int kb = F.wave * 128 + kk * 16;
            f32x4 a[4] = {(f32x4){0.f, 0.f, 0.f, 0.f}, (f32x4){0.f, 0.f, 0.f, 0.f}, (f32x4){0.f, 0.f, 0.f, 0.f}, (f32x4){0.f, 0.f, 0.f, 0.f}};
#pragma unroll
            for (int hf = 0; hf < 2; ++hf) {
                f32x4 wv[8];
#pragma unroll
                for (int t = 0; t < 8; ++t) wv[t] = *(const f32x4*)(in_w_ada + (size_t)(kb + 8 * hf + t) * NMOD + col0 + 4 * q);
#pragma unroll
                for (int b4 = 0; b4 < 4; ++b4) { const f32x4 c0 = *(const f32x4*)(in_c + b4 * DM + kb + 8 * hf), c1 = *(const f32x4*)(in_c + b4 * DM + kb + 8 * hf + 4);
                    a[b4] += c0.x * wv[0]; a[b4] += c0.y * wv[1]; a[b4] += c0.z * wv[2]; a[b4] += c0.w * wv[3]; a[b4] += c1.x * wv[4]; a[b4] += c1.y * wv[5]; a[b4] += c1.z * wv[6]; a[b4] += c1.w * wv[7]; }
                asm volatile("" ::: "memory"); }
#pragma unroll
            for (int b4 = 0; b4 < 4; ++b4) part[((F.wave * 8 + kk) * 6 + q) * 4 + b4] = a[b4]; }
        LDS_WAIT(); __syncthreads();
        if (F.tid < 96) { const int b4 = F.tid / 24, cc = F.tid % 24, qq = cc >> 2, comp = cc & 3; float s = 0.f;
            for (int p = 0; p < 64; ++p) s += part[(p * 6 + qq) * 4 + b4][comp];
            P_MOD[(size_t)b4 * NMOD + col0 + cc] = s + in_b_ada[col0 + cc]; }
        LDS_WAIT(); __syncthreads();
    }
    for (int r = gw; r < 512; r += NGW) { const int idx = r * 64 + lane, e = idx >> 10, k = idx & 1023; P_WRT[idx] = in_w_router[k * NEXP + e]; }
    asm volatile("s_waitcnt vmcnt(0)" ::: "memory");
    p0_transposes(F, P0T_EXPERTS, P0T_ALL);
    asm volatile("s_waitcnt vmcnt(0)" ::: "memory"); LDS_WAIT();
    for (int r = gw; r < 32; r += NGW) { const int which = r >> 4, rr = r & 15, n = rr >> 1, nb = rr & 1;
        p0_transpose_item((which ? in_w_rg_x : in_w_rg_a) + n * 4096, 64, 64, (which ? P_WX_T : P_WA_T) + n * 4096, 0, 32 * nb, 32 * nb, (LAS float*)(F.lds + RING_OFF + F.wave * 16384), lane); }
}
__device__ __forceinline__ void p1_norm(Frame& F) {
    const float* in_x = F.in(I_x); const float* in_g_mix = F.in(I_g_mix);
    const int gw = F.vcu * NWAVES + F.wave, NGW = F.G * NWAVES, lane = F.lane;
    for (int m = gw; m < TT; m += NGW) {
        const int b = m / SEQ;
        const GAS f32x4* xr = (const GAS f32x4*)(in_x + (size_t)m * DM) + lane;
        f32x4 v[4]; float ss = 0.f;
#pragma unroll
        for (int j = 0; j < 4; ++j) { v[j] = xr[64 * j]; ss += (v[j].x * v[j].x + v[j].y * v[j].y) + (v[j].z * v[j].z + v[j].w * v[j].w); }
        const float rstd = 1.0f / sqrtf(wave_sum(ss) * (1.0f / DM) + NORM_EPS);
        const float* mb = P_MOD + (size_t)b * NMOD;
#pragma unroll
        for (int j = 0; j < 4; ++j) { const int col = 4 * lane + 256 * j;
            const f32x4 g = *(const f32x4*)(in_g_mix + col), sc = *(const f32x4*)(mb + DM + col), sh = *(const f32x4*)(mb + col);
            const f32x4 h = (v[j] * rstd) * g * (sc + 1.0f) + sh;
            v2u o; o.x = pk2(h.x, h.y); o.y = pk2(h.z, h.w); *(GAS v2u*)(P_XN + (size_t)m * DM + col) = o; }
        asm volatile("" ::: "memory");
    }
}
template <bool FINAL> __device__ __forceinline__ void rglru_items(Frame& F) {
    LAS unsigned char* wl = F.lds + RING_OFF + F.wave * 16384;
    LAS float* summ = (LAS float*)(F.lds + SUMM_OFF);
    const float* in_conv_w = F.in(I_conv_w); const float* in_conv_b = F.in(I_conv_b); const float* in_b_rg_a = F.in(I_b_rg_a); const float* in_b_rg_x = F.in(I_b_rg_x); const float* in_lam = F.in(I_lam);
    const int lane = F.lane, w = F.wave;
    for (int it = F.vcu; it < NB * 8 * 16; it += F.G) {
        const int sp = it & 15, n = (it >> 4) & 7, b = it >> 7;
        const int gc = n * 64 + lane, t0 = sp * 256 + w * 32;
        const bf16* xrp = P_XR + ((size_t)b * SEQ) * DH + gc;
        float xin[35];
#pragma unroll
        for (int i = 0; i < 35; ++i) { const int tt = t0 - 3 + i, tc = tt < 0 ? 0 : tt; const float v = bf2f(xrp[(size_t)tc * DH]); xin[i] = tt < 0 ? 0.f : v; }
        const float cw0 = in_conv_w[gc], cw1 = in_conv_w[DH + gc], cw2 = in_conv_w[2 * DH + gc], cw3 = in_conv_w[3 * DH + gc], cb = in_conv_b[gc];
        float xc[32];
#pragma unroll
        for (int t = 0; t < 32; ++t) xc[t] = ((cw0 * xin[t] + cw1 * xin[t + 1]) + (cw2 * xin[t + 2] + cw3 * xin[t + 3])) + cb;
        LAS unsigned short* w16 = (LAS unsigned short*)wl;
#pragma unroll
        for (int t = 0; t < 32; ++t) w16[t * 64 + lane] = (unsigned short)f2bf(xc[t]);
        LDS_WAIT(); asm volatile("" ::: "memory");
        const int tok = lane & 31, hh = lane >> 5;
        bf16x8 af[4];
#pragma unroll
        for (int s = 0; s < 4; ++s) af[s] = *(const LAS bf16x8*)(wl + (tok * 64 + 16 * s + 8 * hh) * 2);
        f32x16 ga[2], gx[2];
#pragma unroll
        for (int nt = 0; nt < 2; ++nt) { ga[nt] = f32x16{}; gx[nt] = f32x16{};
            const size_t wo = ((size_t)(n * 64 + tok + 32 * nt)) * 64 + 8 * hh;
#pragma unroll
            for (int s = 0; s < 4; ++s) { const bf16x8 ba = *(const GAS bf16x8*)(P_WA_T + wo + 16 * s), bx = *(const GAS bf16x8*)(P_WX_T + wo + 16 * s);
                ga[nt] = __builtin_amdgcn_mfma_f32_32x32x16_bf16(af[s], ba, ga[nt], 0, 0, 0); gx[nt] = __builtin_amdgcn_mfma_f32_32x32x16_bf16(af[s], bx, gx[nt], 0, 0, 0); } }
        LDS_WAIT(); asm volatile("" ::: "memory");
        LAS float* wf = (LAS float*)wl;
#pragma unroll
        for (int nt = 0; nt < 2; ++nt)
#pragma unroll
            for (int rr = 0; rr < 16; ++rr) { const int tr = crow(rr, hh); wf[tr * 64 + tok + 32 * nt] = ga[nt][rr]; wf[2048 + tr * 64 + tok + 32 * nt] = gx[nt][rr]; }
        LDS_WAIT(); asm volatile("" ::: "memory");
        const float ba_ = in_b_rg_a[gc], bx_ = in_b_rg_x[gc], spc = log1pf(expf(-in_lam[gc]));
        float av[32], uv[32];
#pragma unroll
        for (int t = 0; t < 32; ++t) { const float pa = wf[t * 64 + lane] + ba_, px = wf[2048 + t * 64 + lane] + bx_;
            const float rg = __builtin_amdgcn_rcpf(1.0f + __builtin_amdgcn_exp2f(-1.4426950408889634f * pa)), ig = __builtin_amdgcn_rcpf(1.0f + __builtin_amdgcn_exp2f(-1.4426950408889634f * px));
            const float a = __builtin_amdgcn_exp2f((-8.0f * 1.4426950408889634f) * rg * spc);
            av[t] = a; uv[t] = __builtin_amdgcn_sqrtf(fmaxf(1.0f - a * a, 0.f)) * (ig * xc[t]); }
        LDS_WAIT(); asm volatile("" ::: "memory");
        float h = 0.f, P = 1.f;
#pragma unroll
        for (int t = 0; t < 32; ++t) { h = av[t] * h + uv[t]; P *= av[t]; }
        summ[(w * 64 + lane) * 2] = P; summ[(w * 64 + lane) * 2 + 1] = h;
        LDS_WAIT(); __syncthreads();
        if (!FINAL) {
            if (w == 0) { float Pt = 1.f, Ht = 0.f;
#pragma unroll
                for (int q = 0; q < 8; ++q) { const float p = summ[(q * 64 + lane) * 2], hq = summ[(q * 64 + lane) * 2 + 1]; Ht = p * Ht + hq; Pt *= p; }
                float* o = P_RSUM + ((size_t)(b * 16 + sp) * DH + gc) * 2; o[0] = Pt; o[1] = Ht; }
        } else {
            float hc = 0.f;
            { float pq[16], hq[16];
#pragma unroll
              for (int q = 0; q < 16; ++q) { const float* r2 = P_RSUM + ((size_t)(b * 16 + (q < sp ? q : 0)) * DH + gc) * 2; pq[q] = r2[0]; hq[q] = r2[1]; }
#pragma unroll
              for (int q = 0; q < 16; ++q) if (q < sp) hc = pq[q] * hc + hq[q]; }
            for (int q = 0; q < w; ++q) hc = summ[(q * 64 + lane) * 2] * hc + summ[(q * 64 + lane) * 2 + 1];
            h = hc;
            const bf16* grp = P_GR + ((size_t)b * SEQ + t0) * DH + gc; bf16* op = P_MIX + ((size_t)b * SEQ + t0) * DM + DH + gc;
            float gv[32];
#pragma unroll
            for (int t = 0; t < 32; ++t) gv[t] = bf2f(grp[(size_t)t * DH]);
            asm volatile("s_waitcnt vmcnt(0)" ::: "memory");
#pragma unroll
            for (int t = 0; t < 32; ++t) { h = av[t] * h + uv[t]; const float g = gv[t]; const float y = 0.7978845608028654f * (g + 0.044715f * g * g * g);
                const float th = 1.0f - 2.0f * __builtin_amdgcn_rcpf(1.0f + __builtin_amdgcn_exp2f((2.0f * 1.4426950408889634f) * y)); op[(size_t)t * DM] = (bf16)f2bf(h * (0.5f * g * (1.0f + th))); }
        }
        asm volatile("s_waitcnt vmcnt(0)" ::: "memory");
        LDS_WAIT(); __syncthreads();
    }
}
__device__ __forceinline__ void rglru_single(Frame& F) {
    LAS unsigned char* wl = F.lds + RING_OFF + F.wave * 16384;
    LAS float* summ = (LAS float*)(F.lds + SUMM_OFF);
    const float* in_conv_w = F.in(I_conv_w); const float* in_conv_b = F.in(I_conv_b); const float* in_b_rg_a = F.in(I_b_rg_a); const float* in_b_rg_x = F.in(I_b_rg_x); const float* in_lam = F.in(I_lam);
    const int lane = F.lane, w = F.wave;
    for (int it = F.vcu; it < NB * 8 * 16; it += F.G) {
        const int sp = it & 15, n = (it >> 4) & 7, b = it >> 7;
        const int gc = n * 64 + lane, t0 = sp * 256 + w * 32;
        const bf16* xrp = P_XR + ((size_t)b * SEQ) * DH + gc;
        float xin[35];
#pragma unroll
        for (int i = 0; i < 35; ++i) { const int tt = t0 - 3 + i, tc = tt < 0 ? 0 : tt; const float v = bf2f(xrp[(size_t)tc * DH]); xin[i] = tt < 0 ? 0.f : v; }
        const float cw0 = in_conv_w[gc], cw1 = in_conv_w[DH + gc], cw2 = in_conv_w[2 * DH + gc], cw3 = in_conv_w[3 * DH + gc], cb = in_conv_b[gc];
        float xc[32];
#pragma unroll
        for (int t = 0; t < 32; ++t) xc[t] = ((cw0 * xin[t] + cw1 * xin[t + 1]) + (cw2 * xin[t + 2] + cw3 * xin[t + 3])) + cb;
        LAS unsigned short* w16 = (LAS unsigned short*)wl;
#pragma unroll
        for (int t = 0; t < 32; ++t) w16[t * 64 + lane] = (unsigned short)f2bf(xc[t]);
        LDS_WAIT(); asm volatile("" ::: "memory");
        const int tok = lane & 31, hh = lane >> 5;
        bf16x8 af[4];
#pragma unroll
        for (int s = 0; s < 4; ++s) af[s] = *(const LAS bf16x8*)(wl + (tok * 64 + 16 * s + 8 * hh) * 2);
        f32x16 ga[2], gx[2];
#pragma unroll
        for (int nt = 0; nt < 2; ++nt) { ga[nt] = f32x16{}; gx[nt] = f32x16{};
            const size_t wo = ((size_t)(n * 64 + tok + 32 * nt)) * 64 + 8 * hh;
#pragma unroll
            for (int s = 0; s < 4; ++s) { const bf16x8 ba = *(const GAS bf16x8*)(P_WA_T + wo + 16 * s), bx = *(const GAS bf16x8*)(P_WX_T + wo + 16 * s);
                ga[nt] = __builtin_amdgcn_mfma_f32_32x32x16_bf16(af[s], ba, ga[nt], 0, 0, 0); gx[nt] = __builtin_amdgcn_mfma_f32_32x32x16_bf16(af[s], bx, gx[nt], 0, 0, 0); } }
        LDS_WAIT(); asm volatile("" ::: "memory");
        LAS float* wf = (LAS float*)wl;
#pragma unroll
        for (int nt = 0; nt < 2; ++nt)
#pragma unroll
            for (int rr = 0; rr < 16; ++rr) { const int tr = crow(rr, hh); wf[tr * 64 + tok + 32 * nt] = ga[nt][rr]; wf[2048 + tr * 64 + tok + 32 * nt] = gx[nt][rr]; }
        LDS_WAIT(); asm volatile("" ::: "memory");
        const float ba_ = in_b_rg_a[gc], bx_ = in_b_rg_x[gc], spc = log1pf(expf(-in_lam[gc]));
        float av[32], uv[32];
        typedef float f32x2_g __attribute__((ext_vector_type(2)));
#pragma unroll
        for (int t = 0; t < 32; t += 2) {
            const f32x2_g pa = (f32x2_g){wf[t * 64 + lane], wf[(t + 1) * 64 + lane]} + ba_, px = (f32x2_g){wf[2048 + t * 64 + lane], wf[2048 + (t + 1) * 64 + lane]} + bx_;
            const f32x2_g xa = pa * -1.4426950408889634f, xx = px * -1.4426950408889634f;
            const f32x2_g da = (f32x2_g){__builtin_amdgcn_exp2f(xa.x), __builtin_amdgcn_exp2f(xa.y)} + 1.0f, dx = (f32x2_g){__builtin_amdgcn_exp2f(xx.x), __builtin_amdgcn_exp2f(xx.y)} + 1.0f;
            const f32x2_g rg = (f32x2_g){__builtin_amdgcn_rcpf(da.x), __builtin_amdgcn_rcpf(da.y)}, ig = (f32x2_g){__builtin_amdgcn_rcpf(dx.x), __builtin_amdgcn_rcpf(dx.y)};
            const f32x2_g la = rg * ((-8.0f * 1.4426950408889634f) * spc);
            const f32x2_g a2 = (f32x2_g){__builtin_amdgcn_exp2f(la.x), __builtin_amdgcn_exp2f(la.y)};
            const f32x2_g om = 1.0f - a2 * a2, gx = ig * (f32x2_g){xc[t], xc[t + 1]};
            av[t] = a2.x; av[t + 1] = a2.y;
            uv[t] = __builtin_amdgcn_sqrtf(fmaxf(om.x, 0.f)) * gx.x; uv[t + 1] = __builtin_amdgcn_sqrtf(fmaxf(om.y, 0.f)) * gx.y; }
        LDS_WAIT(); asm volatile("" ::: "memory");
        float h = 0.f, P = 1.f;
#pragma unroll
        for (int t = 0; t < 32; ++t) { h = av[t] * h + uv[t]; P *= av[t]; }
        summ[(w * 64 + lane) * 2] = P; summ[(w * 64 + lane) * 2 + 1] = h;
        LDS_WAIT(); __syncthreads();
        const bf16* grp = P_GR + ((size_t)b * SEQ + t0) * DH + gc; bf16* op = P_MIX + ((size_t)b * SEQ + t0) * DM + DH + gc;
        float gv[32];
#pragma unroll
        for (int t = 0; t < 32; ++t) gv[t] = bf2f(grp[(size_t)t * DH]);
        LAS float* hspan = (LAS float*)(F.lds + TILE_OFF);
        if (w == 0) {
            float Pt = 1.f, Ht = 0.f;
#pragma unroll
            for (int q = 0; q < 8; ++q) { const float p = summ[(q * 64 + lane) * 2], hq = summ[(q * 64 + lane) * 2 + 1]; Ht = p * Ht + hq; Pt *= p; }
            unsigned long long* rx = (unsigned long long*)(F.ws + WS_CTL + (size_t)CW_RX * 4) + ((size_t)((b * 8 + n) * 16) * 64 + lane);
            __hip_atomic_store(rx + sp * 64, ((unsigned long long)__float_as_uint(Ht) << 32) | (unsigned long long)(__float_as_uint(Pt) | 1u), RLX_AGENT);
        }
#pragma unroll
        for (int t = 0; t < 32; ++t) { const float g = gv[t]; const float y = 0.7978845608028654f * (g + 0.044715f * g * g * g);
            const float th = 1.0f - 2.0f * __builtin_amdgcn_rcpf(1.0f + __builtin_amdgcn_exp2f((2.0f * 1.4426950408889634f) * y)); gv[t] = 0.5f * g * (1.0f + th); }
        if (w == 0) {
            unsigned long long* rx = (unsigned long long*)(F.ws + WS_CTL + (size_t)CW_RX * 4) + ((size_t)((b * 8 + n) * 16) * 64 + lane);
            unsigned long long v[15]; unsigned spins = 0u;
            for (;;) { bool ok = true;
#pragma unroll
                for (int q = 0; q < 15; ++q) { v[q] = q < sp ? __hip_atomic_load(rx + q * 64, RLX_AGENT) : 1ull; ok = ok && (v[q] != 0ull); }
                if (__all(ok)) break;
                __builtin_amdgcn_s_sleep(1); if (++spins > (1u << 20)) { if (lane == 0) __hip_atomic_store((unsigned*)(F.ws + WS_CTL) + CW_TMO, 0xA11u, RLX_AGENT); break; } }
            float hc = 0.f;
#pragma unroll
            for (int q = 0; q < 15; ++q) if (q < sp) hc = __uint_as_float((unsigned)v[q]) * hc + __uint_as_float((unsigned)(v[q] >> 32));
            hspan[lane] = hc;
        }
        LDS_WAIT(); __syncthreads();
        {   float hc = hspan[lane];
            for (int q = 0; q < w; ++q) hc = summ[(q * 64 + lane) * 2] * hc + summ[(q * 64 + lane) * 2 + 1];
            h = hc;
#pragma unroll
            for (int t = 0; t < 32; ++t) { h = av[t] * h + uv[t]; op[(size_t)t * DM] = (bf16)f2bf(h * gv[t]); }
        }
        LDS_WAIT(); __syncthreads();
    }
}
typedef float cvt_f32x2 __attribute__((ext_vector_type(2))); typedef __bf16 cvt_bf16x2 __attribute__((ext_vector_type(2)));
__device__ __forceinline__ unsigned cvt2bf(float lo, float hi) { const cvt_f32x2 v = {lo, hi}; return __builtin_bit_cast(unsigned, __builtin_convertvector(v, cvt_bf16x2)); }
struct AttnUnit { int p, dsh, r, L0; size_t hb; };
__device__ __forceinline__ void attn_decode(int u, AttnUnit& a) {
    const int uu = u & 15, bh = (u >> 4) & 31; a.p = u >> 9; a.dsh = 2 * a.p;
    const int spr = 16 >> a.dsh;
    a.r = uu / spr; a.L0 = (uu % spr) * 256; a.hb = ((size_t)(bh >> 3) * SEQ) * DH + (bh & 7) * HD;
}
constexpr int ATT_KS = 144, ATT_VS = 192, ATT_VOFF = 384 * ATT_KS;
static_assert(ATT_VOFF + 384 * ATT_VS <= RING_BYTES, "attention LDS");
__device__ __forceinline__ void attn_items(Frame& F) {
    LAS unsigned char* kl = F.lds + RING_OFF; LAS unsigned char* vl = F.lds + RING_OFF + ATT_VOFF;
    const int lane = F.lane, c = lane & 31, hh = lane >> 5, w = F.wave, tid = F.tid;
    const float NEG = -1e30f;
    const int gi = lane >> 4, li = lane & 15;
    const int tr_base = (4 * hh + (li >> 2)) * ATT_VS + (16 * (gi & 1) + 4 * (li & 3)) * 2;
    const bf16 *QB = P_QB, *KB = P_KB, *VB = P_VB;
    constexpr int NUNIT = 3 * NB * NHEAD * 16;
    int u = F.vcu; if (u >= NUNIT) return;
    AttnUnit cu; attn_decode(u, cu);
    v4u kr[6], vr[6]; bf16x8 qn[4];
#define ATT_LOAD(A) do { _Pragma("unroll") for (int i = 0; i < 6; ++i) { const int cid = tid + 512 * i, rho = cid >> 3, ch = cid & 7; const int sub = (A).L0 - 128 + rho; \
        const int subc = sub < 0 ? 0 : sub; const size_t go = (A).hb + (size_t)((subc << (A).dsh) + (A).r) * DH + ch * 8; kr[i] = *(const GAS v4u*)(KB + go); vr[i] = *(const GAS v4u*)(VB + go); } \
        { const int tq = (((A).L0 + 32 * w + c) << (A).dsh) + (A).r; _Pragma("unroll") for (int s = 0; s < 4; ++s) qn[s] = *(const GAS bf16x8*)(QB + (A).hb + (size_t)tq * DH + 16 * s + 8 * hh); } } while (0)
    ATT_LOAD(cu);
    for (;;) {
#pragma unroll
        for (int i = 0; i < 6; ++i) { const int cid = tid + 512 * i, rho = cid >> 3, ch = cid & 7;
            *(LAS v4u*)(kl + rho * ATT_KS + ch * 16) = kr[i]; *(LAS v4u*)(vl + rho * ATT_VS + ch * 16) = vr[i]; }
        bf16x8 qf[4];
#pragma unroll
        for (int s = 0; s < 4; ++s) qf[s] = qn[s];
        const int un = u + F.G; const bool more = un < NUNIT; AttnUnit nx = cu;
        if (more) { attn_decode(un, nx); ATT_LOAD(nx); }
        LDS_WAIT(); __syncthreads();
        float m = NEG, l = 0.f; f32x16 o0 = f32x16{}, o1 = f32x16{};
        for (int j = 0; j < 5; ++j) {
            const int rho0 = 32 * w + 32 * j; if (cu.L0 - 128 + rho0 < 0) continue;
            bf16x8 kf[4];
#pragma unroll
            for (int s = 0; s < 4; ++s) kf[s] = *(const LAS bf16x8*)(kl + (rho0 + c) * ATT_KS + (16 * s + 8 * hh) * 2);
            f32x16 sc = f32x16{};
#pragma unroll
            for (int s = 0; s < 4; ++s) sc = __builtin_amdgcn_mfma_f32_32x32x16_bf16(kf[s], qf[s], sc, 0, 0, 0);
            if (j == 0) {
#pragma unroll
                for (int rr = 0; rr < 16; ++rr) if (crow(rr, hh) < c) sc[rr] = NEG;
            }
            if (j == 4) {
#pragma unroll
                for (int rr = 0; rr < 16; ++rr) if (crow(rr, hh) > c) sc[rr] = NEG;
            }
            float mx = fmaxf(fmaxf(sc[0], sc[1]), fmaxf(sc[2], sc[3]));
#pragma unroll
            for (int rr = 4; rr < 16; rr += 4) mx = fmaxf(mx, fmaxf(fmaxf(sc[rr], sc[rr + 1]), fmaxf(sc[rr + 2], sc[rr + 3])));
            mx = fmaxf(mx, __shfl_xor(mx, 32));
            if (__any(mx > m)) { const float mn = fmaxf(m, mx), alpha = __builtin_amdgcn_exp2f(m - mn); m = mn; l *= alpha;
#pragma unroll
                for (int rr = 0; rr < 16; ++rr) { o0[rr] *= alpha; o1[rr] *= alpha; } }
            float ps = 0.f;
#pragma unroll
            for (int rr = 0; rr < 16; ++rr) { sc[rr] = __builtin_amdgcn_exp2f(sc[rr] - m); ps += sc[rr]; }
            l += ps;
            v4u pb0, pb1;
            pb0.x = cvt2bf(sc[0], sc[1]); pb0.y = cvt2bf(sc[2], sc[3]); pb0.z = cvt2bf(sc[4], sc[5]); pb0.w = cvt2bf(sc[6], sc[7]);
            pb1.x = cvt2bf(sc[8], sc[9]); pb1.y = cvt2bf(sc[10], sc[11]); pb1.z = cvt2bf(sc[12], sc[13]); pb1.w = cvt2bf(sc[14], sc[15]);
            LAS unsigned char* vt = vl + rho0 * ATT_VS + tr_base;
#pragma unroll
            for (int dt = 0; dt < 2; ++dt)
#pragma unroll
                for (int s = 0; s < 2; ++s) {
                    const v4i16_t lo = __builtin_amdgcn_ds_read_tr16_b64_v4i16((LAS v4i16_t*)(vt + (16 * s) * ATT_VS + 64 * dt));
                    const v4i16_t hi = __builtin_amdgcn_ds_read_tr16_b64_v4i16((LAS v4i16_t*)(vt + (16 * s + 8) * ATT_VS + 64 * dt));
                    const bf16x8 af = (bf16x8){lo[0], lo[1], lo[2], lo[3], hi[0], hi[1], hi[2], hi[3]};
                    const bf16x8 pf = __builtin_bit_cast(bf16x8, s ? pb1 : pb0);
                    if (dt == 0) o0 = __builtin_amdgcn_mfma_f32_32x32x16_bf16(af, pf, o0, 0, 0, 0); else o1 = __builtin_amdgcn_mfma_f32_32x32x16_bf16(af, pf, o1, 0, 0, 0);
                }
        }
        asm volatile("s_waitcnt vmcnt(0)" ::: "memory");
        {   l += __shfl_xor(l, 32);
            const float inv = 1.0f / l;
            const int tq = ((cu.L0 + 32 * w + c) << cu.dsh) + cu.r;
            bf16* op = P_OP + (size_t)cu.p * TT * DH + cu.hb + (size_t)tq * DH;
#pragma unroll
            for (int g4 = 0; g4 < 4; ++g4) {
                v2u w0, w1; w0.x = cvt2bf(o0[4 * g4] * inv, o0[4 * g4 + 1] * inv); w0.y = cvt2bf(o0[4 * g4 + 2] * inv, o0[4 * g4 + 3] * inv);
                w1.x = cvt2bf(o1[4 * g4] * inv, o1[4 * g4 + 1] * inv); w1.y = cvt2bf(o1[4 * g4 + 2] * inv, o1[4 * g4 + 3] * inv);
                *(GAS v2u*)(op + 8 * g4 + 4 * hh) = w0; *(GAS v2u*)(op + 32 + 8 * g4 + 4 * hh) = w1; }
            if (hh == 0) P_LSE[(((size_t)cu.p * TT * DH + cu.hb + (size_t)tq * DH) >> 6)] = m + __builtin_amdgcn_logf(l); }
        LDS_WAIT(); __syncthreads();
        if (!more) break;
        u = un; cu = nx;
    }
#undef ATT_LOAD
}
__device__ __forceinline__ void attn_merge(Frame& F) {
    const int gt = F.vcu * (NWAVES * 64) + F.tid, NGT = F.G * NWAVES * 64;
    for (int idx = gt; idx < TT * 64; idx += NGT) {
        const int t = idx >> 6, ch = idx & 63, h = ch >> 3;
        const float l0 = P_LSE[(size_t)t * NHEAD + h], l1 = P_LSE[((size_t)TT + t) * NHEAD + h], l2 = P_LSE[((size_t)2 * TT + t) * NHEAD + h];
        const float mx = fmaxf(l0, fmaxf(l1, l2));
        float w0 = __builtin_amdgcn_exp2f(l0 - mx), w1 = __builtin_amdgcn_exp2f(l1 - mx), w2 = __builtin_amdgcn_exp2f(l2 - mx);
        const float inv = 1.0f / (w0 + w1 + w2); w0 *= inv; w1 *= inv; w2 *= inv;
        const v4u a = *(const GAS v4u*)(P_OP + (size_t)t * DH + ch * 8), bq = *(const GAS v4u*)(P_OP + ((size_t)TT + t) * DH + ch * 8), cq = *(const GAS v4u*)(P_OP + ((size_t)2 * TT + t) * DH + ch * 8);
        v4u o;
#pragma unroll
        for (int k = 0; k < 4; ++k) {
            const float lo = w0 * bf2f((unsigned short)(a[k] & 0xffffu)) + w1 * bf2f((unsigned short)(bq[k] & 0xffffu)) + w2 * bf2f((unsigned short)(cq[k] & 0xffffu));
            const float hi = w0 * bf2f((unsigned short)(a[k] >> 16)) + w1 * bf2f((unsigned short)(bq[k] >> 16)) + w2 * bf2f((unsigned short)(cq[k] >> 16));
            o[k] = pk2(lo, hi); }
        *(GAS v4u*)(P_MIX + (size_t)t * DM + ch * 8) = o;
        asm volatile("" ::: "memory");
    }
}

__device__ __forceinline__ void p7_gather(Frame& F, int rank, int nranks, bool lead);
#ifndef ROUTER_SPLIT
#define ROUTER_SPLIT 2
#endif
__device__ __forceinline__ void p6_rows(Frame& F, int only = 0) {
    const float* in_g_ffn = F.in(I_g_ffn); const float* in_b_router = F.in(I_b_router);
    constexpr int RS = ROUTER_SPLIT;
    const bool split = (F.G % RS) == 0;
    if (split && (F.vcu % RS) != 0) { if (only != 1) p0_transposes(F, 0, PT_WGU, (F.vcu / RS) * (RS - 1) + (F.vcu % RS) - 1, (F.G / RS) * (RS - 1)); return; }
    const int rrank = split ? F.vcu / RS : F.vcu, rn = split ? F.G / RS : F.G;
    if (only >= 2) return;
    LAS unsigned char* hl = F.lds + RING_OFF;
    LAS int* wc = (LAS int*)(F.lds + SUMM_OFF);
    const int lane = F.lane, w = F.wave, e = lane & 31, hh = lane >> 5;
    float wreg[64];
#pragma unroll
    for (int i4 = 0; i4 < 16; ++i4) { const f32x4 t = *(const GAS f32x4*)(P_WRT + (size_t)e * DM + 128 * w + 64 * hh + 4 * i4); wreg[4 * i4] = t.x; wreg[4 * i4 + 1] = t.y; wreg[4 * i4 + 2] = t.z; wreg[4 * i4 + 3] = t.w; }
    const float bias = in_b_router[e];
    const __amdgpu_buffer_rsrc_t rs_x1 = __builtin_amdgcn_make_buffer_rsrc((void*)P_X1, 0, 0x7ffffff0, 0x00020000), rs_h8 = __builtin_amdgcn_make_buffer_rsrc((void*)P_XN8, 0, 0x7ffffff0, 0x00020000);
#define P6_LOADROW(dst, m) do { _Pragma("unroll") for (int j_ = 0; j_ < 4; ++j_) (dst)[j_] = __builtin_bit_cast(v2u, __builtin_amdgcn_raw_buffer_load_b64(rs_x1, lane * 8 + j_ * 512, (m) * (DM * 2), 0)); } while (0)
    v2u xa[4][4];
    if (rrank < TT / 64) {
#pragma unroll
      for (int q = 0; q < 4; ++q) P6_LOADROW(xa[q], rrank * 64 + 4 * w + q); }
    for (int chunk = rrank; chunk < TT / 64; chunk += rn) {
      int wcount = 0;
      const int b = (chunk * 64) / SEQ;
      const float* mb = P_MOD + (size_t)b * NMOD;
#pragma nounroll
      for (int bl = 0; bl < 2; ++bl) {
        const int mblk = chunk * 64 + bl * 32;
        f32x4 Gm[4], Sm[4];
#pragma unroll
        for (int j = 0; j < 4; ++j) { const int col = 4 * lane + 256 * j; Gm[j] = *(const f32x4*)(in_g_ffn + col) * (*(const f32x4*)(mb + 4 * DM + col) + 1.0f); Sm[j] = *(const f32x4*)(mb + 3 * DM + col); }
#pragma unroll
        for (int q = 0; q < 4; ++q) { f32x4 v[4]; float sa = 0.f; const int tok = 4 * w + q;
#pragma unroll
            for (int j = 0; j < 4; ++j) { const v2u t = xa[q][j]; v[j] = (f32x4){bf2f((unsigned short)(t.x & 0xffffu)), bf2f((unsigned short)(t.x >> 16)), bf2f((unsigned short)(t.y & 0xffffu)), bf2f((unsigned short)(t.y >> 16))};
                sa += (v[j].x * v[j].x + v[j].y * v[j].y) + (v[j].z * v[j].z + v[j].w * v[j].w); }
            const float ra = 1.0f / sqrtf(wave_sum(sa) * (1.0f / DM) + NORM_EPS);
#pragma unroll
            for (int j = 0; j < 4; ++j) {
                const f32x4 h = (v[j] * ra) * Gm[j] + Sm[j];
                __builtin_amdgcn_raw_buffer_store_b32(pg8::pk4_fp8(h.x * SC_H, h.y * SC_H, h.z * SC_H, h.w * SC_H), rs_h8, lane * 4 + j * 256, (mblk + tok) * DM, 0);
                *(LAS f32x4*)(hl + tok * 4096 + (((lane + 64 * j) ^ (tok & 15)) * 16)) = h; } }
        {
            const int mn = bl == 0 ? mblk + 32 : (chunk + rn < TT / 64 ? (chunk + rn) * 64 : mblk);
#pragma unroll
            for (int q = 0; q < 4; ++q) P6_LOADROW(xa[q], mn + 4 * w + q); }
        LDS_WAIT(); __syncthreads();
        f32x16 acc = f32x16{};
        { const LAS unsigned char* hrow = hl + e * 4096;
#pragma unroll
          for (int i4 = 0; i4 < 16; ++i4) { const f32x4 a4 = *(const LAS f32x4*)(hrow + (((32 * w + 16 * hh + i4) ^ (e & 15)) * 16));
              acc = __builtin_amdgcn_mfma_f32_32x32x2f32(wreg[4 * i4], a4.x, acc, 0, 0, 0); acc = __builtin_amdgcn_mfma_f32_32x32x2f32(wreg[4 * i4 + 1], a4.y, acc, 0, 0, 0);
              acc = __builtin_amdgcn_mfma_f32_32x32x2f32(wreg[4 * i4 + 2], a4.z, acc, 0, 0, 0); acc = __builtin_amdgcn_mfma_f32_32x32x2f32(wreg[4 * i4 + 3], a4.w, acc, 0, 0, 0); } }
        LDS_WAIT(); __syncthreads();
#pragma unroll
        for (int g = 0; g < 4; ++g) *(LAS f32x4*)(hl + (w * 32 + e) * 128 + (((2 * g + hh) ^ (e & 7)) * 16)) = (f32x4){acc[4 * g], acc[4 * g + 1], acc[4 * g + 2], acc[4 * g + 3]};
        LDS_WAIT(); __syncthreads();
#pragma unroll
        for (int pr = 0; pr < 2; ++pr) {
          const int tl = 4 * w + 2 * pr + hh;
          float val = bias;
#pragma unroll
          for (int q = 0; q < 8; ++q) val += *(const LAS float*)(hl + (q * 32 + tl) * 128 + (((e >> 2) ^ (tl & 7)) * 16) + (e & 3) * 4);
          float tv[4]; int te[4];
#pragma unroll
          for (int r = 0; r < 4; ++r) { float mx = val;
              mx = row_max16(mx); mx = fmaxf(mx, __shfl_xor(mx, 16));
              const unsigned long long bal = __ballot(val == mx); const unsigned hb = hh ? (unsigned)(bal >> 32) : (unsigned)bal;
              const int es = __builtin_ctz(hb | 0x80000000u);
              te[r] = es; tv[r] = mx; if (e == es) val = -INFINITY; }
          const float e1 = expf(tv[1] - tv[0]), e2 = expf(tv[2] - tv[0]), e3 = expf(tv[3] - tv[0]); const float inv = 1.0f / (1.0f + e1 + e2 + e3);
          int lpv = 0;
#pragma unroll
          for (int h2 = 0; h2 < 2; ++h2)
#pragma unroll
            for (int r = 0; r < 4; ++r) { const int es = __builtin_amdgcn_readlane(te[r], 32 * h2); const int lp = __builtin_amdgcn_readlane(wcount, es);
                if (lane == es) ++wcount; if (lane == 32 * h2 + r) lpv = lp; }
          if (e < 4) { const int m = mblk + tl, ti = 4 * bl + 2 * pr + hh;
              const int ee = e == 0 ? te[0] : e == 1 ? te[1] : e == 2 ? te[2] : te[3];
              const float g = (e == 0 ? 1.0f : e == 1 ? e1 : e == 2 ? e2 : e3) * inv;
              __hip_atomic_store((GAS unsigned*)(P_TOK_E + m * 4 + e), (unsigned)ee, RLX_AGENT); P_TOK_GATE[m * 4 + e] = g;
              wc[512 + ((w * 8 + ti) * 4 + e) * 2] = ee; wc[512 + ((w * 8 + ti) * 4 + e) * 2 + 1] = lpv; }
        }
        LDS_WAIT(); __syncthreads();
      }
      if (lane < 32) wc[w * 32 + lane] = wcount;
      LDS_WAIT(); __syncthreads();
      if (lane < 32) { int pre = 0; for (int q = 0; q < w; ++q) pre += wc[q * 32 + lane]; wc[256 + w * 32 + lane] = pre;
          if (w == 7) __hip_atomic_store((GAS unsigned*)(P_BCNT + chunk * 32 + lane), (unsigned)(pre + wcount), RLX_AGENT); }
      LDS_WAIT(); asm volatile("" ::: "memory");
      if (lane < 32) { const int ti = lane >> 2, r = lane & 3; const int ee = wc[512 + ((w * 8 + ti) * 4 + r) * 2], l = wc[512 + ((w * 8 + ti) * 4 + r) * 2 + 1];
          __hip_atomic_store((GAS unsigned*)(P_TOK_POS + (chunk * 64 + (ti >> 2) * 32 + 4 * w + (ti & 3)) * 4 + r), (unsigned)(wc[256 + w * 32 + ee] + l), RLX_AGENT); }
      LDS_WAIT(); __syncthreads();
    }
#undef P6_LOADROW
    if (split) {
        asm volatile("s_waitcnt vmcnt(0)" ::: "memory");
        __syncthreads();
        if (F.tid == 0) {
            unsigned* cnt = (unsigned*)(F.ws + WS_CTL) + CW_CNT;
            __hip_atomic_fetch_add(cnt, 1u, RLX_AGENT);
            unsigned spins = 0u;
            while (__hip_atomic_load(cnt, RLX_AGENT) < (unsigned)rn) { __builtin_amdgcn_s_sleep(2); if (++spins > (1u << 22)) { __hip_atomic_store((unsigned*)(F.ws + WS_CTL) + CW_TMO, 0xA66u, RLX_AGENT); break; } }
            __builtin_amdgcn_fence(__ATOMIC_ACQUIRE, "agent");
            asm volatile("s_waitcnt vmcnt(0)" ::: "memory");
        }
        __syncthreads();
        p7_gather(F, rrank, rn, rrank == 0);
    }
}
__device__ __forceinline__ void p7_gather(Frame& F, int rank, int nranks, bool lead) {
    LAS int* pt = (LAS int*)(F.lds + RING_OFF);
    volatile LAS int* lb = (volatile LAS int*)(F.lds + TILE_OFF);
    { const int e = F.tid & 31, seg = F.tid >> 5; int s = 0; int cj[16];
#pragma unroll
      for (int j = 0; j < 16; ++j) { cj[j] = P_BCNT[(seg * 16 + j) * 32 + e]; s += cj[j]; }
      pt[8192 + seg * 32 + e] = s; LDS_WAIT(); __syncthreads();
      int base = 0, tot = 0; for (int q = 0; q < 16; ++q) { const int x = pt[8192 + q * 32 + e]; if (q < seg) base += x; tot += x; }
#pragma unroll
      for (int j = 0; j < 16; ++j) { pt[(seg * 16 + j) * 32 + e] = base; base += cj[j]; }
      if (seg == 0) lb[64 + e] = tot; }
    LDS_WAIT(); __syncthreads();
    if (F.tid < 64) {
        const int e = F.tid & 31; const int c = lb[64 + e]; const int tiles = F.tid < 32 ? (c + 255) >> 8 : 0;
        int incl = tiles;
#pragma unroll
        for (int o = 1; o < 32; o <<= 1) { const int t = __shfl_up(incl, o); if ((F.tid & 63) >= o) incl += t; }
        const int excl = incl - tiles, nt = __shfl(incl, 31);
        if (F.tid < 32) { lb[e] = excl * 256; if (lead) for (int k = 0; k < tiles; ++k) P_TILE_E[excl + k] = e; }
        if (F.tid == 0) { lb[32] = nt * 256; if (lead) P_TILE_N[0] = nt; } }
    LDS_WAIT(); __syncthreads();
    const int gt = rank * (NWAVES * 64) + F.tid, NGT = nranks * NWAVES * 64;
    for (int idx = gt; idx < TT * TOPK + NEXP * 256; idx += NGT) {
        if (idx < TT * TOPK) { const int e = P_TOK_E[idx], pos = P_TOK_POS[idx]; const int slot = lb[e] + pt[(idx >> 8) * 32 + e] + pos; P_TOK_SLOT[idx] = slot; P_SLOT_TOK[slot] = idx >> 2; }
        else { const int q = idx - TT * TOPK, e = q >> 8, i = q & 255; const int c = lb[64 + e]; const int padded = ((c + 255) >> 8) << 8; if (c + i < padded) P_SLOT_TOK[lb[e] + c + i] = TT; }
    }
    if (lead && F.tid < 64) ((GAS v4u*)(P_XN8 + (size_t)TT * DM))[F.tid] = (v4u){0u, 0u, 0u, 0u};
    asm volatile("s_waitcnt vmcnt(0)" ::: "memory");
    LDS_WAIT(); __syncthreads();
    if (F.G % ROUTER_SPLIT) p0_transposes(F, 0, PT_WGU);
}
__device__ __forceinline__ void p10_final(Frame& F) {
    const float* in_g_final = F.in(I_g_final); float* out_p = (float*)F.in(22);
    const int gw = F.vcu * NWAVES + F.wave, NGW = F.G * NWAVES, lane = F.lane;
    const unsigned char* Y2 = (const unsigned char*)P_Y2;
    for (int m = gw; m < TT; m += NGW) {
        const int b = m / SEQ;
        const GAS v2u* xr = (const GAS v2u*)(P_X1 + (size_t)m * DM) + lane;
        f32x4 v[4], a[4];
#pragma unroll
        for (int j = 0; j < 4; ++j) { const v2u t = xr[64 * j]; v[j] = (f32x4){bf2f((unsigned short)(t.x & 0xffffu)), bf2f((unsigned short)(t.x >> 16)), bf2f((unsigned short)(t.y & 0xffffu)), bf2f((unsigned short)(t.y >> 16))}; a[j] = (f32x4){0.f, 0.f, 0.f, 0.f}; }
#pragma unroll
        for (int k = 0; k < 4; ++k) { const int slot = P_TOK_SLOT[m * 4 + k]; const float g = P_TOK_GATE[m * 4 + k] * (1.0f / SC_Y);
            const GAS unsigned* yr = (const GAS unsigned*)(Y2 + (size_t)slot * DM) + lane;
#pragma unroll
            for (int j = 0; j < 4; ++j) { const unsigned y = yr[64 * j]; typedef float f32x2_y __attribute__((ext_vector_type(2)));
                const f32x2_y lo = __builtin_amdgcn_cvt_pk_f32_fp8((int)y, false), hi = __builtin_amdgcn_cvt_pk_f32_fp8((int)y, true);
                a[j] += (f32x4){lo.x, lo.y, hi.x, hi.y} * g; } }
        const float* gf = P_MOD + (size_t)b * NMOD + 5 * DM; float ss = 0.f;
#pragma unroll
        for (int j = 0; j < 4; ++j) { const f32x4 gt = *(const f32x4*)(gf + 4 * lane + 256 * j); v[j] = v[j] + gt * a[j]; ss += (v[j].x * v[j].x + v[j].y * v[j].y) + (v[j].z * v[j].z + v[j].w * v[j].w); }
        const float rstd = 1.0f / sqrtf(wave_sum(ss) * (1.0f / DM) + NORM_EPS);
        GAS f32x4* orow = (GAS f32x4*)(out_p + (size_t)m * DM) + lane;
#pragma unroll
        for (int j = 0; j < 4; ++j) { const f32x4 g = *(const f32x4*)(in_g_final + 4 * lane + 256 * j); orow[64 * j] = (v[j] * rstd) * g; }        asm volatile("" ::: "memory");
    }
}

#ifndef DUP_MASK
#define DUP_MASK 0
#endif
struct Args { const float* in[22]; float* out; unsigned char* ws; int ph_lo, ph_hi, li, pad; };
__global__ void __launch_bounds__(NWAVES * 64, 2) hymba_fwd(Args args) {
    extern __shared__ __attribute__((aligned(16))) unsigned char lds[];
    Frame F;
    F.lds = (LAS unsigned char*)lds;
    F.tid = threadIdx.x; F.lane = F.tid & 63; F.wave = __builtin_amdgcn_readfirstlane(F.tid >> 6);
    F.G = gridDim.x; { const int bx = blockIdx.x; F.vcu = (F.G % 8 == 0) ? (bx % 8) * (F.G / 8) + bx / 8 : bx; }
    unsigned char* ws = args.ws;
    F.ws = ws; F.ka = (const __attribute__((address_space(4))) void*)__builtin_amdgcn_kernarg_segment_ptr();
    for (int u = F.tid; u < (LDS_BYTES - LDSCTL_OFF) / 4; u += NWAVES * 64) ((LAS unsigned*)(F.lds + LDSCTL_OFF))[u] = 0u;
    __syncthreads();
#define CTLP ((gu32*)(F.ws + WS_CTL))
#define MISCP ((volatile LAS unsigned*)(F.lds + MISC_OFF))
    if (N_LAUNCHES != PER_PHASE) (void)xcd_barrier_post((unsigned*)(CTLP + CW_BAR), MISCP + 8);
#define GRID_BAR(seam) do { if (N_LAUNCHES == PER_PHASE) { if (F.tid == 0) __hip_atomic_store(CTLP + CW_TMO, 0xBADBA0u | (unsigned)(seam), RLX_AGENT); } \
    else { XcdBarrier bar_; bar_.bar = (unsigned*)(CTLP + CW_BAR); bar_.x = xb_xcc_id(); bar_.st = MISCP + 8; xcd_barrier(bar_); if (DUPK(13)) xcd_barrier(bar_); } asm volatile("" : "+v"(F.tid), "+v"(F.lane)); } while (0)
    const int lo = (N_LAUNCHES == 1) ? 0 : args.ph_lo, hi = (N_LAUNCHES == 1) ? PER_PHASE : args.ph_hi;
#ifndef PHASE_MASK
#define PHASE_MASK 0x7ff
#endif
#define IN(k) (((PHASE_MASK >> (k)) & 1) && lo <= (k) && (k) < hi)
#define BOTH(k) (IN(k) && IN((k) + 1))
#define DUPK(k) ((DUP_MASK >> (k)) & 1)
#define RUN_P2() do { pg8::Gemm g{P_XN, P_WIN_T, TT, INCOLS, DM}; pg8::HalfTailOrder S; S.init(TT, INCOLS, F.G, (int)blockIdx.x); \
        pg8::EpiBf16<0> E{P_QB, DH, nullptr, DH, (size_t)TT * DH, C2}; \
        pg8::gemm_phase<pg8::EpiBf16<0>, pg8::HalfTailOrder, true, true, false, false, true>(F.lds + RING_OFF, g, S, E); } while (0)
#define RUN_P5() do { pg8::Gemm g{P_MIX, P_WOUT_T, TT, DM, DM}; pg8::StaticOrder S; S.init(TT, DM, F.G, (int)blockIdx.x); \
        pg8::EpiResGate E{F.in(I_x), P_X1, DM, P_MOD + 2 * DM, NMOD, SEQ}; \
        pg8::gemm_phase<pg8::EpiResGate, pg8::StaticOrder, true, true>(F.lds + RING_OFF, g, S, E); } while (0)
#define RUN_P8() do { const int ntm = P_TILE_N[0]; \
        LAS int* lte = (LAS int*)(F.lds + SUMM_OFF); for (int i_ = F.tid; i_ < ntm; i_ += NWAVES * 64) lte[i_] = P_TILE_E[i_]; LDS_WAIT(); __syncthreads(); \
        pg8::Gemm g{(const pg8::bf16_t*)P_XN8, (const pg8::bf16_t*)P_WGU8, ntm * 256, DE2, DM / 2}; pg8::GroupedOrder S; S.init(lte, ntm, 8, F.G, (int)blockIdx.x); \
        LAS int* rt = (LAS int*)(F.lds + ROWTAB_OFF); { pg8::Unit u_; for (int i_ = 0; i_ < ROWTAB_UNITS && S.next(i_, u_); ++i_) if (F.tid < 256) rt[i_ * 256 + F.tid] = P_SLOT_TOK[u_.pm * 256 + F.tid] * DM; } \
        LDS_WAIT(); __syncthreads(); \
        pg8::EpiSwiglu E{P_ACT8, F.in(I_b_gate_up), 1.0f / (SC_H * SC_W), SC_ACT}; \
        pg8::gemm_phase<pg8::EpiSwiglu, pg8::GroupedOrder, true, true, true, true>(F.lds + RING_OFF, g, S, E, rt); \
        asm volatile("s_waitcnt vmcnt(0)" ::: "memory"); __syncthreads(); p0_transposes(F, PT_WGU, P0T_EXPERTS); } while (0)
#define RUN_P9(NS) do { const int ntm = P_TILE_N[0]; \
        LAS int* lte = (LAS int*)(F.lds + SUMM_OFF); for (int i_ = F.tid; i_ < ntm; i_ += NWAVES * 64) lte[i_] = P_TILE_E[i_]; LDS_WAIT(); __syncthreads(); \
        pg8::Gemm g{(const pg8::bf16_t*)P_ACT8, (const pg8::bf16_t*)P_WD8, ntm * 256, DM, DM / 2}; pg8::GroupedOrder S; S.init(lte, ntm, 4, F.G, (int)blockIdx.x); \
        pg8::EpiDown E{P_Y2, F.in(I_b_down), 1.0f / (SC_ACT * SC_W), NS, SC_Y}; \
        pg8::gemm_phase<pg8::EpiDown, pg8::GroupedOrder, true, true, true>(F.lds + RING_OFF, g, S, E); } while (0)
    if (IN(0)) { p0_prologue(F); if (BOTH(0)) GRID_BAR(0); if (DUPK(0)) { p0_prologue(F); GRID_BAR(0); } }
    if (IN(1)) { p1_norm(F); if (BOTH(1)) GRID_BAR(1); if (DUPK(1)) { p1_norm(F); GRID_BAR(1); } }
    if (IN(2)) { RUN_P2(); if (BOTH(2)) GRID_BAR(2); if (DUPK(2)) { RUN_P2(); GRID_BAR(2); } }
    if (IN(3)) { rglru_single(F); attn_items(F); if (BOTH(3)) GRID_BAR(3);  if (DUPK(11)) { attn_items(F); GRID_BAR(3); }  }
    if (IN(4)) { attn_merge(F); if (BOTH(4)) GRID_BAR(4); if (DUPK(4)) { attn_merge(F); GRID_BAR(4); } }
    if (IN(5)) { RUN_P5(); if (BOTH(5)) GRID_BAR(5); if (DUPK(5)) { RUN_P5(); GRID_BAR(5); } }
    if (IN(6)) { p6_rows(F); if (BOTH(6)) GRID_BAR(6); if (DUPK(6)) { p6_rows(F); GRID_BAR(6); } if (DUPK(14)) { p6_rows(F, 1); GRID_BAR(6); } if (DUPK(15)) { p6_rows(F, 2); GRID_BAR(6); } }
    if (IN(7) && (F.G % ROUTER_SPLIT) != 0) { p7_gather(F, F.vcu, F.G, blockIdx.x == 0); if (BOTH(7)) GRID_BAR(7); }
    if (IN(8)) { RUN_P8(); if (BOTH(8)) GRID_BAR(8); if (DUPK(8)) { RUN_P8(); GRID_BAR(8); } }
    if (IN(9)) { RUN_P9(0); if (BOTH(9)) GRID_BAR(9); if (DUPK(9)) { RUN_P9(0); GRID_BAR(9); } if (DUPK(19)) { RUN_P9(1); GRID_BAR(9); } if (DUPK(20)) { RUN_P9(2); GRID_BAR(9); } }
    if (IN(10)) { p10_final(F); if (DUPK(10)) { GRID_BAR(10); p10_final(F); } }
#undef IN
#undef BOTH
}

extern "C" void kernel_launch(void* const* d_in, const int* in_sizes, int n_in, void* d_out, int out_size, void* d_ws, size_t ws_size, hipStream_t stream) {
    static int grid = 0;
    if (grid == 0) {
        if (n_in != 22 || in_sizes[0] != TT * DM || out_size != TT * DM || ws_size < WS_END) { fprintf(stderr, "kernel_launch: unexpected shapes (n_in %d, in0 %d, out %d, ws %zu); nothing launched\n", n_in, n_in > 0 ? in_sizes[0] : -1, out_size, ws_size); grid = -1; return; }
        int dev = 0, cus = 0, per_cu = 0;
        if (hipGetDevice(&dev) != hipSuccess || hipDeviceGetAttribute(&cus, hipDeviceAttributeMultiprocessorCount, dev) != hipSuccess) { fprintf(stderr, "kernel_launch: device query failed\n"); grid = -1; return; }
        if (hipFuncSetAttribute((const void*)hymba_fwd, hipFuncAttributeMaxDynamicSharedMemorySize, LDS_BYTES) != hipSuccess) { fprintf(stderr, "kernel_launch: hipFuncSetAttribute failed\n"); grid = -1; return; }
        if (hipOccupancyMaxActiveBlocksPerMultiprocessor(&per_cu, (const void*)hymba_fwd, NWAVES * 64, LDS_BYTES) != hipSuccess || per_cu < 1) { fprintf(stderr, "kernel_launch: occupancy query reports %d workgroups per CU\n", per_cu); per_cu = 1; }
        (void)hipGetLastError();
        if (cus < 256) { fprintf(stderr, "kernel_launch: built for a 256-CU device (one workgroup per CU), found %d CUs; nothing launched\n", cus); grid = -1; return; }
        grid = 256;
    }
    if (grid < 0) return;
    if (hipMemsetAsync((char*)d_ws + WS_CTL, 0, CTL_ZERO_BYTES, stream) != hipSuccess) { fprintf(stderr, "kernel_launch: memset failed\n"); return; }
    Args a{};
    for (int i = 0; i < 22; ++i) a.in[i] = (const float*)d_in[i];
    a.out = (float*)d_out; a.ws = (unsigned char*)d_ws; a.pad = DUP_MASK;
    for (int li = 0; li < N_LAUNCHES; ++li) {
        a.ph_lo = (N_LAUNCHES == PER_PHASE) ? li : 0; a.ph_hi = (N_LAUNCHES == PER_PHASE) ? li + 1 : PER_PHASE; a.li = li;
        hipLaunchKernelGGL(hymba_fwd, dim3(grid), dim3(NWAVES * 64), LDS_BYTES, stream, a);
        const hipError_t le = hipPeekAtLastError();
        if (le != hipSuccess) { fprintf(stderr, "kernel_launch: launch %d failed: %s\n", li, hipGetErrorName(le)); break; }
    }
}
```
